# Optimizing an MI355X kernel written in HIP

```python
import math
import jax, jax.numpy as jnp
from jax import lax
import numpy as np

D_MODEL = 2048
BATCH = 2
SEQ = 8192
DEPTH = 4
DEC_BATCH = 2
DEC_SEQ = 4096
PAST_LEN = 128

N_META = 16
GRID_W = 64
HEAD_DIM = 128
N_Q_HEADS = D_MODEL // HEAD_DIM
N_KV_HEADS = N_Q_HEADS // 4
GROUP = N_Q_HEADS // N_KV_HEADS
Q_BLOCK = 128
ROPE_THETA = 10000.0
D_HYENA = D_MODEL // 2
FILT_EMB = 33
FILT_WIDTH = 64
HYENA_FAST_DECAY = 0.3
HYENA_SLOW_DECAY = 1.5
HYENA_TARGET = 1e-2
D_FF = 5632
LN_EPS = 1e-5
QK_EPS = 1e-6
ALPHA = float((2 * DEPTH) ** 0.25)
BETA = float((8 * DEPTH) ** -0.25)
N_HY_COLS = 3 * D_HYENA
N_Q_COLS = N_Q_HEADS * HEAD_DIM
N_KV_COLS = N_KV_HEADS * HEAD_DIM
N_GATE_COLS = 2 * D_MODEL
N_IN = N_HY_COLS + N_Q_COLS + 2 * N_KV_COLS + N_GATE_COLS
SPLITS = (N_HY_COLS, N_HY_COLS + N_Q_COLS, N_HY_COLS + N_Q_COLS + N_KV_COLS,
          N_HY_COLS + N_Q_COLS + 2 * N_KV_COLS)

kernel_name = "hyena_gqa_macaron_deepnorm_encoder"


def _layernorm(x, g, b):
    xf = x.astype(jnp.float32)
    mu = jnp.mean(xf, -1, keepdims=True)
    var = jnp.mean(jnp.square(xf - mu), -1, keepdims=True)
    return ((xf - mu) * lax.rsqrt(var + LN_EPS) * g.astype(jnp.float32) + b.astype(jnp.float32)).astype(x.dtype)


def _swiglu(x, w13, w2):
    gate, up = jnp.split(x @ w13, 2, axis=-1)
    return (jax.nn.silu(gate) * up) @ w2


def _short_conv(u, w, b):
    up = jnp.pad(u, ((0, 0), (1, 1), (0, 0)))
    return up[:, :-2] * w[0] + up[:, 1:-1] * w[1] + up[:, 2:] * w[2] + b


def _hyena_filter(L, w1, b1, freq, w2, b2, w3):
    f32 = jnp.float32
    t = jnp.linspace(0.0, 1.0, L, dtype=f32)[:, None]
    bands = (FILT_EMB - 1) // 2
    fr = jnp.linspace(1e-4, bands - 1, bands, dtype=f32)
    w = 2.0 * math.pi * jnp.arange(L, dtype=f32)[:, None] / L
    z = jnp.concatenate([t, jnp.cos(fr * w), -jnp.sin(fr * w)], -1)
    fq = freq.astype(f32)
    h = jnp.sin(fq * (z @ w1.astype(f32) + b1.astype(f32)))
    h = jnp.sin(fq * (h @ w2.astype(f32) + b2.astype(f32)))
    h = (h @ w3.astype(f32)).reshape(L, 2, D_HYENA)
    deltas = jnp.abs(jnp.linspace(math.log(HYENA_TARGET) / HYENA_SLOW_DECAY,
                                  math.log(HYENA_TARGET) / HYENA_FAST_DECAY, D_HYENA, dtype=f32))
    h = h * jnp.exp(-t * deltas)[:, None, :]
    h_full = jnp.concatenate([h[:, 0], jnp.zeros((1, D_HYENA), f32), h[:0:-1, 1]], 0)
    return h_full / jnp.sum(jnp.abs(h_full), 0, keepdims=True)


def _hyena(u, conv_w, conv_b, w1, b1, freq, w2, b2, w3, skip):
    B, L, _ = u.shape
    u = _short_conv(u, conv_w, conv_b)
    x0, x1, v = jnp.split(u, 3, axis=-1)
    z = (x1 * v).astype(jnp.float32)
    h = _hyena_filter(L, w1, b1, freq, w2, b2, w3)
    n = 2 * L
    y = jnp.fft.irfft(jnp.fft.rfft(z, n=n, axis=1) * jnp.fft.rfft(h, n=n, axis=0)[None], n=n, axis=1)[:, :L]
    y = y + skip.astype(jnp.float32) * z
    return (x0.astype(jnp.float32) * y).astype(u.dtype)


def _rmsnorm_head(x, g):
    xf = x.astype(jnp.float32)
    return xf * lax.rsqrt(jnp.mean(xf * xf, -1, keepdims=True) + QK_EPS) * g.astype(jnp.float32)


def _rope_half(x, pos):
    half = x.shape[-1] // 2
    inv = ROPE_THETA ** (-jnp.arange(half, dtype=jnp.float32) / half)
    ang = pos[:, None] * inv
    cos = jnp.cos(ang)[:, None, :]
    sin = jnp.sin(ang)[:, None, :]
    x1, x2 = x[..., :half], x[..., half:]
    return jnp.concatenate([x1 * cos - x2 * sin, x2 * cos + x1 * sin], -1)


def _axial_rope(x, row, col):
    h = HEAD_DIM // 2
    return jnp.concatenate([_rope_half(x[..., :h], row), _rope_half(x[..., h:], col)], -1)


def _axial_positions(n_tokens):
    rows = n_tokens // GRID_W
    row = jnp.repeat(jnp.arange(rows, dtype=jnp.float32), GRID_W)
    col = jnp.tile(jnp.arange(GRID_W, dtype=jnp.float32), rows)
    meta_row = jnp.full((N_META,), -1.0, jnp.float32)
    meta_col = jnp.arange(N_META, dtype=jnp.float32)
    return jnp.concatenate([meta_row, row]), jnp.concatenate([meta_col, col])


def _attend(qb, k, v):
    s = jnp.einsum('bqgrd,bkgd->bgrqk', qb, k).astype(jnp.float32) * (HEAD_DIM ** -0.5)
    p = jax.nn.softmax(s, axis=-1).astype(v.dtype)
    return jnp.einsum('bgrqk,bkgd->bqgrd', p, v)


def _gqa(q, k, v, row, col, q_norm, k_norm):
    B, L, _ = q.shape
    dt = q.dtype
    q = _axial_rope(_rmsnorm_head(q.reshape(B, L, N_Q_HEADS, HEAD_DIM), q_norm), row, col).astype(dt)
    k = _axial_rope(_rmsnorm_head(k.reshape(B, L, N_KV_HEADS, HEAD_DIM), k_norm), row, col).astype(dt)
    v = v.reshape(B, L, N_KV_HEADS, HEAD_DIM)
    q = q.reshape(B, L, N_KV_HEADS, GROUP, HEAD_DIM)
    n_real = L - N_META
    nb = n_real // Q_BLOCK
    o_meta = _attend(q[:, :N_META], k, v)
    q_blocks = jnp.moveaxis(q[:, N_META:].reshape(B, nb, Q_BLOCK, N_KV_HEADS, GROUP, HEAD_DIM), 1, 0)
    o_real = lax.map(lambda qb: _attend(qb, k, v), q_blocks)
    o_real = jnp.moveaxis(o_real, 0, 1).reshape(B, n_real, N_KV_HEADS, GROUP, HEAD_DIM)
    return jnp.concatenate([o_meta, o_real], 1).reshape(B, L, N_Q_HEADS * HEAD_DIM)


def _mixer(h, row, col, w_in, b_gate, hy_conv_w, hy_conv_b, filt_w1, filt_b1, filt_freq, filt_w2,
           filt_b2, filt_w3, hy_skip, q_norm, k_norm, w_br_hy, w_br_attn, w_out):
    proj = h @ w_in
    hy_in, q, k, v, gates = jnp.split(proj, SPLITS, axis=-1)
    y_hy = _hyena(hy_in, hy_conv_w, hy_conv_b, filt_w1, filt_b1, filt_freq, filt_w2, filt_b2,
                  filt_w3, hy_skip) @ w_br_hy
    y_at = _gqa(q, k, v, row, col, q_norm, k_norm) @ w_br_attn
    g_hy, g_at = jnp.split(jax.nn.sigmoid(gates + b_gate), 2, axis=-1)
    return (g_hy * y_hy + g_at * y_at) @ w_out


def _trunk(x, meta_tokens, ln_g, ln_b, ffa_w13, ffa_w2, w_in, b_gate, hy_conv_w, hy_conv_b,
           filt_w1, filt_b1, filt_freq, filt_w2, filt_b2, filt_w3, hy_skip, q_norm, k_norm,
           w_br_hy, w_br_attn, w_out, ffb_w13, ffb_w2):
    B, S, D = x.shape
    row, col = _axial_positions(S)
    h = jnp.concatenate([jnp.broadcast_to(meta_tokens.astype(x.dtype)[None], (B, N_META, D)), x], 1)
    for l in range(DEPTH):
        h = _layernorm(ALPHA * h + 0.5 * _swiglu(h, ffa_w13[l], ffa_w2[l]), ln_g[l, 0], ln_b[l, 0])
        mix = _mixer(h, row, col, w_in[l], b_gate[l], hy_conv_w[l], hy_conv_b[l], filt_w1[l], filt_b1[l],
                     filt_freq[l], filt_w2[l], filt_b2[l], filt_w3[l], hy_skip[l], q_norm[l], k_norm[l],
                     w_br_hy[l], w_br_attn[l], w_out[l])
        h = _layernorm(ALPHA * h + mix, ln_g[l, 1], ln_b[l, 1])
        h = _layernorm(ALPHA * h + 0.5 * _swiglu(h, ffb_w13[l], ffb_w2[l]), ln_g[l, 2], ln_b[l, 2])
    return h[:, N_META:]


def setup_inputs(seed: int = 0) -> dict:
    key = jax.random.key(seed)
    ks = jax.random.split(key, 26)
    f32 = jnp.float32

    def nrm(k, shape, scale):
        return jax.random.normal(k, shape, f32) * scale

    return {
        "x_prompt": nrm(ks[0], (BATCH, SEQ, D_MODEL), 1.0),
        "x_sample": nrm(ks[1], (DEC_BATCH, DEC_SEQ, D_MODEL), 1.0),
        "meta_tokens": nrm(ks[2], (N_META, D_MODEL), 1.0),
        "ln_g": 1.0 + nrm(ks[3], (DEPTH, 3, D_MODEL), 0.02),
        "ln_b": nrm(ks[4], (DEPTH, 3, D_MODEL), 0.02),
        "ffa_w13": nrm(ks[5], (DEPTH, D_MODEL, 2 * D_FF), D_MODEL ** -0.5),
        "ffa_w2": nrm(ks[6], (DEPTH, D_FF, D_MODEL), BETA * D_FF ** -0.5),
        "w_in": nrm(ks[7], (DEPTH, D_MODEL, N_IN), D_MODEL ** -0.5),
        "b_gate": nrm(ks[8], (DEPTH, N_GATE_COLS), 0.02),
        "hy_conv_w": nrm(ks[9], (DEPTH, 3, N_HY_COLS), 3 ** -0.5),
        "hy_conv_b": nrm(ks[10], (DEPTH, N_HY_COLS), 0.02),
        "filt_w1": nrm(ks[11], (DEPTH, FILT_EMB, FILT_WIDTH), FILT_EMB ** -0.5),
        "filt_b1": nrm(ks[12], (DEPTH, FILT_WIDTH), 0.02),
        "filt_freq": 1.0 + nrm(ks[13], (DEPTH, FILT_WIDTH), 0.02),
        "filt_w2": nrm(ks[14], (DEPTH, FILT_WIDTH, FILT_WIDTH), FILT_WIDTH ** -0.5),
        "filt_b2": nrm(ks[15], (DEPTH, FILT_WIDTH), 0.02),
        "filt_w3": nrm(ks[16], (DEPTH, FILT_WIDTH, 2 * D_HYENA), FILT_WIDTH ** -0.5),
        "hy_skip": nrm(ks[17], (DEPTH, D_HYENA), 1.0),
        "q_norm": 1.0 + nrm(ks[18], (DEPTH, HEAD_DIM), 0.02),
        "k_norm": 1.0 + nrm(ks[19], (DEPTH, HEAD_DIM), 0.02),
        "w_br_hy": nrm(ks[20], (DEPTH, D_HYENA, D_MODEL), D_HYENA ** -0.5),
        "w_br_attn": nrm(ks[21], (DEPTH, N_Q_COLS, D_MODEL), N_Q_COLS ** -0.5),
        "w_out": nrm(ks[22], (DEPTH, D_MODEL, D_MODEL), BETA * D_MODEL ** -0.5),
        "ffb_w13": nrm(ks[23], (DEPTH, D_MODEL, 2 * D_FF), D_MODEL ** -0.5),
        "ffb_w2": nrm(ks[24], (DEPTH, D_FF, D_MODEL), BETA * D_FF ** -0.5),
    }


def reference(x_prompt, x_sample, meta_tokens, ln_g, ln_b, ffa_w13, ffa_w2, w_in, b_gate, hy_conv_w,
              hy_conv_b, filt_w1, filt_b1, filt_freq, filt_w2, filt_b2, filt_w3, hy_skip, q_norm, k_norm,
              w_br_hy, w_br_attn, w_out, ffb_w13, ffb_w2):
    params = (meta_tokens, ln_g, ln_b, ffa_w13, ffa_w2, w_in, b_gate, hy_conv_w, hy_conv_b, filt_w1,
              filt_b1, filt_freq, filt_w2, filt_b2, filt_w3, hy_skip, q_norm, k_norm, w_br_hy,
              w_br_attn, w_out, ffb_w13, ffb_w2)
    y_prompt = _trunk(x_prompt, *params)
    y_sample = _trunk(x_sample, *params)
    return (y_prompt, y_sample)
```

```cpp
#ifndef REP_MASK
#define REP_MASK 0u
#endif
#include <hip/hip_runtime.h>
#include <cstdio>
#include <cstdint>
#include <math.h>

constexpr int DM = 2048, DEPTH = 4, NMETA = 16, DFF = 5632, NIN = 10240, DHY = 1024, HD = 128, NQH = 16, NKVH = 4;
constexpr int SP = 8192, SS = 4096, LP = SP + NMETA, LS = SS + NMETA;
constexpr int NTOK = 2 * LP + 2 * LS;
constexpr int MPAD = 24832;
constexpr int COL_Q = 3072, COL_K = 5120, COL_V = 5632, COL_G = 6144;
constexpr float LN_EPS = 1e-5f, QK_EPS = 1e-6f;
constexpr float ALPHA = 1.6817928305074290f;
constexpr int FILT_EMB = 33, FILT_W = 64;
__host__ __device__ __forceinline__ int seq_row0(int s) { return s == 0 ? 0 : (s == 1 ? LP : (s == 2 ? 2 * LP : 2 * LP + LS)); }
__host__ __device__ __forceinline__ int seq_len(int s) { return s < 2 ? LP : LS; }

constexpr size_t MiB = 1u << 20;
constexpr size_t al256(size_t x) { return (x + 255) / 256 * 256; }
constexpr size_t WS_CTL = 0, CTL_ZERO_BYTES = 1 * MiB;
constexpr size_t W13_E = (size_t)2 * DFF * DM, W2_E = (size_t)DM * DFF, WIN_E = (size_t)NIN * DM, WBH_E = (size_t)DM * DHY, WBA_E = (size_t)DM * DM, WOUT_E = (size_t)DM * DM;
constexpr size_t WS_W13A = 1 * MiB, WS_W2A = WS_W13A + 2 * W13_E, WS_WIN = WS_W2A + 2 * W2_E, WS_WBH = WS_WIN + 2 * WIN_E, WS_WBA = WS_WBH + 2 * WBH_E, WS_WOUT = WS_WBA + 2 * WBA_E,
                 WS_W13B = WS_WOUT + 2 * WOUT_E, WS_W2B = WS_W13B + 2 * W13_E, WS_WEND = WS_W2B + 2 * W2_E;
constexpr size_t WS_H32 = al256(WS_WEND);
constexpr size_t WS_HB = WS_H32 + (size_t)MPAD * DM * 4;
constexpr size_t WS_PROJ = WS_HB + (size_t)MPAD * DM * 2;
constexpr size_t WS_ZT = WS_PROJ + (size_t)MPAD * NIN * 2;
constexpr size_t ZT_E = (size_t)2 * DHY * LP + (size_t)2 * DHY * LS;
constexpr int DYC = DHY + DM;
constexpr size_t WS_YHY = al256(WS_ZT + ZT_E * 4);
constexpr size_t WS_YAT = WS_YHY + (size_t)MPAD * DHY * 2;
constexpr size_t WS_G = WS_YAT + (size_t)MPAD * DM * 2;
constexpr size_t WS_H2 = WS_G + (size_t)MPAD * DM * 2;
constexpr size_t WS_W3T = WS_H2 + (size_t)DEPTH * 2 * LP * FILT_W * 2;
static_assert((size_t)2 * DHY * (LP + LS) * 4 <= (size_t)MPAD * DM * 2, "taps fit in G");
constexpr int LPP = 130 * 64, LSP = 66 * 64;
constexpr size_t KC_E = (size_t)(2 * LPP + 2 * LSP) * NKVH * HD;
constexpr size_t WS_KC = al256(WS_W3T + (size_t)DEPTH * 2 * DHY * FILT_W * 2);
constexpr size_t WS_VC = WS_KC + KC_E * 2;
constexpr size_t WS_ST = al256(WS_VC + KC_E * 2);
constexpr int NSTAT = 1 + 3 * DEPTH;
constexpr size_t WS_CS = WS_ST + (size_t)NSTAT * MPAD * 2 * 8;
constexpr int NCS = 2 * DFF + NIN + 2 * DFF, CS_W13A = 0, CS_WIN = 2 * DFF, CS_W13B = 2 * DFF + NIN;
constexpr size_t WS_CB = WS_CS + (size_t)DEPTH * NCS * 8;
constexpr size_t WS_ONE = WS_CB + (size_t)DEPTH * NCS * 8;
constexpr size_t WS_END = WS_ONE + 2 * DM * 4;
__host__ __device__ __forceinline__ size_t kc_row(int s, int kvh) { return (s < 2 ? (size_t)s * NKVH * LPP + (size_t)kvh * LPP : (size_t)2 * NKVH * LPP + (size_t)(s - 2) * NKVH * LSP + (size_t)kvh * LSP); }
typedef _Float16 zt_t;
__host__ __device__ __forceinline__ size_t zt_off(int s) { return s == 0 ? 0 : (s == 1 ? (size_t)DHY * LP : (s == 2 ? (size_t)2 * DHY * LP : (size_t)2 * DHY * LP + (size_t)DHY * LS)); }
constexpr int CW_BAR = 4096;
constexpr int CW_Q = 16384;

constexpr int LDS_FFT_BYTES = (16384 + 16384 / 32) * 8;
constexpr int LDS_SIDE = LDS_FFT_BYTES;
constexpr int LDS_MISC = LDS_SIDE + 2048;
constexpr int LDS_BYTES = 147456;
static_assert(LDS_MISC + 256 <= LDS_BYTES, "LDS map");

#define GAS __attribute__((address_space(1)))
#define LAS __attribute__((address_space(3)))
typedef unsigned short bf16;
typedef unsigned v4u __attribute__((ext_vector_type(4)));
typedef unsigned v2u __attribute__((ext_vector_type(2)));
typedef float f32x4 __attribute__((ext_vector_type(4)));
typedef short bf16x8 __attribute__((ext_vector_type(8)));
#define LDS_WAIT() asm volatile("s_waitcnt lgkmcnt(0)" ::: "memory")
#define VM_WAIT() asm volatile("s_waitcnt vmcnt(0)" ::: "memory")
__device__ __forceinline__ unsigned pk2(float lo, float hi) { unsigned r; asm volatile("v_cvt_pk_bf16_f32 %0, %1, %2" : "=v"(r) : "v"(lo), "v"(hi)); return r; }
__device__ __forceinline__ unsigned f2bf(float f) { return pk2(f, 0.f) & 0xffffu; }
__device__ __forceinline__ float bf2f(unsigned short b) { return __builtin_bit_cast(float, ((unsigned)b) << 16); }
__device__ __forceinline__ float bflo(unsigned w) { return __builtin_bit_cast(float, w << 16); }
__device__ __forceinline__ float bfhi(unsigned w) { return __builtin_bit_cast(float, w & 0xffff0000u); }
__device__ __forceinline__ unsigned mix_issue(unsigned* qctr) {
    unsigned v = 0u; int t = threadIdx.x; asm volatile("" : "+v"(t));
    if (t == 0) v = __hip_atomic_fetch_add(qctr, 1u, __ATOMIC_RELAXED, __HIP_MEMORY_SCOPE_AGENT);
    return v;
}
template <int O> __device__ __forceinline__ float xshfl(float x) { return __builtin_bit_cast(float, __builtin_amdgcn_ds_swizzle(__builtin_bit_cast(int, x), (O << 10) | 0x1f)); }
__device__ __forceinline__ float xadd32(float x) {
    int l = (int)__builtin_amdgcn_mbcnt_hi(~0u, __builtin_amdgcn_mbcnt_lo(~0u, 0u)); asm volatile("" : "+v"(l));
    return x + __builtin_bit_cast(float, __builtin_amdgcn_ds_bpermute((l ^ 32) << 2, __builtin_bit_cast(int, x)));
}
__device__ __forceinline__ float wave_sum(float v) {
    v += xshfl<1>(v); v += xshfl<2>(v); v += xshfl<4>(v); v += xshfl<8>(v); v += xshfl<16>(v);
    return xadd32(v);
}
#ifdef __HIPCC__
#define FHD __host__ __device__ __forceinline__
#else
#define FHD inline
#endif

#if defined(__clang__)
typedef float cf __attribute__((ext_vector_type(2)));
FHD cf cmulc(cf a, cf b) { const cf t = a.xx * b; const cf s = a.yy * b.yx; cf r; r.x = t.x - s.x; r.y = t.y + s.y; return r; }
FHD cf cmul(cf a, cf b) {
#if defined(__HIP_DEVICE_COMPILE__)
    cf t, r;
    asm("v_pk_mul_f32 %0, %1, %2 op_sel:[0,0] op_sel_hi:[0,1]" : "=v"(t) : "v"(a), "v"(b));
    asm("v_pk_fma_f32 %0, %1, %2, %3 op_sel:[1,1,0] op_sel_hi:[1,0,1] neg_lo:[1,0,0]" : "=v"(r) : "v"(a), "v"(b), "v"(t));
    return r;
#else
    return cmulc(a, b);
#endif
}
FHD cf cadd(cf a, cf b) { return a + b; }
FHD cf csub(cf a, cf b) { return a - b; }
FHD cf cmulnegi(cf a) { cf r; r.x = a.y; r.y = -a.x; return r; }
#else
struct cf { float x, y; };
FHD cf cmul(cf a, cf b) { cf r; r.x = a.x * b.x - a.y * b.y; r.y = a.x * b.y + a.y * b.x; return r; }
FHD cf cadd(cf a, cf b) { cf r; r.x = a.x + b.x; r.y = a.y + b.y; return r; }
FHD cf csub(cf a, cf b) { cf r; r.x = a.x - b.x; r.y = a.y - b.y; return r; }
FHD cf cmulnegi(cf a) { cf r; r.x = a.y; r.y = -a.x; return r; }
#endif
FHD int fphys(int i) { return i + (i >> 5); }

FHD cf twid(float frac) {
    cf r;
#if defined(__HIP_DEVICE_COMPILE__)
    r.x = __builtin_amdgcn_cosf(frac); r.y = -__builtin_amdgcn_sinf(frac);
#else
    r.x = cosf(6.283185307179586f * frac); r.y = -sinf(6.283185307179586f * frac);
#endif
    return r;
}

FHD void dft4(cf& a0, cf& a1, cf& a2, cf& a3) {
    const cf s02 = cadd(a0, a2), d02 = csub(a0, a2), s13 = cadd(a1, a3), d13 = cmulnegi(csub(a1, a3));
    a0 = cadd(s02, s13); a2 = csub(s02, s13); a1 = cadd(d02, d13); a3 = csub(d02, d13);
}
template <int R> struct Dft;
template <> struct Dft<2> { static FHD void run(cf (&u)[2]) { const cf a = u[0], b = u[1]; u[0] = cadd(a, b); u[1] = csub(a, b); } };
template <> struct Dft<4> { static FHD void run(cf (&u)[4]) { dft4(u[0], u[1], u[2], u[3]); } };
template <> struct Dft<16> {
    static FHD void run(cf (&u)[16]) {
#pragma unroll
        for (int a = 0; a < 4; ++a) dft4(u[a], u[a + 4], u[a + 8], u[a + 12]);
        const float c1 = 0.92387953251128674f, s1 = 0.38268343236508978f, h = 0.70710678118654752f;
        const cf W1 = {c1, -s1}, W2 = {h, -h}, W3 = {s1, -c1}, W6 = {-h, -h}, W9 = {-c1, s1};
        u[1 + 4] = cmulc(u[1 + 4], W1); u[1 + 8] = cmulc(u[1 + 8], W2); u[1 + 12] = cmulc(u[1 + 12], W3);
        u[2 + 4] = cmulc(u[2 + 4], W2); u[2 + 8] = cmulnegi(u[2 + 8]);  u[2 + 12] = cmulc(u[2 + 12], W6);
        u[3 + 4] = cmulc(u[3 + 4], W3); u[3 + 8] = cmulc(u[3 + 8], W6); u[3 + 12] = cmulc(u[3 + 12], W9);
#pragma unroll
        for (int q = 0; q < 4; ++q) dft4(u[4 * q], u[4 * q + 1], u[4 * q + 2], u[4 * q + 3]);
#pragma unroll
        for (int q = 0; q < 4; ++q)
#pragma unroll
            for (int s = q + 1; s < 4; ++s) { const cf t = u[4 * q + s]; u[4 * q + s] = u[4 * s + q]; u[4 * s + q] = t; }
    }
};

FHD int launder(int t) {
#if defined(__HIP_DEVICE_COMPILE__)
    asm volatile("" : "+v"(t));
#endif
    return t;
}
template <int N, int R, int NT, int P> struct FPass {
    static constexpr int T = N / R, B = T / NT;
    static_assert(T % 32 == 0 && (P == 1 || P == 16 || P % 32 == 0), "offset algebra");
    static FHD void load(const cf* buf, int tid0, cf (&u)[B][R]) {
        const int tid = launder(tid0);
#pragma unroll
        for (int b = 0; b < B; ++b) { const cf* pb = buf + fphys(tid + b * NT);
#pragma unroll
            for (int r = 0; r < R; ++r) u[b][r] = pb[r * (T + T / 32)]; }
    }
    static FHD void compute(int tid0, cf (&u)[B][R]) {
        const int tid = launder(tid0);
#pragma unroll
        for (int b = 0; b < B; ++b) {
            const int i = tid + b * NT, k = i & (P - 1);
            if (P > 1) {
                cf w1 = twid((float)k * (1.0f / (float)(P * R)));
#if defined(__HIP_DEVICE_COMPILE__)
                { float one = 1.0f; asm volatile("" : "+v"(one)); w1 = w1 * one; }
#endif
                cf w = w1;
#pragma unroll
                for (int r = 1; r < R; ++r) { u[b][r] = cmul(u[b][r], w); if (r + 1 < R) w = cmul(w, w1); }
            }
            Dft<R>::run(u[b]);
        }
    }
    static FHD void store(cf* buf, int tid0, const cf (&u)[B][R]) {
        const int tid = launder(tid0);
#pragma unroll
        for (int b = 0; b < B; ++b) {
            const int i = tid + b * NT, k = i & (P - 1), j = (i - k) * R + k;
            cf* q = buf + fphys(j);
            if (P == 1) {
#pragma unroll
                for (int r = 0; r < R; ++r) q[r] = u[b][r];
            } else if (P == 16) {
                cf* qo = q + ((j >> 4) & 1);
#pragma unroll
                for (int r = 0; r < R; ++r) { if (r & 1) qo[16 * r + (r >> 1)] = u[b][r]; else q[16 * r + (r >> 1)] = u[b][r]; }
            } else {
#pragma unroll
                for (int r = 0; r < R; ++r) q[r * (P + P / 32)] = u[b][r];
            }
        }
    }
};
namespace pg8 {
#define PG8_LAS __attribute__((address_space(3)))
typedef unsigned short bf16_t;
typedef short bf16x8 __attribute__((ext_vector_type(8)));
typedef _Float16 f16x8 __attribute__((ext_vector_type(8)));
typedef float f32x4 __attribute__((ext_vector_type(4)));
typedef unsigned u32x4 __attribute__((ext_vector_type(4)));
constexpr int NCS_STRIDE = 2 * 5632 + 10240 + 2 * 5632;
constexpr int BM = 256, BK = 64, HALF = 128, HTB = HALF * BK * 2  , STAGE_BYTES = 8 * HTB, NXCD = 8;

__host__ __device__ __forceinline__ int lds_byte(int r, int c) { const int st = (r >> 4) * 2 + (c >> 5), rr = r & 15, cc = c & 31, ob = rr * 64 + cc * 2; return st * 1024 + (ob ^ (((ob >> 9) & 1) << 5)); }
__host__ __device__ __forceinline__ void stage_rc(int b, int& R, int& C) { const int st = b / 1024, sb = b % 1024, swz = sb ^ (((sb >> 9) & 1) << 5); R = (st >> 1) * 16 + swz / 64; C = (st & 1) * 32 + (swz % 64) / 2; }
__host__ __device__ __forceinline__ int perm32(int rho) { const int n = rho >> 4, i = rho & 15; return 8 * (i >> 2) + 4 * n + (i & 3); }

struct Unit { int pm, pn; };
struct Gemm { const bf16_t* A; const bf16_t* Bt; int M, N, K; };

struct StaticOrder {
    int nM, nN, nwg, G, c, WGM, rev;
    __host__ __device__ void init(int M, int N, int G_, int c_, int wgm = 8, int rev_ = 0) { nM = M / BM; nN = N / BM; nwg = nM * nN; G = G_; c = c_; WGM = wgm; rev = rev_; }
    __host__ __device__ bool next(int i, Unit& u) const {
        const int L = i * G + c; if (L >= nwg) return false;
        int wgid = L; { const int q = nwg / NXCD, r = nwg % NXCD, xcd = wgid % NXCD, off = wgid / NXCD; wgid = (xcd < r ? xcd * (q + 1) : r * (q + 1) + (xcd - r) * q) + off; }
        const int nig = WGM * nN, gid = wgid / nig, fm = gid * WGM, gsz = (nM - fm) < WGM ? (nM - fm) : WGM;
        u.pm = fm + ((wgid % nig) % gsz); u.pn = (wgid % nig) / gsz; if (rev) u.pm = nM - 1 - u.pm; return true;
    }
    __device__ __forceinline__ void a_ready(const Unit&) const {}
    __device__ __forceinline__ void done(const Unit&) const {}
};


__device__ __forceinline__ unsigned cvt_pk_bf16(float lo, float hi) { unsigned r; asm volatile("v_cvt_pk_bf16_f32 %0, %1, %2" : "=v"(r) : "v"(lo), "v"(hi)); return r; }
typedef float f32x2 __attribute__((ext_vector_type(2)));
__device__ __forceinline__ float ubf_lo(unsigned w) { return __builtin_bit_cast(float, w << 16); }
__device__ __forceinline__ float ubf_hi(unsigned w) { return __builtin_bit_cast(float, w & 0xffff0000u); }
__device__ __forceinline__ float silu_f(float x) { return x * __builtin_amdgcn_rcpf(1.0f + __builtin_amdgcn_exp2f(-1.4426950408889634f * x)); }
__device__ __forceinline__ float sigm_f(float x) { return __builtin_amdgcn_rcpf(1.0f + __builtin_amdgcn_exp2f(-1.4426950408889634f * x)); }

constexpr float STAT_SCALE = 1048576.0f, STAT_INV = 1.0f / 1048576.0f;
__device__ __forceinline__ f32x4 cs_load4(const float* p) { return *(const f32x4*)p + *(const f32x4*)(p + NCS_STRIDE); }
__device__ __forceinline__ void stat_add(float* Sn, int row, float ps, float pq) {
    long long* p = (long long*)Sn + 2 * (size_t)row;
    __hip_atomic_fetch_add(p, (long long)__builtin_rintf(ps * STAT_SCALE), __ATOMIC_RELAXED, __HIP_MEMORY_SCOPE_AGENT); __hip_atomic_fetch_add(p + 1, (long long)__builtin_rintf(pq * STAT_SCALE), __ATOMIC_RELAXED, __HIP_MEMORY_SCOPE_AGENT);
}
__device__ __forceinline__ void stat_mr(long long s1i, long long s2i, float& rstd, float& mr) {
    const float mean = (float)s1i * (STAT_INV / 2048.0f); float var = (float)s2i * (STAT_INV / 2048.0f) - mean * mean; var = var < 0.f ? 0.f : var;
    rstd = __builtin_amdgcn_rsqf(var + 1e-5f); mr = mean * rstd;
}
__device__ __forceinline__ void row_mr(const float* S, int row, float& rstd, float& mr) {
    const long long* p = (const long long*)S + 2 * (size_t)row; stat_mr(p[0], p[1], rstd, mr);
}
__device__ __forceinline__ void rows_mr(const float* S, int row0, float (&rstd)[2][4], float (&mr)[2][4]) {
    typedef long long i64x2 __attribute__((ext_vector_type(2)));
#pragma unroll
    for (int ai = 0; ai < 2; ++ai)
#pragma unroll
        for (int m = 0; m < 4; ++m) { const i64x2 st = *(const i64x2*)((const long long*)S + 2 * (size_t)(row0 + ai * HALF + m * 16)); stat_mr(st[0], st[1], rstd[ai][m], mr[ai][m]); }
}
struct EpiSwiglu {
    static constexpr bool PERM = true, AFTER_DRAIN = false; static constexpr int HOOK_T = 0;
    bf16_t* O; int ldc; const float* S; const float* cs; const float* cb;
    __device__ __forceinline__ void operator()(const f32x4 (&acc)[2][2][4][2], const Unit& u, int wr, int wc, int fr, int fq) const {
        const int row0 = u.pm * BM + wr * 64 + fr, col0 = u.pn * HALF + wc * 32 + 8 * fq, wcol0 = u.pn * BM + wc * 32 + 8 * fq;
        f32x4 csv[2][2], cbv[2][2]; float rstdv[2][4], mrv[2][4]; rows_mr(S, row0, rstdv, mrv);
        constexpr float KG = -1.4426950408889634f, KU = -0.6931471805599453f;
#pragma unroll
        for (int bj = 0; bj < 2; ++bj)
#pragma unroll
            for (int n = 0; n < 2; ++n) { csv[bj][n] = cs_load4(cs + wcol0 + bj * HALF + 4 * n); cbv[bj][n] = cs_load4(cb + wcol0 + bj * HALF + 4 * n) * (bj ? KU : KG); }
#pragma unroll
        for (int ai = 0; ai < 2; ++ai)
#pragma unroll
            for (int m = 0; m < 4; ++m) { const int row = row0 + ai * HALF + m * 16; const float rg = rstdv[ai][m] * KG, ru = rstdv[ai][m] * KU, ng = -mrv[ai][m] * KG, nu = -mrv[ai][m] * KU;
                bf16_t* rowp = O + (size_t)row * ldc + col0;
                const f32x4 g0 = acc[ai][0][m][0] * rg + (csv[0][0] * ng + cbv[0][0]), g1 = acc[ai][0][m][1] * rg + (csv[0][1] * ng + cbv[0][1]);
                const f32x4 u0 = acc[ai][1][m][0] * ru + (csv[1][0] * nu + cbv[1][0]), u1 = acc[ai][1][m][1] * ru + (csv[1][1] * nu + cbv[1][1]);
#define SWG(G, U) ((G) * (U) * __builtin_amdgcn_rcpf(1.0f + __builtin_amdgcn_exp2f(G)))
                u32x4 w; w.x = cvt_pk_bf16(SWG(g0[0], u0[0]), SWG(g0[1], u0[1])); w.y = cvt_pk_bf16(SWG(g0[2], u0[2]), SWG(g0[3], u0[3]));
                w.z = cvt_pk_bf16(SWG(g1[0], u1[0]), SWG(g1[1], u1[1])); w.w = cvt_pk_bf16(SWG(g1[2], u1[2]), SWG(g1[3], u1[3]));
#undef SWG
                *(u32x4*)rowp = w; }
    }
};
typedef _Float16 f16x2 __attribute__((ext_vector_type(2)));
__device__ __forceinline__ unsigned pk_f16(float lo, float hi) { unsigned a, b; asm volatile("v_cvt_f16_f32 %0, %1" : "=v"(a) : "v"(lo)); asm volatile("v_cvt_f16_f32 %0, %1" : "=v"(b) : "v"(hi)); return (a & 0xffffu) | (b << 16); }
__device__ __forceinline__ float f16_lo(unsigned w) { return (float)__builtin_bit_cast(f16x2, w)[0]; }
__device__ __forceinline__ float f16_hi(unsigned w) { return (float)__builtin_bit_cast(f16x2, w)[1]; }
struct EpiResid {
    static constexpr bool PERM = true, AFTER_DRAIN = false; static constexpr int HOOK_T = 0;
    bf16_t* R; bf16_t* RB; int ldc; float alpha, s; const float* So; const float* go; const float* bo; float* Sn;
    __device__ __forceinline__ void operator()(const f32x4 (&acc)[2][2][4][2], const Unit& u, int wr, int wc, int fr, int fq) const {
        const int row0 = u.pm * BM + wr * 64 + fr, col0 = u.pn * BM + wc * 32 + 8 * fq;
        f32x4 gv[2][2], bv[2][2]; float rstdv[2][4], mrv[2][4]; rows_mr(So, row0, rstdv, mrv);
#pragma unroll
        for (int bj = 0; bj < 2; ++bj)
#pragma unroll
            for (int n = 0; n < 2; ++n) { gv[bj][n] = *(const f32x4*)(go + col0 + bj * HALF + 4 * n); bv[bj][n] = *(const f32x4*)(bo + col0 + bj * HALF + 4 * n); }
#pragma unroll
        for (int ai = 0; ai < 2; ++ai)
#pragma unroll
            for (int m = 0; m < 4; ++m) { const int row = row0 + ai * HALF + m * 16; const float rstd = rstdv[ai][m], mr = mrv[ai][m];
                const unsigned off = (unsigned)(row * ldc + col0) * 2u; char* rowp = (char*)R + off; char* rbp = (char*)RB + off; float ps = 0.f, pq = 0.f;
#pragma unroll
                for (int bj = 0; bj < 2; ++bj) { const u32x4 hw = *(const u32x4*)(rowp + bj * HALF * 2);
                    const f32x4 h0 = {f16_lo(hw.x), f16_hi(hw.x), f16_lo(hw.y), f16_hi(hw.y)}, h1 = {f16_lo(hw.z), f16_hi(hw.z), f16_lo(hw.w), f16_hi(hw.w)};
                    const f32x4 r0 = ((h0 * rstd - mr) * gv[bj][0] + bv[bj][0]) * alpha + acc[ai][bj][m][0] * s, r1 = ((h1 * rstd - mr) * gv[bj][1] + bv[bj][1]) * alpha + acc[ai][bj][m][1] * s;
                    u32x4 w; w.x = pk_f16(r0[0], r0[1]); w.y = pk_f16(r0[2], r0[3]); w.z = pk_f16(r1[0], r1[1]); w.w = pk_f16(r1[2], r1[3]);
                    *(u32x4*)(rowp + bj * HALF * 2) = w;
                    if (RB) { u32x4 wb; wb.x = cvt_pk_bf16(r0[0], r0[1]); wb.y = cvt_pk_bf16(r0[2], r0[3]); wb.z = cvt_pk_bf16(r1[0], r1[1]); wb.w = cvt_pk_bf16(r1[2], r1[3]);
                        *(u32x4*)(rbp + bj * HALF * 2) = wb; }
                    ps += ((r0[0] + r0[1]) + (r0[2] + r0[3])) + ((r1[0] + r1[1]) + (r1[2] + r1[3]));
                    pq += ((r0[0] * r0[0] + r0[1] * r0[1]) + (r0[2] * r0[2] + r0[3] * r0[3])) + ((r1[0] * r1[0] + r1[1] * r1[1]) + (r1[2] * r1[2] + r1[3] * r1[3])); }
                ps += ::xshfl<16>(ps); ps = ::xadd32(ps); pq += ::xshfl<16>(pq); pq = ::xadd32(pq);
                if (fq == 0) stat_add(Sn, row, ps, pq);
                asm volatile("" ::: "memory"); }
    }
    __device__ __forceinline__ void tail(int row, int col, float s0, float s1) const {
        float rstd, mr; row_mr(So, row, rstd, mr);
        const unsigned hw = *(const unsigned*)(R + (size_t)row * ldc + col);
        const float r0 = ((f16_lo(hw) * rstd - mr) * go[col] + bo[col]) * alpha + s0 * s, r1 = ((f16_hi(hw) * rstd - mr) * go[col + 1] + bo[col + 1]) * alpha + s1 * s;
        *(unsigned*)(R + (size_t)row * ldc + col) = pk_f16(r0, r1); if (RB) *(unsigned*)(RB + (size_t)row * ldc + col) = cvt_pk_bf16(r0, r1);
        float ps = r0 + r1, pq = r0 * r0 + r1 * r1;
        ps += ::xshfl<1>(ps); ps += ::xshfl<2>(ps); ps += ::xshfl<4>(ps); pq += ::xshfl<1>(pq); pq += ::xshfl<2>(pq); pq += ::xshfl<4>(pq);
        if ((threadIdx.x & 7) == 0) stat_add(Sn, row, ps, pq);
    }
};
struct EpiProj {
    static constexpr bool PERM = true, AFTER_DRAIN = false; static constexpr int HOOK_T = 0;
    bf16_t* O; int ldc; const float* bias; int gate_col0; const float* S; const float* cs; const float* cb;
    __device__ __forceinline__ void operator()(const f32x4 (&acc)[2][2][4][2], const Unit& u, int wr, int wc, int fr, int fq) const {
        const int row0 = u.pm * BM + wr * 64 + fr, col0 = u.pn * BM + wc * 32 + 8 * fq;
        const bool gate = (u.pn * BM >= gate_col0);
        f32x4 csv[2][2], cbv[2][2]; float rstdv[2][4], mrv[2][4]; rows_mr(S, row0, rstdv, mrv);
#pragma unroll
        for (int bj = 0; bj < 2; ++bj)
#pragma unroll
            for (int n = 0; n < 2; ++n) { csv[bj][n] = cs_load4(cs + col0 + bj * HALF + 4 * n); cbv[bj][n] = cs_load4(cb + col0 + bj * HALF + 4 * n);
                if (gate) cbv[bj][n] += *(const f32x4*)(bias + (col0 - gate_col0) + bj * HALF + 4 * n); }
#pragma unroll
        for (int ai = 0; ai < 2; ++ai)
#pragma unroll
            for (int m = 0; m < 4; ++m) { const int row = row0 + ai * HALF + m * 16; const float rstd = rstdv[ai][m], mr = mrv[ai][m];
                bf16_t* rowp = O + (size_t)row * ldc + col0;
#pragma unroll
                for (int bj = 0; bj < 2; ++bj) { f32x4 v0 = acc[ai][bj][m][0] * rstd - csv[bj][0] * mr + cbv[bj][0], v1 = acc[ai][bj][m][1] * rstd - csv[bj][1] * mr + cbv[bj][1];
                    if (gate) {
#pragma unroll
                        for (int j = 0; j < 4; ++j) { v0[j] = sigm_f(v0[j]); v1[j] = sigm_f(v1[j]); } }
                    u32x4 w; w.x = cvt_pk_bf16(v0[0], v0[1]); w.y = cvt_pk_bf16(v0[2], v0[3]); w.z = cvt_pk_bf16(v1[0], v1[1]); w.w = cvt_pk_bf16(v1[2], v1[3]);
                    *(u32x4*)(rowp + bj * HALF) = w; } }
    }
};
__device__ __forceinline__ void epiproj_tail(const EpiProj& E, int row, int col, float s0, float s1) {
    float rstd, mr; row_mr(E.S, row, rstd, mr);
    float c0 = E.cs[col] + E.cs[col + NCS_STRIDE], c1 = E.cs[col + 1] + E.cs[col + 1 + NCS_STRIDE], b0 = E.cb[col] + E.cb[col + NCS_STRIDE], b1 = E.cb[col + 1] + E.cb[col + 1 + NCS_STRIDE];
    float v0 = s0 * rstd - c0 * mr + b0, v1 = s1 * rstd - c1 * mr + b1;
    if (col >= E.gate_col0) { v0 = sigm_f(v0 + E.bias[col - E.gate_col0]); v1 = sigm_f(v1 + E.bias[col + 1 - E.gate_col0]); }
    *(unsigned*)(E.O + (size_t)row * E.ldc + col) = cvt_pk_bf16(v0, v1);
}
struct EpiProjTail { const EpiProj& E; __device__ __forceinline__ void tail(int row, int col, float s0, float s1) const { epiproj_tail(E, row, col, s0, s1); } };
struct EpiGate2 {
    static constexpr bool PERM = true, AFTER_DRAIN = false; static constexpr int HOOK_T = DHY / BK;
    bf16_t* G; int ldc; const bf16_t* Gate; int ldg;
    static __device__ __forceinline__ float gcl(float g) { return g < 1e-30f ? 1e-30f : g; }
    __device__ __forceinline__ void mid(f32x4 (&acc)[2][2][4][2], const Unit& u, int wr, int wc, int fr, int fq) const {
        const int row0 = u.pm * BM + wr * 64 + fr, col0 = u.pn * BM + wc * 32 + 8 * fq;
#pragma unroll
        for (int ai = 0; ai < 2; ++ai)
#pragma unroll
          for (int mp = 0; mp < 2; ++mp) {
            u32x4 hv[2][2], av[2][2];
#pragma unroll
            for (int mm = 0; mm < 2; ++mm) { const bf16_t* gp = Gate + (size_t)(row0 + ai * HALF + (2 * mp + mm) * 16) * ldg + col0;
#pragma unroll
                for (int bj = 0; bj < 2; ++bj) { hv[mm][bj] = *(const u32x4*)(gp + bj * HALF); av[mm][bj] = *(const u32x4*)(gp + DM + bj * HALF); } }
#pragma unroll
            for (int mm = 0; mm < 2; ++mm) { const int m = 2 * mp + mm;
#pragma unroll
                for (int bj = 0; bj < 2; ++bj) { const u32x4 h = hv[mm][bj], a = av[mm][bj];
                    const f32x4 r0 = {ubf_lo(h.x) * __builtin_amdgcn_rcpf(gcl(ubf_lo(a.x))), ubf_hi(h.x) * __builtin_amdgcn_rcpf(gcl(ubf_hi(a.x))), ubf_lo(h.y) * __builtin_amdgcn_rcpf(gcl(ubf_lo(a.y))), ubf_hi(h.y) * __builtin_amdgcn_rcpf(gcl(ubf_hi(a.y)))};
                    const f32x4 r1 = {ubf_lo(h.z) * __builtin_amdgcn_rcpf(gcl(ubf_lo(a.z))), ubf_hi(h.z) * __builtin_amdgcn_rcpf(gcl(ubf_hi(a.z))), ubf_lo(h.w) * __builtin_amdgcn_rcpf(gcl(ubf_lo(a.w))), ubf_hi(h.w) * __builtin_amdgcn_rcpf(gcl(ubf_hi(a.w)))};
                    acc[ai][bj][m][0] *= r0; acc[ai][bj][m][1] *= r1; } }
            asm volatile("" ::: "memory"); }
    }
    __device__ __forceinline__ void operator()(const f32x4 (&acc)[2][2][4][2], const Unit& u, int wr, int wc, int fr, int fq) const {
        const int row0 = u.pm * BM + wr * 64 + fr, col0 = u.pn * BM + wc * 32 + 8 * fq;
#pragma unroll
        for (int ai = 0; ai < 2; ++ai) {
            u32x4 av[4][2];
#pragma unroll
            for (int m = 0; m < 4; ++m)
#pragma unroll
                for (int bj = 0; bj < 2; ++bj) av[m][bj] = *(const u32x4*)(Gate + (size_t)(row0 + ai * HALF + m * 16) * ldg + col0 + DM + bj * HALF);
#pragma unroll
            for (int m = 0; m < 4; ++m) { bf16_t* rowp = G + (size_t)(row0 + ai * HALF + m * 16) * ldc + col0;
#pragma unroll
                for (int bj = 0; bj < 2; ++bj) { const u32x4 a = av[m][bj]; const f32x4 a0 = acc[ai][bj][m][0], a1 = acc[ai][bj][m][1];
                    u32x4 w; w.x = cvt_pk_bf16(gcl(ubf_lo(a.x)) * a0[0], gcl(ubf_hi(a.x)) * a0[1]); w.y = cvt_pk_bf16(gcl(ubf_lo(a.y)) * a0[2], gcl(ubf_hi(a.y)) * a0[3]);
                    w.z = cvt_pk_bf16(gcl(ubf_lo(a.z)) * a1[0], gcl(ubf_hi(a.z)) * a1[1]); w.w = cvt_pk_bf16(gcl(ubf_lo(a.w)) * a1[2], gcl(ubf_hi(a.w)) * a1[3]);
                    *(u32x4*)(rowp + bj * HALF) = w; } }
            asm volatile("" ::: "memory"); }
    }
    __device__ __forceinline__ void tail(int row, int col, float h0, float h1, float a0, float a1) const {
        const unsigned gh = *(const unsigned*)(Gate + (size_t)row * ldg + col), ga = *(const unsigned*)(Gate + (size_t)row * ldg + col + DM);
        *(unsigned*)(G + (size_t)row * ldc + col) = cvt_pk_bf16(ubf_lo(gh) * h0 + ubf_lo(ga) * a0, ubf_hi(gh) * h1 + ubf_hi(ga) * a1);
    }
};
template <class Epi, class Sched, bool ALIGN_EPI = false, bool SP2 = false, bool F16 = false  >
__device__ __forceinline__ void gemm_phase(PG8_LAS unsigned char* lds, const Gemm g, const Sched& S, const Epi& E) {
    int tid_ = threadIdx.x; asm volatile("" : "+v"(tid_));
    const int tid = tid_, wid = __builtin_amdgcn_readfirstlane(tid >> 6), lane = tid & 63, wr = wid >> 2, wc = wid & 3, fr = lane & 15, fq = lane >> 4;
    const int K = g.K, nt = K / BK;
    unsigned voffA[2], voffB[2]; int aoff, boff;
    auto lane_offsets = [&](int t) {
        const int l = t & 63;
#pragma unroll
        for (int i = 0; i < 2; ++i) { int R, C; stage_rc(t * 16 + i * 8192, R, C); const int Rb = Epi::PERM ? ((R & ~31) + perm32(R & 31)) : R;
            voffA[i] = (unsigned)(R * K + C) * 2u; voffB[i] = (unsigned)(Rb * K + C) * 2u; }
        aoff = lds_byte(wr * 64 + (l & 15), (l >> 4) * 8); boff = lds_byte(wc * 32 + (l & 15), (l >> 4) * 8); };
    lane_offsets(tid);
    const size_t kstep = (size_t)(BK * 2);
    const size_t hstep = (size_t)HALF * K * 2;
    const size_t tstep = 2 * hstep;
    const unsigned ldsw = (unsigned)wid * 1024u;
#define PG8_SA(b, h) (((b) * 2 + (h)) * HTB)
#define PG8_SB(b, h) ((4 + (b) * 2 + (h)) * HTB)
#define PG8_STAGE(bufoff, gbase, voff) do { _Pragma("unroll") for (int _i = 0; _i < 2; ++_i) \
        __builtin_amdgcn_global_load_lds((const unsigned*)((const char*)(gbase) + (voff)[_i]), (PG8_LAS unsigned*)(lds + (bufoff) + ldsw + _i * 8192), 16, 0, 0); } while (0)
#define PG8_LDA(dst, b, h) do { _Pragma("unroll") for (int m = 0; m < 4; ++m) _Pragma("unroll") for (int k = 0; k < 2; ++k) dst[m][k] = *(const PG8_LAS bf16x8*)(lds + PG8_SA(b, h) + aoff + m * 2048 + k * 1024); } while (0)
#define PG8_LDB(dst, b, h) do { _Pragma("unroll") for (int n = 0; n < 2; ++n) _Pragma("unroll") for (int k = 0; k < 2; ++k) dst[n][k] = *(const PG8_LAS bf16x8*)(lds + PG8_SB(b, h) + boff + n * 2048 + k * 1024); } while (0)
#define PG8_MMA(ai, bj, At, Bt) do { __builtin_amdgcn_s_setprio(1); _Pragma("unroll") for (int m = 0; m < 4; ++m) _Pragma("unroll") for (int n = 0; n < 2; ++n) _Pragma("unroll") for (int k = 0; k < 2; ++k) \
        acc[ai][bj][m][n] = F16 ? __builtin_amdgcn_mfma_f32_16x16x32_f16(__builtin_bit_cast(f16x8, Bt[n][k]), __builtin_bit_cast(f16x8, At[m][k]), acc[ai][bj][m][n], 0, 0, 0) \
                                : __builtin_amdgcn_mfma_f32_16x16x32_bf16(Bt[n][k], At[m][k], acc[ai][bj][m][n], 0, 0, 0); __builtin_amdgcn_s_setprio(0); } while (0)
#define PG8_WAIT_V(n) asm volatile("s_waitcnt vmcnt(" #n ")" ::: "memory")
#define PG8_WAIT_L(n) asm volatile("s_waitcnt lgkmcnt(" #n ")" ::: "memory")
#define PG8_BAR __builtin_amdgcn_s_barrier()
#define PG8_SCHED __builtin_amdgcn_sched_barrier(0)
    Unit cur, nxt; int ui = 0;
    if (!S.next(0, cur)) return;
    f32x4 acc[2][2][4][2];
#pragma unroll
    for (int a = 0; a < 2; ++a)
#pragma unroll
        for (int b = 0; b < 2; ++b)
#pragma unroll
            for (int m = 0; m < 4; ++m)
#pragma unroll
                for (int n = 0; n < 2; ++n) acc[a][b][m][n] = (f32x4){0.f, 0.f, 0.f, 0.f};
    bf16x8 At[4][2], B0[2][2], B1[2][2];
    const char* cA = (const char*)g.A + (size_t)cur.pm * tstep; const char* cB = (const char*)g.Bt + (size_t)cur.pn * tstep;
    S.a_ready(cur);
    if constexpr (SP2) {
        PG8_STAGE(PG8_SB(0, 0), cB, voffB); PG8_STAGE(PG8_SB(0, 1), cB + hstep, voffB); PG8_STAGE(PG8_SA(0, 0), cA, voffA); PG8_STAGE(PG8_SA(0, 1), cA + hstep, voffA);
        if (wr == 1) PG8_BAR;
        PG8_WAIT_V(2); PG8_BAR;
        PG8_STAGE(PG8_SB(1, 0), cB + kstep, voffB); PG8_STAGE(PG8_SA(1, 0), cA + kstep, voffA); PG8_STAGE(PG8_SB(1, 1), cB + hstep + kstep, voffB);
        PG8_WAIT_V(6); PG8_BAR;
    } else {
        PG8_STAGE(PG8_SB(0, 0), cB, voffB); PG8_STAGE(PG8_SA(0, 0), cA, voffA); PG8_STAGE(PG8_SB(0, 1), cB + hstep, voffB); PG8_STAGE(PG8_SA(0, 1), cA + hstep, voffA);
        if (wr == 1) PG8_BAR;
        PG8_WAIT_V(4); PG8_BAR;
        PG8_STAGE(PG8_SB(1, 0), cB + kstep, voffB); PG8_STAGE(PG8_SA(1, 0), cA + kstep, voffA); PG8_STAGE(PG8_SB(1, 1), cB + hstep + kstep, voffB);
        PG8_WAIT_V(6); PG8_BAR;
    }
    for (;;) {
        const bool has_next = S.next(ui + 1, nxt);
        const char* nA = has_next ? (const char*)g.A + (size_t)nxt.pm * tstep : cA; const char* nB = has_next ? (const char*)g.Bt + (size_t)nxt.pn * tstep : cB;
        for (int t = 0; t < nt; t += 2) {
            const bool last = (t == nt - 2);
            const char* a1 = cA + (size_t)(t + 1) * kstep;
            const char* a2 = last ? nA : cA + (size_t)(t + 2) * kstep; const char* b2 = last ? nB : cB + (size_t)(t + 2) * kstep;
            const char* a3 = a2 + kstep; const char* b3 = b2 + kstep;
            if (last && has_next) S.a_ready(nxt);
            if constexpr (Epi::HOOK_T > 0) { if (t == Epi::HOOK_T) { int lh; asm volatile("v_mbcnt_lo_u32_b32 %0, -1, 0\n\tv_mbcnt_hi_u32_b32 %0, -1, %0" : "=v"(lh));
                E.mid(acc, cur, wr, wc, lh & 15, lh >> 4); } }
            if constexpr (SP2) {
            PG8_LDB(B0, 0, 0); PG8_LDB(B1, 0, 1); PG8_SCHED; PG8_LDA(At, 0, 0); PG8_STAGE(PG8_SA(1, 1), a1 + hstep, voffA);
            PG8_WAIT_V(8); PG8_WAIT_L(0); PG8_BAR; PG8_MMA(0, 0, At, B0); PG8_MMA(0, 1, At, B1); PG8_BAR; PG8_SCHED;
            PG8_LDA(At, 0, 1); PG8_STAGE(PG8_SB(0, 0), b2, voffB); PG8_STAGE(PG8_SB(0, 1), b2 + hstep, voffB); PG8_STAGE(PG8_SA(0, 0), a2, voffA);
            PG8_WAIT_V(8); PG8_WAIT_L(0); PG8_BAR; PG8_MMA(1, 0, At, B0); PG8_MMA(1, 1, At, B1); PG8_BAR; PG8_SCHED;
            PG8_LDB(B0, 1, 0); PG8_LDB(B1, 1, 1); PG8_SCHED; PG8_LDA(At, 1, 0); PG8_STAGE(PG8_SA(0, 1), a2 + hstep, voffA);
            PG8_WAIT_V(8); PG8_WAIT_L(0); PG8_BAR; PG8_MMA(0, 0, At, B0); PG8_MMA(0, 1, At, B1); PG8_BAR; PG8_SCHED;
            PG8_LDA(At, 1, 1); PG8_STAGE(PG8_SB(1, 0), b3, voffB); PG8_STAGE(PG8_SB(1, 1), b3 + hstep, voffB); PG8_STAGE(PG8_SA(1, 0), a3, voffA);
            PG8_WAIT_V(8); PG8_WAIT_L(0); PG8_BAR; PG8_MMA(1, 0, At, B0); PG8_MMA(1, 1, At, B1); PG8_BAR; PG8_SCHED;
            } else {
            PG8_LDB(B0, 0, 0); PG8_SCHED; PG8_LDA(At, 0, 0); PG8_STAGE(PG8_SA(1, 1), a1 + hstep, voffA);
            PG8_WAIT_L(8); PG8_BAR; PG8_WAIT_L(0); PG8_MMA(0, 0, At, B0); PG8_BAR; PG8_SCHED;
            PG8_LDB(B1, 0, 1); PG8_STAGE(PG8_SB(0, 0), b2, voffB);
            PG8_BAR; PG8_WAIT_L(0); PG8_MMA(0, 1, At, B1); PG8_BAR;
            PG8_LDA(At, 0, 1); PG8_STAGE(PG8_SA(0, 0), a2, voffA);
            PG8_BAR; PG8_WAIT_L(0); PG8_MMA(1, 0, At, B0); PG8_BAR; PG8_SCHED;
            PG8_STAGE(PG8_SB(0, 1), b2 + hstep, voffB);
            PG8_WAIT_V(6); PG8_BAR; PG8_MMA(1, 1, At, B1); PG8_BAR;
            PG8_LDB(B0, 1, 0); PG8_SCHED; PG8_LDA(At, 1, 0); PG8_STAGE(PG8_SA(0, 1), a2 + hstep, voffA);
            PG8_WAIT_L(8); PG8_BAR; PG8_WAIT_L(0); PG8_MMA(0, 0, At, B0); PG8_BAR; PG8_SCHED;
            PG8_LDB(B1, 1, 1); PG8_STAGE(PG8_SB(1, 0), b3, voffB);
            PG8_BAR; PG8_WAIT_L(0); PG8_MMA(0, 1, At, B1); PG8_BAR;
            PG8_LDA(At, 1, 1); PG8_STAGE(PG8_SA(1, 0), a3, voffA);
            PG8_BAR; PG8_WAIT_L(0); PG8_MMA(1, 0, At, B0); PG8_BAR; PG8_SCHED;
            PG8_STAGE(PG8_SB(1, 1), b3 + hstep, voffB);
            PG8_WAIT_V(6); PG8_BAR; PG8_MMA(1, 1, At, B1); PG8_BAR;
            }
        }
        if constexpr (ALIGN_EPI) { if (wr == 0) PG8_BAR; }
        if constexpr (!Epi::AFTER_DRAIN) { int le; asm volatile("v_mbcnt_lo_u32_b32 %0, -1, 0\n\tv_mbcnt_hi_u32_b32 %0, -1, %0" : "=v"(le));
            E(acc, cur, wr, wc, le & 15, le >> 4); S.done(cur); }
        if (!has_next) break;
#pragma unroll
        for (int a = 0; a < 2; ++a)
#pragma unroll
            for (int b = 0; b < 2; ++b)
#pragma unroll
                for (int m = 0; m < 4; ++m)
#pragma unroll
                    for (int n = 0; n < 2; ++n) acc[a][b][m][n] = (f32x4){0.f, 0.f, 0.f, 0.f};
        cur = nxt; cA = nA; cB = nB; ++ui;
        { int l2; asm volatile("v_mbcnt_lo_u32_b32 %0, -1, 0\n\tv_mbcnt_hi_u32_b32 %0, -1, %0" : "=v"(l2)); lane_offsets(wid * 64 + l2); }
        if constexpr (ALIGN_EPI) { if (wr == 1) PG8_BAR; }
    }
    PG8_WAIT_V(0);
    if constexpr (!ALIGN_EPI) { if (wr == 0) PG8_BAR; }
    PG8_BAR;
    if constexpr (Epi::AFTER_DRAIN) { E.fused(acc, cur, wr, wc, fr, fq, lds, wid, lane); S.done(cur); }
#undef PG8_SA
#undef PG8_SB
#undef PG8_STAGE
#undef PG8_LDA
#undef PG8_LDB
#undef PG8_MMA
#undef PG8_WAIT_V
#undef PG8_WAIT_L
#undef PG8_BAR
#undef PG8_SCHED
}
}

template <class TEpi>
__device__ __forceinline__ void gemm_tail(LAS unsigned char* lds, const bf16* A  , const bf16* Bt  , int N, int K, int R0, const TEpi& E, int G, int bid) {
    int tid_ = threadIdx.x; asm volatile("" : "+v"(tid_));
    const int tid = tid_, wave = __builtin_amdgcn_readfirstlane(tid >> 6), lane = tid & 63, fr = lane & 15, fq = lane >> 4, kw = K >> 3;
    LAS float* red = (LAS float*)lds;
    for (int nt = bid; nt < (N >> 4); nt += G) {
        f32x4 acc[4];
#pragma unroll
        for (int mt = 0; mt < 4; ++mt) acc[mt] = (f32x4){0.f, 0.f, 0.f, 0.f};
        const bf16* ap = A + (size_t)fr * K + wave * kw + fq * 8;
        const bf16* bp = Bt + (size_t)(nt * 16 + fr) * K + wave * kw + fq * 8;
#pragma unroll 4
        for (int k = 0; k < kw; k += 32) {
            const bf16x8 b = *(const bf16x8*)(bp + k);
#pragma unroll
            for (int mt = 0; mt < 4; ++mt) { const bf16x8 a = *(const bf16x8*)(ap + (size_t)(mt * 16) * K + k); acc[mt] = __builtin_amdgcn_mfma_f32_16x16x32_bf16(a, b, acc[mt], 0, 0, 0); }
        }
#pragma unroll
        for (int mt = 0; mt < 4; ++mt)
#pragma unroll
            for (int i = 0; i < 4; ++i) red[(wave * 64 + mt * 16 + fq * 4 + i) * 17 + fr] = acc[mt][i];
        __syncthreads();
        { const int m = tid >> 3, n2 = (tid & 7) * 2; float s0 = 0.f, s1 = 0.f;
#pragma unroll
          for (int w = 0; w < 8; ++w) { s0 += red[(w * 64 + m) * 17 + n2]; s1 += red[(w * 64 + m) * 17 + n2 + 1]; }
          E.tail(R0 + m, nt * 16 + n2, s0, s1); }
        __syncthreads();
    }
}

template <class TEpi>
__device__ __forceinline__ void gemm_tail2(LAS unsigned char* lds, const bf16* A  , const bf16* Bt  , int N, int K, int K1, int R0, const TEpi& E, int G, int bid) {
    int tid_ = threadIdx.x; asm volatile("" : "+v"(tid_));
    const int tid = tid_, wave = __builtin_amdgcn_readfirstlane(tid >> 6), lane = tid & 63, fr = lane & 15, fq = lane >> 4;
    LAS float* red = (LAS float*)lds;
    for (int nt = bid; nt < (N >> 4); nt += G) {
        float sv[2][2];
#pragma unroll
        for (int seg = 0; seg < 2; ++seg) {
            const int kb = seg ? K1 : 0, kw = (seg ? K - K1 : K1) >> 3;
            f32x4 acc[4];
#pragma unroll
            for (int mt = 0; mt < 4; ++mt) acc[mt] = (f32x4){0.f, 0.f, 0.f, 0.f};
            const bf16* ap = A + (size_t)fr * K + kb + wave * kw + fq * 8;
            const bf16* bp = Bt + (size_t)(nt * 16 + fr) * K + kb + wave * kw + fq * 8;
#pragma unroll 4
            for (int k = 0; k < kw; k += 32) {
                const bf16x8 b = *(const bf16x8*)(bp + k);
#pragma unroll
                for (int mt = 0; mt < 4; ++mt) { const bf16x8 a = *(const bf16x8*)(ap + (size_t)(mt * 16) * K + k); acc[mt] = __builtin_amdgcn_mfma_f32_16x16x32_bf16(a, b, acc[mt], 0, 0, 0); }
            }
#pragma unroll
            for (int mt = 0; mt < 4; ++mt)
#pragma unroll
                for (int i = 0; i < 4; ++i) red[(wave * 64 + mt * 16 + fq * 4 + i) * 17 + fr] = acc[mt][i];
            __syncthreads();
            { const int m = tid >> 3, n2 = (tid & 7) * 2; float s0 = 0.f, s1 = 0.f;
#pragma unroll
              for (int w = 0; w < 8; ++w) { s0 += red[(w * 64 + m) * 17 + n2]; s1 += red[(w * 64 + m) * 17 + n2 + 1]; }
              sv[seg][0] = s0; sv[seg][1] = s1; }
            __syncthreads();
        }
        E.tail(R0 + (tid >> 3), nt * 16 + (tid & 7) * 2, sv[0][0], sv[0][1], sv[1][0], sv[1][1]);
    }
}

namespace att {
#ifndef ATT_SDEPTH
#define ATT_SDEPTH 1
#endif
constexpr int D = 128, NW = 8, QBLK = 32, KVBLK = 64;
constexpr float SCALE = 0.088388347648318440f;
constexpr float THR = 8.f;
__device__ constexpr float ROTF[32] = {1.000000000e+00f, 7.498942093e-01f, 5.623413252e-01f, 4.216965034e-01f, 3.162277660e-01f, 2.371373706e-01f, 1.778279410e-01f, 1.333521432e-01f, 1.000000000e-01f, 7.498942093e-02f, 5.623413252e-02f, 4.216965034e-02f, 3.162277660e-02f, 2.371373706e-02f, 1.778279410e-02f, 1.333521432e-02f, 1.000000000e-02f, 7.498942093e-03f, 5.623413252e-03f, 4.216965034e-03f, 3.162277660e-03f, 2.371373706e-03f, 1.778279410e-03f, 1.333521432e-03f, 1.000000000e-03f, 7.498942093e-04f, 5.623413252e-04f, 4.216965034e-04f, 3.162277660e-04f, 2.371373706e-04f, 1.778279410e-04f, 1.333521432e-04f};
constexpr int LDQ = NIN, LDK = HD, LDV = NIN, LDO = DYC;
constexpr int KPITCH = D * 2 + 16;
constexpr size_t SHM_V = KVBLK * D * 2, SHM_K = KVBLK * KPITCH, SHM_ATTN = 2 * SHM_V + 2 * SHM_K + NW * 64 * 4;
using s16x4  = __attribute__((ext_vector_type(4))) short;
using f32x16 = __attribute__((ext_vector_type(16))) float;
#define KSWZ(row, colB) ((row) * KPITCH + (colB))
#define SBAR() __builtin_amdgcn_sched_barrier(0)
__device__ __forceinline__ int crow(int r, int hi) { return (r & 3) + 8 * (r >> 2) + 4 * hi; }
__device__ __forceinline__ unsigned cvtpk(float lo, float hi) { unsigned r; asm volatile("v_cvt_pk_bf16_f32 %0, %1, %2" : "=v"(r) : "v"(lo), "v"(hi)); return r; }

__device__ __forceinline__ void partialSM(f32x16& p0, f32x16& p1, float& m_reg, float& mn, float& alpha) {
  constexpr float C = SCALE * 1.4426950408889634f;
  float pmax = p0[0]; for (int r = 1; r < 16; ++r) pmax = fmaxf(pmax, p0[r]); for (int r = 0; r < 16; ++r) pmax = fmaxf(pmax, p1[r]);
  { auto rr = __builtin_amdgcn_permlane32_swap(__float_as_uint(pmax), __float_as_uint(pmax), false, false);
    pmax = fmaxf(__uint_as_float(rr[0]), __uint_as_float(rr[1])); }
  if (__builtin_expect(__all(pmax - m_reg <= THR / SCALE), 1)) { mn = m_reg; alpha = 1.f; }
  else { mn = fmaxf(m_reg, pmax); alpha = __builtin_amdgcn_exp2f((m_reg - mn) * C); m_reg = mn; }
  float mnC = -mn * C;
  for (int r = 0; r < 16; ++r) p0[r] = fmaf(p0[r], C, mnC); for (int r = 0; r < 16; ++r) p1[r] = fmaf(p1[r], C, mnC);
}
__device__ __forceinline__ void expP0(f32x16& p0) { for (int r = 0; r < 16; ++r) { float e = __builtin_amdgcn_exp2f(p0[r]); asm volatile("" : "+v"(e)); p0[r] = e; } }
__device__ __forceinline__ void finishSM(f32x16& p0, f32x16& p1, float alpha, float& l_reg, bf16x8& pa0, bf16x8& pa1, bf16x8& pa2, bf16x8& pa3) {
  for (int r = 0; r < 16; ++r) p1[r] = __builtin_amdgcn_exp2f(p1[r]);
  float ps = 0; for (int r = 0; r < 16; ++r) ps += p0[r]; for (int r = 0; r < 16; ++r) ps += p1[r];
  { auto rr = __builtin_amdgcn_permlane32_swap(__float_as_uint(ps), __float_as_uint(ps), false, false);
    ps = __uint_as_float(rr[0]) + __uint_as_float(rr[1]); }
  l_reg = l_reg * alpha + ps;
#define PK4(P, BASE, OUT) do { unsigned a0 = cvtpk(P[BASE + 0], P[BASE + 1]), a1 = cvtpk(P[BASE + 2], P[BASE + 3]);   \
    unsigned b0 = cvtpk(P[BASE + 4], P[BASE + 5]), b1 = cvtpk(P[BASE + 6], P[BASE + 7]);                              \
    auto r0 = __builtin_amdgcn_permlane32_swap(a0, b0, false, false); auto r1 = __builtin_amdgcn_permlane32_swap(a1, b1, false, false); \
    v4u w = {r0[0], r1[0], r0[1], r1[1]}; OUT = *reinterpret_cast<bf16x8*>(&w); } while (0)
  PK4(p0, 0, pa0); PK4(p0, 8, pa1); PK4(p1, 0, pa2); PK4(p1, 8, pa3);
#undef PK4
}
template <int BUF> __device__ __forceinline__ void qkt(f32x16& p0, f32x16& p1, const char* kp, const bf16x8* qr) {
  const char* k0 = kp + BUF * (int)SHM_K; const char* k1 = k0 + 32 * KPITCH;
  bf16x8 b0[8], b1[8];
#pragma unroll
  for (int d0 = 0; d0 < 8; ++d0) { b0[d0] = *reinterpret_cast<const bf16x8*>(k0 + d0 * 32); b1[d0] = *reinterpret_cast<const bf16x8*>(k1 + d0 * 32); }
  p0 = f32x16{}; p1 = f32x16{};
#pragma unroll
  for (int d0 = 0; d0 < 8; ++d0) { p0 = __builtin_amdgcn_mfma_f32_32x32x16_bf16(b0[d0], qr[d0], p0, 0, 0, 0); p1 = __builtin_amdgcn_mfma_f32_32x32x16_bf16(b1[d0], qr[d0], p1, 0, 0, 0); }
}
template <int NE> __device__ __forceinline__ void qkt_order() {
  __builtin_amdgcn_sched_group_barrier(0x100, 4, 0);
  if (NE) __builtin_amdgcn_sched_group_barrier(0x400, NE, 0);
#pragma unroll
  for (int d0 = 0; d0 < 6; ++d0) { __builtin_amdgcn_sched_group_barrier(0x100, 2, 0); __builtin_amdgcn_sched_group_barrier(0x008, 2, 0); }
  __builtin_amdgcn_sched_group_barrier(0x008, 4, 0);
}
__device__ __forceinline__ void kmask(f32x16& p0, f32x16& p1, int kbase, int nvalid, int hi) {
#pragma unroll
  for (int r = 0; r < 16; ++r) { const int k = kbase + crow(r, hi); if (k >= nvalid) p0[r] = -1e30f; if (k + 32 >= nvalid) p1[r] = -1e30f; }
}
__device__ __forceinline__ int v_st(int k, int c) { const int kk = (k & ~0xC) | ((k & 4) << 1) | ((k & 8) >> 1); return ((kk >> 3) * 4 + (c >> 5)) * 512 + ((kk & 7) * 32 + (c & 31)) * 2; }
__device__ __forceinline__ int v_rd_base(int lane) { return ((lane & 3) << 3) | (((lane >> 2) & 3) << 6) | (((lane >> 4) & 1) << 5) | (((lane >> 5) & 1) << 8); }
constexpr int v_rd_off(int d0, int ks, int half) { return d0 * 512 + ks * 4096 + half * 2048; }
template <int OFF> __device__ __forceinline__ s16x4 tr_read(int vb) {
  s16x4 r; asm volatile("ds_read_b64_tr_b16 %0, %1 offset:%2" : "=&v"(r) : "v"(vb), "i"(OFF) : "memory"); return r;
}
template <int D0> __device__ __forceinline__ void pv_one(f32x16& od, int vb, bf16x8 pa0, bf16x8 pa1, bf16x8 pa2, bf16x8 pa3) {
  const s16x4 l0 = tr_read<v_rd_off(D0, 0, 0)>(vb), h0 = tr_read<v_rd_off(D0, 0, 1)>(vb), l1 = tr_read<v_rd_off(D0, 1, 0)>(vb), h1 = tr_read<v_rd_off(D0, 1, 1)>(vb);
  const s16x4 l2 = tr_read<v_rd_off(D0, 2, 0)>(vb), h2 = tr_read<v_rd_off(D0, 2, 1)>(vb), l3 = tr_read<v_rd_off(D0, 3, 0)>(vb), h3 = tr_read<v_rd_off(D0, 3, 1)>(vb);
  asm volatile("s_waitcnt lgkmcnt(0)" ::: "memory"); SBAR();
#define PK(L, H) (bf16x8){L[0], L[1], L[2], L[3], H[0], H[1], H[2], H[3]}
  od = __builtin_amdgcn_mfma_f32_32x32x16_bf16(pa0, PK(l0, h0), od, 0, 0, 0);
  od = __builtin_amdgcn_mfma_f32_32x32x16_bf16(pa1, PK(l1, h1), od, 0, 0, 0);
  od = __builtin_amdgcn_mfma_f32_32x32x16_bf16(pa2, PK(l2, h2), od, 0, 0, 0);
  od = __builtin_amdgcn_mfma_f32_32x32x16_bf16(pa3, PK(l3, h3), od, 0, 0, 0);
#undef PK
}
__device__ __forceinline__ void pv_d0(f32x16* o, int vb, bf16x8 pa0, bf16x8 pa1, bf16x8 pa2, bf16x8 pa3) {
  pv_one<0>(o[0], vb, pa0, pa1, pa2, pa3); pv_one<1>(o[1], vb, pa0, pa1, pa2, pa3); pv_one<2>(o[2], vb, pa0, pa1, pa2, pa3); pv_one<3>(o[3], vb, pa0, pa1, pa2, pa3);
}

__device__ __forceinline__ void attn_unit(const bf16* __restrict__ Qb, int qvalid, int packed, const bf16* __restrict__ Kh, const bf16* __restrict__ Vh,
                                          bf16* __restrict__ Ob, int nvalid, int NT, char* lds, unsigned* qctr, unsigned& nxt  , const float* __restrict__ qg  , int tq0  ) {
  int tid_ = threadIdx.x; asm volatile("" : "+v"(tid_));
  const int tid = tid_, wid = tid >> 6, lane = tid & 63, r32 = lane & 31, hi = lane >> 5;
  bf16* V_lds = (bf16*)lds; bf16* K_lds = (bf16*)(lds + 2 * SHM_V);
  float* ws = (float*)(lds + 2 * SHM_V + 2 * SHM_K) + wid * 64; float* li_l = ws; float* al_l = ws + 32;
  float m_reg = -1e30f, l_reg = 0; f32x16 o[4] = {}; bf16x8 qr[8];
  { int qrow = wid * QBLK + r32; qrow = qrow < qvalid ? qrow : qvalid - 1;
    const bf16* Qw = Qb + (packed ? (long)(qrow & 15) * LDQ + (qrow >> 4) * HD : (long)qrow * LDQ) + hi * 8;
#pragma unroll
    for (int d0 = 0; d0 < 8; ++d0) qr[d0] = *reinterpret_cast<const bf16x8*>(Qw + d0 * 16);
    float qf[8][8]; float ss = 0.f;
#pragma unroll
    for (int d0 = 0; d0 < 8; ++d0)
#pragma unroll
        for (int e = 0; e < 8; ++e) { qf[d0][e] = __builtin_bit_cast(float, (unsigned)(unsigned short)qr[d0][e] << 16); ss += qf[d0][e] * qf[d0][e]; }
    ss = ::xadd32(ss);
    const float rstd = __builtin_amdgcn_rsqf(ss * (1.0f / HD) + QK_EPS);
#pragma unroll
    for (int d0 = 0; d0 < 8; ++d0) { const f32x4 g0 = *(const f32x4*)(qg + d0 * 16 + hi * 8), g1 = *(const f32x4*)(qg + d0 * 16 + hi * 8 + 4);
#pragma unroll
        for (int e = 0; e < 4; ++e) { qf[d0][e] *= rstd * g0[e]; qf[d0][4 + e] *= rstd * g1[e]; } }
    const int tq = tq0 + (packed ? (qrow & 15) : qrow);
    float rowp, colp; if (tq < NMETA) { rowp = -1.0f; colp = (float)tq; } else { const int jj = tq - NMETA; rowp = (float)(jj >> 6); colp = (float)(jj & 63); }
    const float hsc = hi ? 0.1f * 0.15915494309189535f : 0.15915494309189535f;
#pragma unroll
    for (int sg = 0; sg < 2; ++sg) { const float ph = (sg ? colp : rowp) * hsc;
#pragma unroll
        for (int dd = 0; dd < 2; ++dd)
#pragma unroll
            for (int e = 0; e < 8; ++e) { const float ang = ph * ROTF[16 * dd + e];
                const float sn = __builtin_amdgcn_sinf(ang), cs = __builtin_amdgcn_cosf(ang), a = qf[4 * sg + dd][e], b = qf[4 * sg + dd + 2][e];
                qf[4 * sg + dd][e] = a * cs - b * sn; qf[4 * sg + dd + 2][e] = b * cs + a * sn; } }
#pragma unroll
    for (int d0 = 0; d0 < 8; ++d0) { v4u w; w.x = ::pk2(qf[d0][0], qf[d0][1]); w.y = ::pk2(qf[d0][2], qf[d0][3]); w.z = ::pk2(qf[d0][4], qf[d0][5]); w.w = ::pk2(qf[d0][6], qf[d0][7]);
        qr[d0] = __builtin_bit_cast(bf16x8, w); } }
  const int sr = tid >> 4, sc = (tid & 15) * 8, vst0 = v_st(sr, sc), vst1 = v_st(32 + sr, sc);
  const int vb0 = (int)(uintptr_t)V_lds + v_rd_base(lane);
  constexpr int SDEPTH = ATT_SDEPTH;
  struct { bf16x8 vs0, vs1, ks0, ks1; } sr_[SDEPTH];
  const unsigned goff0 = (unsigned)(sr * LDK + sc) * 2u, goff1 = goff0 + 32u * LDK * 2u;
  const unsigned gofv0 = (unsigned)(sr * LDV + sc) * 2u, gofv1 = gofv0 + 32u * LDV * 2u;
#define SLOAD(i, k0) do { const char* vbp = (const char*)Vh + (size_t)(k0) * (LDV * 2); const char* kbp = (const char*)Kh + (size_t)(k0) * (LDK * 2); \
    sr_[i].vs0 = *reinterpret_cast<const bf16x8*>(vbp + gofv0); sr_[i].vs1 = *reinterpret_cast<const bf16x8*>(vbp + gofv1); \
    sr_[i].ks0 = *reinterpret_cast<const bf16x8*>(kbp + goff0); sr_[i].ks1 = *reinterpret_cast<const bf16x8*>(kbp + goff1); } while (0)
#define SWRITE(b, i) do { *(bf16x8*)((char*)V_lds + (b) * SHM_V + vst0) = sr_[i].vs0;          \
    *(bf16x8*)((char*)V_lds + (b) * SHM_V + vst1) = sr_[i].vs1; int kc = sc * 2;               \
    *(bf16x8*)((char*)K_lds + (b) * SHM_K + KSWZ(sr, kc)) = sr_[i].ks0;                       \
    *(bf16x8*)((char*)K_lds + (b) * SHM_K + KSWZ(32 + sr, kc)) = sr_[i].ks1; } while (0)
#define SWAIT() do { if constexpr (SDEPTH == 2) asm volatile("s_waitcnt vmcnt(4)" ::: "memory"); else asm volatile("s_waitcnt vmcnt(0)" ::: "memory"); } while (0)
#define RESC(a) do { if (__any((a) < 1.f)) { if (hi == 0) al_l[r32] = (a); asm volatile("s_waitcnt lgkmcnt(0)" ::: "memory"); \
    for (int d = 0; d < 4; ++d) for (int r = 0; r < 16; ++r) o[d][r] *= al_l[crow(r, hi)]; } } while (0)
  f32x16 pA0, pA1, pB0, pB1; float mnA, mnB, alA, alB; bf16x8 pa0, pa1, pa2, pa3;
  constexpr int SE = 0, SO = SDEPTH - 1;
  SLOAD(SE, 0); asm volatile("s_waitcnt vmcnt(0)" ::: "memory"); SWRITE(0, SE); __syncthreads();
  const char* kb0 = (const char*)K_lds + r32 * KPITCH + hi * 16;
  qkt<0>(pA0, pA1, kb0, qr); qkt_order<0>(); SBAR(); partialSM(pA0, pA1, m_reg, mnA, alA);
  SLOAD(SO, KVBLK); if constexpr (SDEPTH == 2) { if (2 < NT) SLOAD(SE, 2 * KVBLK); }
  SWAIT(); SWRITE(1, SO); __syncthreads();
  for (int j = 1; j + 1 < NT; j += 2) {
    SBAR(); qkt<1>(pB0, pB1, kb0, qr); expP0(pA0); qkt_order<16>(); SBAR();
    if (__builtin_expect((j + 1) * KVBLK > nvalid, 0)) kmask(pB0, pB1, j * KVBLK, nvalid, hi);
    finishSM(pA0, pA1, alA, l_reg, pa0, pa1, pa2, pa3); SBAR();
    SLOAD(SO, (j + SDEPTH) * KVBLK); SBAR();
    pv_d0(o, vb0, pa0, pa1, pa2, pa3); partialSM(pB0, pB1, m_reg, mnB, alB);
    __syncthreads(); SWAIT(); SWRITE(0, SE);
    RESC(alB); __syncthreads();
    SBAR(); qkt<0>(pA0, pA1, kb0, qr); expP0(pB0); qkt_order<16>(); SBAR();
    if (__builtin_expect((j + 2) * KVBLK > nvalid, 0)) kmask(pA0, pA1, (j + 1) * KVBLK, nvalid, hi);
    finishSM(pB0, pB1, alB, l_reg, pa0, pa1, pa2, pa3); SBAR();
    if (SDEPTH == 1 || j + 3 < NT) SLOAD(SE, (j + 1 + SDEPTH) * KVBLK); SBAR();
    pv_d0(o, vb0 + (int)SHM_V, pa0, pa1, pa2, pa3); partialSM(pA0, pA1, m_reg, mnA, alA);
    __syncthreads(); SWAIT(); SWRITE(1, SO);
    RESC(alA); __syncthreads();
  }
  nxt = ::mix_issue(qctr);
  expP0(pA0); finishSM(pA0, pA1, alA, l_reg, pa0, pa1, pa2, pa3); SBAR();
  pv_d0(o, vb0, pa0, pa1, pa2, pa3);
  if (hi == 0) li_l[r32] = l_reg; asm volatile("s_waitcnt lgkmcnt(0)" ::: "memory");
  const int rbase = wid * QBLK; const bool odd = (lane & 1);
#pragma unroll
  for (int r = 0; r < 16; r += 2) {
    const int rowA = crow(r, hi), rowB = crow(r + 1, hi);
    const float ia = __builtin_amdgcn_rcpf(li_l[rowA]), ib = __builtin_amdgcn_rcpf(li_l[rowB]);
    const int myrow = odd ? rowB : rowA;
#pragma unroll
    for (int d0 = 0; d0 < 4; ++d0) {
      const float va = o[d0][r] * ia, vb = o[d0][r + 1] * ib;
      const float send = odd ? va : vb, got = ::xshfl<1>(send);
      const unsigned w = odd ? cvtpk(got, vb) : cvtpk(va, got);
      const int orow = rbase + myrow;
      if (orow < qvalid) *(unsigned*)(Ob + (packed ? (long)(orow & 15) * LDO + (orow >> 4) * HD : (long)orow * LDO) + d0 * 32 + (r32 & ~1)) = w;
    }
  }
#undef SLOAD
#undef SWRITE
#undef SWAIT
#undef RESC
}
#undef KSWZ
#undef SBAR
}

struct FiltArgs { const zt_t* tf; const zt_t* tb; const float* skip; };
template <int N, int RL>
__device__ __forceinline__ void conv_unit(bool dostore, int skip  , char* ldsg, const FiltArgs fa, int c, int L, zt_t* z0p, zt_t* z1p  , unsigned* qctr, unsigned& nxt  ) {
    constexpr int NT = 512, PER = N / NT;
    int tid_ = threadIdx.x; asm volatile("" : "+v"(tid_));
    const int tid = tid_;
    cf* buf = (cf*)ldsg;
    float* side = (float*)(ldsg + LDS_SIDE);
    float* exf = side + 128;
    float* exb = side + 160;
    float* zh0 = side + 192, *zh1 = side + 224, *zt0 = side + 256, *zt1 = side + 288;
    float* red = side + 320;
    const int lo = N - L + 1;
    constexpr int LC = (N == 16384) ? LP : LS, PZ = (LC + NT - 1) / NT, PT = (LC / 4 + NT - 1) / NT;
    float zr0[PZ], zr1[PZ];
    { int t0 = tid; asm volatile("" : "+v"(t0));
#pragma unroll
    for (int i = 0; i < PZ; ++i) { const int t = t0 + i * NT; const bool ok = ((i + 1) * NT <= LC) || t < L; zr0[i] = ok ? (float)z0p[t] : 0.f; zr1[i] = ok ? (float)z1p[t] : 0.f; } }
    const float delta = 3.0701134573253945f + (float)c * (12.280453829301578f / 1023.0f);
    const float tinv = 1.0f / (float)(L - 1);
    float asum = 0.f;
    if (!(skip & 1)) for (int q = tid; q < (L >> 2); q += NT) {
        typedef _Float16 h4 __attribute__((ext_vector_type(4)));
        const h4 sfh = *(const h4*)(fa.tf + 4 * q), sbh = *(const h4*)(fa.tb + 4 * q);
        const f32x4 sf4 = {(float)sfh[0], (float)sfh[1], (float)sfh[2], (float)sfh[3]}, sb4 = {(float)sbh[0], (float)sbh[1], (float)sbh[2], (float)sbh[3]};
#pragma unroll
        for (int i = 0; i < 4; ++i) {
            const int k = 4 * q + i;
            const float dec = __expf(-(float)k * tinv * delta);
            const float sf = sf4[i] * dec, sb = sb4[i] * dec;
            asum += fabsf(sf) + (k >= 1 ? fabsf(sb) : 0.f);
            if (k < lo) { cf v; v.x = sf; v.y = 0.f; buf[fphys(k)] = v; if (k >= 1) { cf w; w.x = sb; w.y = 0.f; buf[fphys(N - k)] = w; } }
            else { float zz = 0.f; asm volatile("" : "+v"(zz)); cf v; v.x = zz; v.y = zz; buf[fphys(k)] = v; exf[k - lo] = sf; exb[k - lo] = sb; }
        }
    }
    asum = wave_sum(asum);
    if ((tid & 63) == 0) red[tid >> 6] = asum;
    __syncthreads();
    float norm = __builtin_amdgcn_rcpf(((red[0] + red[1]) + (red[2] + red[3])) + ((red[4] + red[5]) + (red[6] + red[7])));
    asm volatile("" : "+v"(norm));
    cf Hreg[PER / RL][RL];
    {
        if (!(skip & 2)) {
        { using FP = FPass<N, 16, NT, 1>; cf u[FP::B][16]; FP::load(buf, tid, u); __syncthreads(); FP::compute(tid, u); FP::store(buf, tid, u); __syncthreads(); }
        { using FP = FPass<N, 16, NT, 16>; cf u[FP::B][16]; FP::load(buf, tid, u); __syncthreads(); FP::compute(tid, u); FP::store(buf, tid, u); __syncthreads(); }
        { using FP = FPass<N, 16, NT, 256>; cf u[FP::B][16]; FP::load(buf, tid, u); __syncthreads(); FP::compute(tid, u); FP::store(buf, tid, u); __syncthreads(); }
        }
        FPass<N, RL, NT, 4096>::load(buf, tid, Hreg); __syncthreads(); FPass<N, RL, NT, 4096>::compute(tid, Hreg);
    }
#pragma unroll
    for (int i = 0; i < PZ; ++i) { const int t = tid + i * NT; cf v; v.x = zr0[i]; v.y = zr1[i];
        if (i == 0) { if (t <= 30) { zh0[t] = v.x; zh1[t] = v.y; } }
        if ((i + 1) * NT > N - LC + 1) { if (t >= lo && t < L) { zt0[t - lo] = v.x; zt1[t - lo] = v.y; } }
        buf[fphys(t)] = v; }
    for (int t = tid + PZ * NT; t < N; t += NT) { float zz = 0.f; asm volatile("" : "+v"(zz)); cf v; v.x = zz; v.y = zz; buf[fphys(t)] = v; }
    __syncthreads();
    if (!(skip & 4)) {
        { using FP = FPass<N, 16, NT, 1>; cf u[FP::B][16]; FP::load(buf, tid, u); __syncthreads(); FP::compute(tid, u); FP::store(buf, tid, u); __syncthreads(); }
        { using FP = FPass<N, 16, NT, 16>; cf u[FP::B][16]; FP::load(buf, tid, u); __syncthreads(); FP::compute(tid, u); FP::store(buf, tid, u); __syncthreads(); }
        { using FP = FPass<N, 16, NT, 256>; cf u[FP::B][16]; FP::load(buf, tid, u); __syncthreads(); FP::compute(tid, u); FP::store(buf, tid, u); __syncthreads(); }
        { cf u[PER / RL][RL]; FPass<N, RL, NT, 4096>::load(buf, tid, u); __syncthreads(); FPass<N, RL, NT, 4096>::compute(tid, u);
#pragma unroll
          for (int b = 0; b < PER / RL; ++b)
#pragma unroll
              for (int r = 0; r < RL; ++r) { cf w = cmul(u[b][r], Hreg[b][r]); w.y = -w.y; u[b][r] = w; }
          FPass<N, RL, NT, 4096>::store(buf, tid, u); __syncthreads(); }
    }
    if (dostore) nxt = mix_issue(qctr);
    if (!(skip & 4)) {
        { using FP = FPass<N, 16, NT, 1>; cf u[FP::B][16]; FP::load(buf, tid, u); __syncthreads(); FP::compute(tid, u); FP::store(buf, tid, u); __syncthreads(); }
        { using FP = FPass<N, 16, NT, 16>; cf u[FP::B][16]; FP::load(buf, tid, u); __syncthreads(); FP::compute(tid, u); FP::store(buf, tid, u); __syncthreads(); }
        { using FP = FPass<N, 16, NT, 256>; cf u[FP::B][16]; FP::load(buf, tid, u); __syncthreads(); FP::compute(tid, u); FP::store(buf, tid, u); __syncthreads(); }
        { cf u[PER / RL][RL]; FPass<N, RL, NT, 4096>::load(buf, tid, u); __syncthreads(); FPass<N, RL, NT, 4096>::compute(tid, u); FPass<N, RL, NT, 4096>::store(buf, tid, u); __syncthreads(); }
    }
    const float sk = fa.skip[c], sc = norm * (1.0f / (float)N);
    if (!(skip & 8)) {
        float y0[PZ], y1[PZ];
        int tf = tid; asm volatile("" : "+v"(tf));
#pragma unroll
        for (int i = 0; i < PZ; ++i) { const int t = tf + i * NT; const bool ok = ((i + 1) * NT <= LC) || t < L; y0[i] = ok ? (float)z0p[t] : 0.f; y1[i] = ok ? (float)z1p[t] : 0.f; }
#pragma unroll
        for (int i = 0; i < PZ; ++i) { const int t = tf + i * NT;
            if (((i + 1) * NT <= LC) || t < L) {
                const cf v = buf[fphys(t)];
                float a = v.x * sc, b = -v.y * sc;
                if (i == 0 || (i + 1) * NT > N - LC + 1) {
                    float ca = 0.f, cb = 0.f;
                    if (t >= lo) for (int k = lo; k <= t; ++k) { const float h = exf[k - lo]; ca += h * zh0[t - k]; cb += h * zh1[t - k]; }
                    if (t <= L - 1 - lo) for (int k = lo; k <= L - 1 - t; ++k) { const float h = exb[k - lo]; ca += h * zt0[t + k - lo]; cb += h * zt1[t + k - lo]; }
                    a += ca * norm; b += cb * norm; }
                a += sk * y0[i]; b += sk * y1[i];
                if (dostore) { z0p[t] = (zt_t)a; z1p[t] = (zt_t)b; } } }
    }
    __syncthreads();
}

#define XB_TMO      128
#define XB_XCNT(j)  (256  + 64 * (j))
#define XB_XSUB(j)  (1280 + 64 * (j))
#define XB_XGEN(j)  (2304 + 64 * (j))
#define XB_TOP      3328
#define XB_TOPGEN   3392
#define XCD_BAR_WORDS 3456
#define XB_SPIN_CAP (1u << 18)
__device__ __forceinline__ unsigned xb_ld(unsigned* p)              { return __hip_atomic_load(p, __ATOMIC_RELAXED, __HIP_MEMORY_SCOPE_AGENT); }
__device__ __forceinline__ unsigned xb_add(unsigned* p, unsigned v) { return __hip_atomic_fetch_add(p, v, __ATOMIC_RELAXED, __HIP_MEMORY_SCOPE_AGENT); }
__device__ __forceinline__ unsigned xb_xcc_id() { return (unsigned)__builtin_amdgcn_s_getreg((3 << 11) | 20) & 0xFu; }
#define XB_SPIN(cond, bar) do { unsigned _sp = 0; while (cond) { __builtin_amdgcn_s_sleep(1); \
    if ((++_sp & 255u) == 0u) { if (xb_ld(&(bar)[XB_TMO])) break; if (_sp > XB_SPIN_CAP) { atomicAdd(&(bar)[XB_TMO], 1u); break; } } } } while (0)
struct XcdBarrier { unsigned* bar; unsigned x; volatile LAS unsigned* st; };
__device__ __forceinline__ XcdBarrier xcd_barrier_post(unsigned* bar, volatile LAS unsigned* st) {
    XcdBarrier b; b.bar = bar; b.x = xb_xcc_id(); b.st = st;
    if (threadIdx.x == 0) (void)xb_add(&bar[XB_XCNT(b.x)], 1u);
    return b;
}
__device__ __forceinline__ void xcd_barrier_complete(unsigned* bar, unsigned x, unsigned& nloc, unsigned& nx) {
    const unsigned G = gridDim.x * gridDim.y * gridDim.z;
    unsigned sum, cnt, mine, sp = 0u;
    for (;;) {
        sum = 0u; cnt = 0u; mine = 0u;
#pragma unroll
        for (unsigned j = 0; j < 16; ++j) { const unsigned c = xb_ld(&bar[XB_XCNT(j)]); sum += c; cnt += (c > 0u) ? 1u : 0u; mine = (j == x) ? c : mine; }
        if (sum == G) break;
        __builtin_amdgcn_s_sleep(1);
        if ((++sp & 255u) == 0u) { if (xb_ld(&bar[XB_TMO])) break; if (sp > XB_SPIN_CAP) { atomicAdd(&bar[XB_TMO], 1u); break; } }
    }
    nloc = mine > 0u ? mine : 1u; nx = cnt > 0u ? cnt : 1u;
}
__device__ __forceinline__ void xcd_barrier(const XcdBarrier& b) {
    asm volatile("s_waitcnt vmcnt(0)" ::: "memory");
    __syncthreads();
    if (threadIdx.x == 0) {
        unsigned* bar = b.bar; unsigned bx = b.x;
        asm volatile("" : "+s"(bar), "+s"(bx));
        __builtin_amdgcn_s_waitcnt(0);
        unsigned nloc = b.st[0], nx = b.st[1];
        if (nloc == 0u) { xcd_barrier_complete(bar, bx, nloc, nx); b.st[0] = nloc; b.st[1] = nx; }
        const unsigned old = xb_add(&bar[XB_XSUB(bx)], 1u);
        const unsigned gen = old / nloc;
        if (old + 1u == (gen + 1u) * nloc) {
            __builtin_amdgcn_fence(__ATOMIC_RELEASE, "agent");
            asm volatile("s_waitcnt vmcnt(0)" ::: "memory");
            const unsigned og = xb_add(&bar[XB_TOP], 1u);
            const unsigned tg = og / nx;
            if (og + 1u == (tg + 1u) * nx) xb_add(&bar[XB_TOPGEN], 1u);
            else XB_SPIN(xb_ld(&bar[XB_TOPGEN]) == tg, bar);
            __builtin_amdgcn_fence(__ATOMIC_ACQUIRE, "agent");
            xb_add(&bar[XB_XGEN(bx)], 1u);
            asm volatile("s_waitcnt vmcnt(0)" ::: "memory");
        } else {
            XB_SPIN(xb_ld(&bar[XB_XGEN(bx)]) == gen, bar);
            __builtin_amdgcn_fence(__ATOMIC_ACQUIRE, "agent");
            asm volatile("s_waitcnt vmcnt(0)" ::: "memory");
        }
    }
    __syncthreads();
}

struct Ptrs {
    const float *x_prompt, *x_sample, *meta, *ln_g, *ln_b, *ffa_w13, *ffa_w2, *w_in, *b_gate, *conv_w, *conv_b, *f_w1, *f_b1, *f_freq, *f_w2, *f_b2, *f_w3, *skip, *q_norm, *k_norm,
                *w_br_hy, *w_br_attn, *w_out, *ffb_w13, *ffb_w2;
    float* out; unsigned char* ws;
};
typedef const __attribute__((address_space(4))) Ptrs CPtrs;
__device__ __forceinline__ unsigned pkh16(float lo, float hi) { unsigned a, b; asm volatile("v_cvt_f16_f32 %0, %1" : "=v"(a) : "v"(lo)); asm volatile("v_cvt_f16_f32 %0, %1" : "=v"(b) : "v"(hi)); return (a & 0xffffu) | (b << 16); }
#ifndef MMA_F16
#define MMA_F16 0
#endif
#if MMA_F16
__device__ __forceinline__ unsigned pkh2(float lo, float hi) { return pkh16(lo, hi); }
__device__ __forceinline__ float hsum2(unsigned w) { return pg8::f16_lo(w) + pg8::f16_hi(w); }
#else
__device__ __forceinline__ unsigned pkh2(float lo, float hi) { return pk2(lo, hi); }
__device__ __forceinline__ float hsum2(unsigned w) { return bflo(w) + bfhi(w); }
#endif
__device__ __forceinline__ void transpose_item(const float* W, int K, int N, bf16* WT, int k0, int n0, int dst_row0, LAS float* scr, int lane, const float* gk, const float* bk, float (&csum)[4], float (&bsum)[4], int ldw  ) {
#pragma unroll 8
    for (int i = 0; i < 32; ++i) { const int kk = 2 * i + (lane >> 5); scr[kk * 33 + (lane & 31)] = W[(size_t)(k0 + kk) * N + n0 + (lane & 31)]; }
    LDS_WAIT(); asm volatile("" ::: "memory");
    const int c = lane & 7;
    float gq[8], bq[8];
#pragma unroll
    for (int q = 0; q < 8; ++q) { gq[q] = gk ? gk[k0 + 8 * c + q] : 1.0f; bq[q] = gk ? bk[k0 + 8 * c + q] : 0.0f; }
#pragma unroll
    for (int j = 0; j < 4; ++j) { const int n = (lane >> 3) + 8 * j; const LAS float* s = scr + (8 * c) * 33 + n;
        float w[8]; float bs = 0.f;
#pragma unroll
        for (int q = 0; q < 8; ++q) { const float x = s[q * 33]; bs += bq[q] * x; w[q] = x * gq[q]; }
        v4u o; if (gk) { o.x = pkh2(w[0], w[1]); o.y = pkh2(w[2], w[3]); o.z = pkh2(w[4], w[5]); o.w = pkh2(w[6], w[7]); } else { o.x = pk2(w[0], w[1]); o.y = pk2(w[2], w[3]); o.z = pk2(w[4], w[5]); o.w = pk2(w[6], w[7]); }
        *(GAS v4u*)(WT + (size_t)(dst_row0 + n) * ldw + k0 + 8 * c) = o;
        if (gk) { csum[j] += (hsum2(o.x) + hsum2(o.y)) + (hsum2(o.z) + hsum2(o.w)); bsum[j] += bs; } }
    LDS_WAIT(); asm volatile("" ::: "memory");
}
__device__ __forceinline__ int swiglu_row(int n0) { const int up = n0 >= DFF, j = up ? n0 - DFF : n0; return 256 * (j >> 7) + (up ? 128 : 0) + (j & 127); }
__device__ __forceinline__ void convert_one(const float* W, int K, int N, bf16* WT, int item, LAS float* scr, int lane, int ldw = 0  ) {
    const int nblk = N / 32, kb = item / nblk, nb = item % nblk; float cd[4], bd[4];
    transpose_item(W, K, N, WT, 64 * kb, 32 * nb, 32 * nb, scr, lane, nullptr, nullptr, cd, bd, ldw ? ldw : K);
}
__device__ __forceinline__ void convert_folded(const float* W, int N, bf16* WT, int item, bool swiglu, LAS float* scr, int lane, const float* gk, const float* bk, float* cs, float* cb) {
    const int nb = item >> 1, half = item & 1, n0 = 32 * nb, dst = swiglu ? swiglu_row(n0) : n0;
    float csum[4] = {0.f, 0.f, 0.f, 0.f}, bsum[4] = {0.f, 0.f, 0.f, 0.f};
    for (int kb = half * (DM / 128); kb < (half + 1) * (DM / 128); ++kb) transpose_item(W, DM, N, WT, 64 * kb, n0, dst, scr, lane, gk, bk, csum, bsum, DM);
#pragma unroll
    for (int j = 0; j < 4; ++j) { float a = csum[j], b = bsum[j];
        a += xshfl<1>(a); a += xshfl<2>(a); a += xshfl<4>(a); b += xshfl<1>(b); b += xshfl<2>(b); b += xshfl<4>(b);
        if ((lane & 7) == 0) { const int n = (lane >> 3) + 8 * j; cs[(size_t)half * NCS + dst + n] = a; cb[(size_t)half * NCS + dst + n] = b; } }
}
__device__ __forceinline__ const float* ln_gain(CPtrs& P, int idx) { return idx < 0 ? (const float*)(P.ws + WS_ONE) : P.ln_g + (size_t)idx * DM; }
__device__ __forceinline__ const float* ln_bias(CPtrs& P, int idx) { return idx < 0 ? (const float*)(P.ws + WS_ONE) + DM : P.ln_b + (size_t)idx * DM; }
__device__ __forceinline__ void phase_convert(CPtrs& P, int layer, LAS unsigned char* lds, int gw, int NGW, int wave, int lane) {
    LAS float* scr = (LAS float*)(lds + wave * 16384);
    constexpr int F13 = 2 * (2 * DFF / 32), FIN = 2 * (NIN / 32), NFOLD = 2 * F13 + FIN;
    constexpr int I2 = (DFF / 64) * (DM / 32), IBH = (DHY / 64) * (DM / 32), IBA = (DM / 64) * (DM / 32), NSHORT = 2 * I2 + IBH + 2 * IBA;
    unsigned char* ws = P.ws;
    float* CS = (float*)(ws + WS_CS) + (size_t)layer * 2 * NCS; float* CB = (float*)(ws + WS_CB) + (size_t)layer * 2 * NCS;
    const int lnA = layer == 0 ? -1 : (layer - 1) * 3 + 2, lnI = layer * 3 + 0, lnB = layer * 3 + 1;
    for (int it = gw; it < NFOLD + NSHORT; it += NGW) {
        int r = it;
        if (r < F13) { convert_folded(P.ffa_w13 + (size_t)layer * DM * 2 * DFF, 2 * DFF, (bf16*)(ws + WS_W13A), r, true, scr, lane, ln_gain(P, lnA), ln_bias(P, lnA), CS + CS_W13A, CB + CS_W13A); continue; } r -= F13;
        if (r < FIN) { convert_folded(P.w_in + (size_t)layer * DM * NIN, NIN, (bf16*)(ws + WS_WIN), r, false, scr, lane, ln_gain(P, lnI), ln_bias(P, lnI), CS + CS_WIN, CB + CS_WIN); continue; } r -= FIN;
        if (r < F13) { convert_folded(P.ffb_w13 + (size_t)layer * DM * 2 * DFF, 2 * DFF, (bf16*)(ws + WS_W13B), r, true, scr, lane, ln_gain(P, lnB), ln_bias(P, lnB), CS + CS_W13B, CB + CS_W13B); continue; } r -= F13;
        if (r < I2) { convert_one(P.ffa_w2 + (size_t)layer * DFF * DM, DFF, DM, (bf16*)(ws + WS_W2A), r, scr, lane); continue; } r -= I2;
        if (r < IBH) { convert_one(P.w_br_hy + (size_t)layer * DHY * DM, DHY, DM, (bf16*)(ws + WS_WBH), r, scr, lane, DYC); continue; } r -= IBH;
        if (r < IBA) { convert_one(P.w_br_attn + (size_t)layer * DM * DM, DM, DM, (bf16*)(ws + WS_WBH) + DHY, r, scr, lane, DYC); continue; } r -= IBA;
        if (r < IBA) { convert_one(P.w_out + (size_t)layer * DM * DM, DM, DM, (bf16*)(ws + WS_WOUT), r, scr, lane); continue; } r -= IBA;
        convert_one(P.ffb_w2 + (size_t)layer * DFF * DM, DFF, DM, (bf16*)(ws + WS_W2B), r, scr, lane);
    }
}
__device__ __forceinline__ void row_to_seq(int m, int& s, int& t) { s = m < LP ? 0 : (m < 2 * LP ? 1 : (m < 2 * LP + LS ? 2 : 3)); t = m - seq_row0(s); }
__device__ __forceinline__ void phase_init(CPtrs& P, int gw, int NGW, int lane) {
    bf16* HB = (bf16*)(P.ws + WS_HB); bf16* R16 = (bf16*)(P.ws + WS_H32);
    { long long* ST = (long long*)(P.ws + WS_ST); float* ONE = (float*)(P.ws + WS_ONE);
      const size_t t0 = (size_t)gw * 64 + lane, ts = (size_t)NGW * 64;
      for (size_t e = t0; e < (size_t)MPAD * 2; e += ts) ST[e] = (e & 1) ? (long long)(2048.0 * (1.0 - 1e-5) * 1048576.0) : 0ll;
      for (size_t e = (size_t)MPAD * 2 + t0; e < (size_t)NSTAT * MPAD * 2; e += ts) ST[e] = 0ll;
      for (size_t e = t0; e < (size_t)2 * DM; e += ts) ONE[e] = e < DM ? 1.0f : 0.0f; }
    for (int m = gw; m < MPAD; m += NGW) {
        const float* src = nullptr;
        if (m < NTOK) { int s, t; row_to_seq(m, s, t);
            if (t < NMETA) src = P.meta + (size_t)t * DM;
            else src = (s < 2 ? P.x_prompt + ((size_t)s * SP + (t - NMETA)) * DM : P.x_sample + ((size_t)(s - 2) * SS + (t - NMETA)) * DM); }
#pragma unroll
        for (int j = 0; j < 4; ++j) { const int e = 8 * lane + 512 * j;
            f32x4 a = {0.f, 0.f, 0.f, 0.f}, b = {0.f, 0.f, 0.f, 0.f};
            if (src) { a = *(const f32x4*)(src + e); b = *(const f32x4*)(src + e + 4); }
            v4u o; o.x = pk2(a[0], a[1]); o.y = pk2(a[2], a[3]); o.z = pk2(b[0], b[1]); o.w = pk2(b[2], b[3]);
            if (!MMA_F16) *(v4u*)(HB + (size_t)m * DM + e) = o;
            v4u h; h.x = pkh16(a[0], a[1]); h.y = pkh16(a[2], a[3]); h.z = pkh16(b[0], b[1]); h.w = pkh16(b[2], b[3]);
            *(v4u*)(R16 + (size_t)m * DM + e) = h; }
    }
}
__device__ __forceinline__ void phase_filter_hidden(CPtrs& P, int gw, int NGW, int lane) {
    bf16* H2 = (bf16*)(P.ws + WS_H2);
    { bf16* W3T = (bf16*)(P.ws + WS_W3T);
      for (int e = gw * 64 + lane; e < DEPTH * 2 * DHY * FILT_W; e += NGW * 64) { const int j = e & 63, cc = (e >> 6) & (2 * DHY - 1), ly = e >> 17; W3T[e] = (bf16)f2bf(P.f_w3[((size_t)ly * FILT_W + j) * 2 * DHY + cc]); } }
    for (int layer = 0; layer < DEPTH; ++layer) {
        float w1c[FILT_EMB], w2c[FILT_W];
#pragma unroll
        for (int f = 0; f < FILT_EMB; ++f) w1c[f] = P.f_w1[((size_t)layer * FILT_EMB + f) * FILT_W + lane];
#pragma unroll
        for (int i = 0; i < FILT_W; ++i) w2c[i] = P.f_w2[((size_t)layer * FILT_W + i) * FILT_W + lane];
        const float b1 = P.f_b1[layer * FILT_W + lane], b2 = P.f_b2[layer * FILT_W + lane], fq = P.f_freq[layer * FILT_W + lane];
        for (int rr = gw; rr < LP + LS; rr += NGW) {
            const int grp = rr < LP ? 0 : 1, k = grp ? rr - LP : rr, L = grp ? LS : LP;
            float zf;
            { const float w = 6.283185307179586f * (float)k / (float)L;
              if (lane == 0) zf = (float)k / (float)(L - 1);
              else { const int mm = (lane - 1) & 15; const float fr = 1e-4f + (float)mm * ((15.0f - 1e-4f) / 15.0f); const float rv = __builtin_amdgcn_fractf(fr * (float)k / (float)L); zf = (lane <= 16) ? __builtin_amdgcn_cosf(rv) : -__builtin_amdgcn_sinf(rv); } }
            float a = b1;
#pragma unroll
            for (int f = 0; f < FILT_EMB; ++f) a += __builtin_bit_cast(float, __builtin_amdgcn_readlane(__builtin_bit_cast(int, zf), f)) * w1c[f];
            const float h1 = __builtin_amdgcn_sinf(__builtin_amdgcn_fractf(fq * a * 0.15915494309189535f));
            float c = b2;
#pragma unroll
            for (int i = 0; i < FILT_W; ++i) c += __builtin_bit_cast(float, __builtin_amdgcn_readlane(__builtin_bit_cast(int, h1), i)) * w2c[i];
            H2[(((size_t)layer * 2 + grp) * LP + k) * FILT_W + lane] = (bf16)f2bf(__builtin_amdgcn_sinf(__builtin_amdgcn_fractf(fq * c * 0.15915494309189535f)));
        }
    }
}
__device__ __forceinline__ void phase_taps(CPtrs& P, int layer, int gw, int NGW, int lane) {
    const bf16* W3T = (const bf16*)(P.ws + WS_W3T) + (size_t)layer * 2 * DHY * FILT_W; zt_t* TAPS = (zt_t*)(P.ws + WS_G);
    const int fr = lane & 15, fq = lane >> 4;
    constexpr int NKP = (LP + 63) / 64, NKS = (LS + 63) / 64, NITEM = (NKP + NKS) * 8;
    for (int it = gw; it < NITEM; it += NGW) {
        const int kb = it >> 3, cb = it & 7, grp = kb >= NKP ? 1 : 0, L = grp ? LS : LP, k0 = (grp ? kb - NKP : kb) * 64;
        const bf16* hb = (const bf16*)(P.ws + WS_H2) + ((size_t)layer * 2 + grp) * LP * FILT_W;
        bf16x8 a[4][2];
#pragma unroll
        for (int mt = 0; mt < 4; ++mt) { int row = k0 + 16 * mt + fr; row = row < L ? row : L - 1;
#pragma unroll
            for (int ks = 0; ks < 2; ++ks) a[mt][ks] = *(const bf16x8*)(hb + (size_t)row * FILT_W + 32 * ks + 8 * fq); }
        zt_t* tb = TAPS + (grp ? (size_t)2 * DHY * LP : 0);
#pragma unroll 4
        for (int ct = 0; ct < 16; ++ct) {
            const int cc = cb * 256 + ct * 16 + fr;
            const bf16x8 b0 = *(const bf16x8*)(W3T + (size_t)cc * FILT_W + 8 * fq), b1 = *(const bf16x8*)(W3T + (size_t)cc * FILT_W + 32 + 8 * fq);
#pragma unroll
            for (int mt = 0; mt < 4; ++mt) { f32x4 acc = {0.f, 0.f, 0.f, 0.f};
                acc = __builtin_amdgcn_mfma_f32_16x16x32_bf16(a[mt][0], b0, acc, 0, 0, 0); acc = __builtin_amdgcn_mfma_f32_16x16x32_bf16(a[mt][1], b1, acc, 0, 0, 0);
                const int kk = k0 + 16 * mt + 4 * fq;
                if (kk < L) { typedef _Float16 h4 __attribute__((ext_vector_type(4))); const h4 hv = {(_Float16)acc[0], (_Float16)acc[1], (_Float16)acc[2], (_Float16)acc[3]}; *(h4*)(tb + (size_t)cc * L + kk) = hv; } }
        }
    }
}
__device__ __forceinline__ void phase_ln_out(CPtrs& P, const float* g, const float* b, int gw, int NGW, int lane) {
    const bf16* HB = (const bf16*)(P.ws + WS_H32);
    f32x4 gv[8], bv[8];
#pragma unroll
    for (int j = 0; j < 4; ++j) { const int e = 8 * lane + 512 * j; gv[2 * j] = *(const f32x4*)(g + e); gv[2 * j + 1] = *(const f32x4*)(g + e + 4); bv[2 * j] = *(const f32x4*)(b + e); bv[2 * j + 1] = *(const f32x4*)(b + e + 4); }
    typedef _Float16 h2 __attribute__((ext_vector_type(2)));
    for (int m = gw; m < NTOK; m += NGW) {
        int s, t; row_to_seq(m, s, t); if (t < NMETA) continue;
        float* orow = P.out + (s < 2 ? ((size_t)s * SP + (t - NMETA)) * DM : (size_t)2 * SP * DM + ((size_t)(s - 2) * SS + (t - NMETA)) * DM);
        f32x4 v[8]; float sm = 0.f;
#pragma unroll
        for (int j = 0; j < 4; ++j) { const v4u w = *(const v4u*)(HB + (size_t)m * DM + 8 * lane + 512 * j);
            v[2 * j] = (f32x4){pg8::f16_lo(w.x), pg8::f16_hi(w.x), pg8::f16_lo(w.y), pg8::f16_hi(w.y)}; v[2 * j + 1] = (f32x4){pg8::f16_lo(w.z), pg8::f16_hi(w.z), pg8::f16_lo(w.w), pg8::f16_hi(w.w)}; }
#pragma unroll
        for (int j = 0; j < 8; ++j) sm += (v[j][0] + v[j][1]) + (v[j][2] + v[j][3]);
        const float mean = wave_sum(sm) * (1.0f / DM); float s2 = 0.f;
#pragma unroll
        for (int j = 0; j < 8; ++j) { v[j] = v[j] - mean; s2 += (v[j][0] * v[j][0] + v[j][1] * v[j][1]) + (v[j][2] * v[j][2] + v[j][3] * v[j][3]); }
        const float rstd = __builtin_amdgcn_rsqf(wave_sum(s2) * (1.0f / DM) + LN_EPS);
#pragma unroll
        for (int j = 0; j < 4; ++j) { const int e = 8 * lane + 512 * j;
            *(f32x4*)(orow + e) = v[2 * j] * rstd * gv[2 * j] + bv[2 * j]; *(f32x4*)(orow + e + 4) = v[2 * j + 1] * rstd * gv[2 * j + 1] + bv[2 * j + 1]; }
    }
}
__device__ __forceinline__ void phase_qkprep(CPtrs& P, int layer, int gw, int NGW, int lane) {
    bf16* PR = (bf16*)(P.ws + WS_PROJ); bf16* KC = (bf16*)(P.ws + WS_KC);
    const int h2 = lane >> 5, l = lane & 31, seg = l >> 4, j = l & 15, idxA = seg * 64 + 2 * j, idxB = idxA + 32;
    const float invf0 = exp2f(-(float)(2 * j) * (13.287712379549449f / 32.0f)), invf1 = exp2f(-(float)(2 * j + 1) * (13.287712379549449f / 32.0f));
    const float gqA0 = P.q_norm[layer * HD + idxA], gqA1 = P.q_norm[layer * HD + idxA + 1], gqB0 = P.q_norm[layer * HD + idxB], gqB1 = P.q_norm[layer * HD + idxB + 1];
    const float gkA0 = P.k_norm[layer * HD + idxA], gkA1 = P.k_norm[layer * HD + idxA + 1], gkB0 = P.k_norm[layer * HD + idxB], gkB1 = P.k_norm[layer * HD + idxB + 1];
    for (int m = gw; m < NTOK; m += NGW) {
        int s, t; row_to_seq(m, s, t);
        float rowp, colp; if (t < NMETA) { rowp = -1.0f; colp = (float)t; } else { const int jj = t - NMETA; rowp = (float)(jj >> 6); colp = (float)(jj & 63); }
        const float pos = seg ? colp : rowp;
        const float rv0 = pos * invf0 * 0.15915494309189535f, rv1 = pos * invf1 * 0.15915494309189535f;
        const float sn0 = __builtin_amdgcn_sinf(rv0), cs0 = __builtin_amdgcn_cosf(rv0), sn1 = __builtin_amdgcn_sinf(rv1), cs1 = __builtin_amdgcn_cosf(rv1);
        bf16* rowb = PR + (size_t)m * NIN;
        unsigned wA[10], wB[10];
#pragma unroll
        for (int it = 8; it < 10; ++it) { const int hd = 2 * it + h2; const bf16* hp = rowb + (it < 8 ? COL_Q + hd * HD : COL_K + (hd - NQH) * HD);
            wA[it] = *(const unsigned*)(hp + idxA); wB[it] = *(const unsigned*)(hp + idxB); }
#pragma unroll
        for (int it = 8; it < 10; ++it) { const int hd = 2 * it + h2; bf16* hp = (it < 8) ? rowb + COL_Q + hd * HD : KC + (kc_row(s, hd - NQH) + t) * HD;
            const float a0 = bflo(wA[it]), a1 = bfhi(wA[it]), b0 = bflo(wB[it]), b1 = bfhi(wB[it]);
            float ss = (a0 * a0 + a1 * a1) + (b0 * b0 + b1 * b1);
            ss += xshfl<1>(ss); ss += xshfl<2>(ss); ss += xshfl<4>(ss); ss += xshfl<8>(ss); ss += xshfl<16>(ss);
            const float rstd = __builtin_amdgcn_rsqf(ss * (1.0f / HD) + QK_EPS);
            const float n1a = a0 * rstd * (it < 8 ? gqA0 : gkA0), n1b = a1 * rstd * (it < 8 ? gqA1 : gkA1), n2a = b0 * rstd * (it < 8 ? gqB0 : gkB0), n2b = b1 * rstd * (it < 8 ? gqB1 : gkB1);
            *(unsigned*)(hp + idxA) = pk2(n1a * cs0 - n2a * sn0, n1b * cs1 - n2b * sn1);
            *(unsigned*)(hp + idxB) = pk2(n2a * cs0 + n1a * sn0, n2b * cs1 + n1b * sn1); }
    }
}
__device__ __forceinline__ void phase_vcopy(CPtrs& P, int gw, int NGW, int lane) {
    const bf16* PR = (const bf16*)(P.ws + WS_PROJ); bf16* KC = (bf16*)(P.ws + WS_KC); bf16* VC = (bf16*)(P.ws + WS_VC);
    const int kvh = lane >> 4, e = (lane & 15) * 8;
    (void)kvh; (void)e; (void)PR;
    constexpr int PADP = LPP - LP, PADS = LSP - LS, NPAD = 2 * NKVH * PADP + 2 * NKVH * PADS;
    for (int r = gw; r < NPAD; r += NGW) { int s, q = r; if (q < 2 * NKVH * PADP) { s = q / (NKVH * PADP); q -= s * NKVH * PADP; } else { q -= 2 * NKVH * PADP; s = 2 + q / (NKVH * PADS); q -= (s - 2) * NKVH * PADS; }
        const int pad = s < 2 ? PADP : PADS, kv = q / pad, t = seq_len(s) + q % pad;
        if (lane < 16) { unsigned z0 = 0u; asm volatile("" : "+v"(z0)); const v4u z = {z0, z0, z0, z0}; *(v4u*)(KC + (kc_row(s, kv) + t) * HD + lane * 8) = z; } }
}
__device__ __forceinline__ void hy_item(int it, int& s, int& tt, int& ct) {
    constexpr int NTP = (LP + 31) / 32, NTS = (LS + 31) / 32;
    int r = it; if (r < 2 * NTP * 8) { s = r / (NTP * 8); r -= s * NTP * 8; } else { r -= 2 * NTP * 8; s = 2 + r / (NTS * 8); r -= (s - 2) * NTS * 8; }
    ct = r & 7; tt = r >> 3;
}
constexpr int HY_NITEM = 2 * ((LP + 31) / 32) * 8 + 2 * ((LS + 31) / 32) * 8;
__device__ __forceinline__ void phase_hy_pre(CPtrs& P, int layer, LAS unsigned char* lds, int gw, int NGW, int wave, int lane) {
    const bf16* PR = (const bf16*)(P.ws + WS_PROJ); zt_t* ZT = (zt_t*)(P.ws + WS_ZT);
    LAS float* tile = (LAS float*)(lds + wave * 16896);
    const float* cw = P.conv_w + (size_t)layer * 3 * 3 * DHY; const float* cb = P.conv_b + (size_t)layer * 3 * DHY;
    const int half = lane >> 5, tl5 = lane & 31;
    for (int it = gw; it < HY_NITEM; it += NGW) {
        int s, tt, ct; hy_item(it, s, tt, ct);
        const int L = seq_len(s), row0 = seq_row0(s), t0 = tt * 32, c0 = ct * 128 + 2 * lane;
        unsigned xr[34], vr[34];
#pragma unroll
        for (int i = 0; i < 34; ++i) { const int t = t0 - 1 + i; const bool ok = (t >= 0 && t < L); const bf16* rp = PR + (size_t)(row0 + (ok ? t : 0)) * NIN + c0;
            const unsigned xa = *(const unsigned*)(rp + DHY), va = *(const unsigned*)(rp + 2 * DHY); xr[i] = ok ? xa : 0u; vr[i] = ok ? va : 0u; }
        float wx[3][2], wv[3][2], bx[2], bv[2];
#pragma unroll
        for (int k = 0; k < 3; ++k) { wx[k][0] = cw[k * 3 * DHY + DHY + c0]; wx[k][1] = cw[k * 3 * DHY + DHY + c0 + 1]; wv[k][0] = cw[k * 3 * DHY + 2 * DHY + c0]; wv[k][1] = cw[k * 3 * DHY + 2 * DHY + c0 + 1]; }
        bx[0] = cb[DHY + c0]; bx[1] = cb[DHY + c0 + 1]; bv[0] = cb[2 * DHY + c0]; bv[1] = cb[2 * DHY + c0 + 1];
#pragma unroll
        for (int q = 0; q < 32; ++q) {
            const float x0 = wx[0][0] * bflo(xr[q]) + wx[1][0] * bflo(xr[q + 1]) + wx[2][0] * bflo(xr[q + 2]) + bx[0], x1 = wx[0][1] * bfhi(xr[q]) + wx[1][1] * bfhi(xr[q + 1]) + wx[2][1] * bfhi(xr[q + 2]) + bx[1];
            const float v0 = wv[0][0] * bflo(vr[q]) + wv[1][0] * bflo(vr[q + 1]) + wv[2][0] * bflo(vr[q + 2]) + bv[0], v1 = wv[0][1] * bfhi(vr[q]) + wv[1][1] * bfhi(vr[q + 1]) + wv[2][1] * bfhi(vr[q + 2]) + bv[1];
            tile[lane * 33 + q] = x0 * v0; tile[2112 + lane * 33 + q] = x1 * v1;
        }
        LDS_WAIT(); asm volatile("" ::: "memory");
        zt_t* zb = ZT + zt_off(s) + (size_t)(ct * 128 + half) * L + t0 + tl5;
        if (t0 + tl5 < L) {
#pragma unroll 16
            for (int cc = 0; cc < 64; ++cc) zb[(size_t)(2 * cc) * L] = (zt_t)tile[half * 2112 + cc * 33 + tl5];
        }
        LDS_WAIT(); asm volatile("" ::: "memory");
    }
}
__device__ __forceinline__ void phase_hy_post(CPtrs& P, int layer, LAS unsigned char* lds, int gw, int NGW, int wave, int lane) {
    const bf16* PR = (const bf16*)(P.ws + WS_PROJ); const zt_t* ZT = (const zt_t*)(P.ws + WS_ZT); bf16* YH = (bf16*)(P.ws + WS_YHY);
    LAS float* tile = (LAS float*)(lds + wave * 16896);
    const float* cw = P.conv_w + (size_t)layer * 3 * 3 * DHY; const float* cb = P.conv_b + (size_t)layer * 3 * DHY;
    const int half = lane >> 5, tl5 = lane & 31;
    for (int it = gw; it < HY_NITEM; it += NGW) {
        int s, tt, ct; hy_item(it, s, tt, ct);
        const int L = seq_len(s), row0 = seq_row0(s), t0 = tt * 32, c0 = ct * 128 + 2 * lane;
        unsigned xr[34];
#pragma unroll
        for (int i = 0; i < 34; ++i) { const int t = t0 - 1 + i; const bool ok = (t >= 0 && t < L); const unsigned xa = *(const unsigned*)(PR + (size_t)(row0 + (ok ? t : 0)) * NIN + c0); xr[i] = ok ? xa : 0u; }
        { const bool okt = (t0 + tl5 < L); const zt_t* zb = ZT + zt_off(s) + (size_t)(ct * 128 + half) * L + (okt ? t0 + tl5 : 0);
#pragma unroll 16
          for (int cc = 0; cc < 64; ++cc) { const float z = (float)zb[(size_t)(2 * cc) * L]; tile[half * 2112 + cc * 33 + tl5] = okt ? z : 0.f; } }
        float wx[3][2], bx[2];
#pragma unroll
        for (int k = 0; k < 3; ++k) { wx[k][0] = cw[k * 3 * DHY + c0]; wx[k][1] = cw[k * 3 * DHY + c0 + 1]; }
        bx[0] = cb[c0]; bx[1] = cb[c0 + 1];
        LDS_WAIT(); asm volatile("" ::: "memory");
#pragma unroll
        for (int q = 0; q < 32; ++q) {
            const float x0 = wx[0][0] * bflo(xr[q]) + wx[1][0] * bflo(xr[q + 1]) + wx[2][0] * bflo(xr[q + 2]) + bx[0], x1 = wx[0][1] * bfhi(xr[q]) + wx[1][1] * bfhi(xr[q + 1]) + wx[2][1] * bfhi(xr[q + 2]) + bx[1];
            if (t0 + q < L) *(unsigned*)(YH + (size_t)(row0 + t0 + q) * DYC + c0) = pk2(x0 * tile[lane * 33 + q], x1 * tile[2112 + lane * 33 + q]);
        }
        LDS_WAIT(); asm volatile("" ::: "memory");
    }
}
constexpr int NFB_P = LP / 256, NFB_S = LS / 256;
static_assert(LP - NFB_P * 256 == 16 && LS - NFB_S * 256 == 16 && ((LP + 63) / 64) % 2 == 1 && ((LS + 63) / 64) % 2 == 1, "attention unit geometry (odd tile counts)");
constexpr int NU_SP = NQH * NFB_P + NKVH, NU_SS = NQH * NFB_S + NKVH;
constexpr int NU_AP = 2 * NU_SP, NU_AS = 2 * NU_SS, NU_ATT = NU_AP + NU_AS;
constexpr int NU_MIX = NU_ATT + 2 * DHY;
__device__ __forceinline__ int mix_fetch(volatile LAS unsigned* MISC, unsigned* qctr) {
    __syncthreads();
    if (threadIdx.x == 0) MISC[16] = __hip_atomic_fetch_add(qctr, 1u, __ATOMIC_RELAXED, __HIP_MEMORY_SCOPE_AGENT);
    __syncthreads();
    return __builtin_amdgcn_readfirstlane((int)MISC[16]);
}
__device__ __forceinline__ int mix_complete(volatile LAS unsigned* MISC, unsigned v) {
    __syncthreads();
    int t = threadIdx.x; asm volatile("" : "+v"(t));
    if (t == 0) MISC[16] = v;
    __syncthreads();
    return __builtin_amdgcn_readfirstlane((int)MISC[16]);
}
#ifndef MIX_MASK
#define MIX_MASK 7
#endif
#define FFT_REPS ((REP_MASK >> 16 & 1u) ? 2 : 1)
#define PROBE_SKIP ((int)(REP_MASK >> 24 & 15u))
template <int MODE  >
__device__ __forceinline__ void phase_mix(CPtrs& P, int layer, unsigned char* ldsg, volatile LAS unsigned* MISC, unsigned* qctr) {
    int u = mix_fetch(MISC, qctr); unsigned nxt = 0u;
    while (u < NU_ATT) {
        if (MIX_MASK & 1) {
            const bf16* PR = (const bf16*)(P.ws + WS_PROJ); bf16* YA = (bf16*)(P.ws + WS_YHY) + DHY; const bf16* KC = (const bf16*)(P.ws + WS_KC); const bf16* VC = (const bf16*)(P.ws + WS_VC);
            int s, r, L, nfb;
            if (u < NU_AP) { s = u / NU_SP; r = u % NU_SP; L = LP; nfb = NFB_P; } else { const int v = u - NU_AP; s = 2 + v / NU_SS; r = v % NU_SS; L = LS; nfb = NFB_S; }
            int hd, q0, qvalid, packed;
            if (r < NQH * nfb) { hd = r / nfb; q0 = (r % nfb) * 256; qvalid = 256; packed = 0; } else { hd = 4 * (r - NQH * nfb); q0 = nfb * 256; qvalid = 64; packed = 1; }
            const int row0 = seq_row0(s), kvh = hd >> 2, NT = (L + 63) / 64;
            att::attn_unit(PR + (size_t)(row0 + q0) * NIN + COL_Q + hd * HD, qvalid, packed, KC + kc_row(s, kvh) * HD, PR + (size_t)row0 * NIN + COL_V + kvh * HD,
                           YA + (size_t)(row0 + q0) * DYC + hd * HD, L, NT, (char*)ldsg, qctr, nxt, P.q_norm + layer * HD, q0);
        }
        u = mix_complete(MISC, nxt);
    }
    if (MODE == 1) return;
    while (u < NU_ATT + DHY) {
        if (MIX_MASK & 2) {
            zt_t* ZT = (zt_t*)(P.ws + WS_ZT); const int c = u - NU_ATT;
            FiltArgs fa; fa.tf = (const zt_t*)(P.ws + WS_G) + (size_t)c * LP; fa.tb = fa.tf + (size_t)DHY * LP; fa.skip = P.skip + (size_t)layer * DHY;
            for (int rp = 0; rp < FFT_REPS; ++rp) conv_unit<16384, 4>(rp == FFT_REPS - 1, rp == FFT_REPS - 1 ? 0 : PROBE_SKIP, (char*)ldsg, fa, c, LP, ZT + zt_off(0) + (size_t)c * LP, ZT + zt_off(1) + (size_t)c * LP, qctr, nxt);
        }
        u = mix_complete(MISC, nxt);
    }
    while (u < NU_MIX) {
        if (MIX_MASK & 4) {
            zt_t* ZT = (zt_t*)(P.ws + WS_ZT); const int c = u - NU_ATT - DHY;
            FiltArgs fa; fa.tf = (const zt_t*)(P.ws + WS_G) + (size_t)2 * DHY * LP + (size_t)c * LS; fa.tb = fa.tf + (size_t)DHY * LS; fa.skip = P.skip + (size_t)layer * DHY;
            for (int rp = 0; rp < FFT_REPS; ++rp) conv_unit<8192, 2>(rp == FFT_REPS - 1, rp == FFT_REPS - 1 ? 0 : PROBE_SKIP, (char*)ldsg, fa, c, LS, ZT + zt_off(2) + (size_t)c * LS, ZT + zt_off(3) + (size_t)c * LS, qctr, nxt);
        }
        u = mix_complete(MISC, nxt);
    }
}

__device__ __forceinline__ CPtrs* lsp(CPtrs* p) { asm volatile("" : "+s"(p)); return p; }
__device__ __forceinline__ int lvg(int v) { asm volatile("" : "+v"(v)); return v; }
__device__ __forceinline__ int lsg(int v) { asm volatile("" : "+s"(v)); return v; }
#ifndef W2_WGM
#define W2_WGM 4
#endif
#ifndef W2_REV
#define W2_REV 0
#endif
constexpr int MMAIN = 24576, MTAIL0 = MMAIN;
static_assert(NTOK - MMAIN == 64, "tail panel is exactly 64 rows");
constexpr int NPH_LAYER = 14, NPHASES = 1 + DEPTH * NPH_LAYER;
struct Args { Ptrs p; int ph_lo, ph_hi; };
__global__ void __launch_bounds__(512, 2) fwd(Args args) {
    extern __shared__ __attribute__((aligned(16))) unsigned char lds[];
    CPtrs* Pk = (CPtrs*)__builtin_amdgcn_kernarg_segment_ptr();
#define P (*lsp(Pk))
    LAS unsigned char* ldsl = (LAS unsigned char*)lds;
    volatile LAS unsigned* MISC = (volatile LAS unsigned*)(ldsl + LDS_MISC);
    const int tid = threadIdx.x, lane = tid & 63, wave = __builtin_amdgcn_readfirstlane(tid >> 6);
    const int G = gridDim.x, gw = blockIdx.x * 8 + wave, NGW = G * 8;
    if (tid < 64) MISC[tid] = 0u;
    __syncthreads();
    unsigned* ctl = (unsigned*)(P.ws + WS_CTL);
    const int lo = args.ph_lo, hi = args.ph_hi;
    const bool multi = (hi - lo) > 1;
    XcdBarrier bar; bar.bar = ctl + CW_BAR; bar.x = 0; bar.st = nullptr;
    if (multi) bar = xcd_barrier_post(ctl + CW_BAR, MISC + 8);
#ifndef PH_MASK
#define PH_MASK 0xFFFFFFFFu
#endif
#ifndef REP_MASK
#define REP_MASK 0u
#endif
#define NREP(j) ((REP_MASK >> (j) & 1u) ? 2 : 1)
#define INP(k, j) ((PH_MASK >> (j) & 1u) && lo <= (k) && (k) < hi)
#define IN(k) (lo <= (k) && (k) < hi)
#define SEAM(k) do { if (IN(k) && (k) + 1 < hi) xcd_barrier(bar); } while (0)
    if (INP(0, 14)) { phase_init(P, gw, NGW, lane); phase_filter_hidden(P, gw, NGW, lane); }
    SEAM(0);
    const pg8::bf16_t* HB = (const pg8::bf16_t*)(P.ws + (MMA_F16 ? WS_H32 : WS_HB));
    pg8::bf16_t* PROJ = (pg8::bf16_t*)(P.ws + WS_PROJ);
    bf16* RBw = MMA_F16 ? (bf16*)nullptr : (bf16*)(P.ws + WS_HB);
#define STAT(i) ((float*)((long long*)(P.ws + WS_ST) + (size_t)(i) * MPAD * 2))
    for (int layer = 0; layer < DEPTH; ++layer) {
        const int pb = 1 + layer * NPH_LAYER;
        const int sA = layer == 0 ? 0 : 3 * layer, sI = 1 + 3 * layer, sB = 2 + 3 * layer, sC = 3 + 3 * layer;
        const int lnA = layer == 0 ? -1 : (layer - 1) * 3 + 2, lnI = layer * 3, lnB = layer * 3 + 1;
        const float* CSl = (const float*)(P.ws + WS_CS) + (size_t)layer * 2 * NCS; const float* CBl = (const float*)(P.ws + WS_CB) + (size_t)layer * 2 * NCS;
        for (int rep = 0; rep < NREP(0); ++rep) { if (rep) xcd_barrier(bar);
        if (INP(pb + 0, 0)) { phase_convert(P, layer, ldsl, lsg(gw), lsg(NGW), lsg(wave), lvg(lane)); phase_taps(P, layer, lsg(gw), lsg(NGW), lvg(lane)); }
        }
        SEAM(pb + 0);
        for (int rep = 0; rep < NREP(1); ++rep) { if (rep) xcd_barrier(bar);
        if (INP(pb + 1, 1)) {
            pg8::Gemm g{HB, (const pg8::bf16_t*)(P.ws + WS_W13A), MPAD, 2 * DFF, DM}; pg8::StaticOrder S; S.init(MPAD, 2 * DFF, lsg(G), lsg((int)blockIdx.x));
            pg8::EpiSwiglu E{PROJ, DFF, STAT(sA), CSl + CS_W13A, CBl + CS_W13A};
            pg8::gemm_phase<pg8::EpiSwiglu, pg8::StaticOrder, true, true, MMA_F16 != 0>(ldsl, g, S, E);
        }
        }
        SEAM(pb + 1);
        if (INP(pb + 2, 2)) {
            pg8::Gemm g{PROJ, (const pg8::bf16_t*)(P.ws + WS_W2A), MMAIN, DM, DFF}; pg8::StaticOrder S; S.init(MMAIN, DM, lsg(G), lsg((int)blockIdx.x), W2_WGM, W2_REV);
            pg8::EpiResid E{(pg8::bf16_t*)(P.ws + WS_H32), (pg8::bf16_t*)RBw, DM, ALPHA, 0.5f, STAT(sA), ln_gain(P, lnA), ln_bias(P, lnA), STAT(sI)};
            gemm_tail(ldsl, (const bf16*)PROJ + (size_t)MTAIL0 * DFF, (const bf16*)(P.ws + WS_W2A), DM, DFF, MTAIL0, E, lsg(G), lsg((int)blockIdx.x));
            pg8::gemm_phase<pg8::EpiResid, pg8::StaticOrder, true, true>(ldsl, g, S, E);
        }
        SEAM(pb + 2);
        for (int rep = 0; rep < NREP(4); ++rep) { if (rep) xcd_barrier(bar);
        if (INP(pb + 4, 4)) {
            pg8::Gemm g{HB, (const pg8::bf16_t*)(P.ws + WS_WIN), MMAIN, NIN, DM}; pg8::StaticOrder S; S.init(MMAIN, NIN, lsg(G), lsg((int)blockIdx.x));
            pg8::EpiProj E{PROJ, NIN, P.b_gate + (size_t)layer * 2 * DM, COL_G, STAT(sI), CSl + CS_WIN, CBl + CS_WIN};
            { pg8::EpiProjTail ET{E}; gemm_tail(ldsl, (const bf16*)HB + (size_t)MTAIL0 * DM, (const bf16*)(P.ws + WS_WIN), NIN, DM, MTAIL0, ET, lsg(G), lsg((int)blockIdx.x)); }
            pg8::gemm_phase<pg8::EpiProj, pg8::StaticOrder, true, true, MMA_F16 != 0>(ldsl, g, S, E);
        }
        }
        SEAM(pb + 4);
        if (INP(pb + 5, 5)) {
            if (wave & 1) { phase_hy_pre(P, layer, ldsl, lsg(gw), lsg(NGW), lsg(wave), lvg(lane)); phase_vcopy(P, lsg(gw), lsg(NGW), lvg(lane)); phase_qkprep(P, layer, lsg(gw), lsg(NGW), lvg(lane)); }
            else { phase_qkprep(P, layer, lsg(gw), lsg(NGW), lvg(lane)); phase_vcopy(P, lsg(gw), lsg(NGW), lvg(lane)); phase_hy_pre(P, layer, ldsl, lsg(gw), lsg(NGW), lsg(wave), lvg(lane)); }
            if (NREP(5) > 1) { xcd_barrier(bar); phase_vcopy(P, lsg(gw), lsg(NGW), lvg(lane)); phase_hy_pre(P, layer, ldsl, lsg(gw), lsg(NGW), lsg(wave), lvg(lane)); } }
        SEAM(pb + 5);
        if (INP(pb + 6, 6)) { phase_mix<0>(P, layer, lds, MISC, ctl + CW_Q + 64 * layer);
            if (NREP(6) > 1) { xcd_barrier(bar); phase_mix<1>(P, layer, lds, MISC, ctl + CW_Q + 64 * (DEPTH + layer)); } }
        SEAM(pb + 6);
        for (int rep = 0; rep < NREP(7); ++rep) { if (rep) xcd_barrier(bar);
        if (INP(pb + 7, 7)) phase_hy_post(P, layer, ldsl, lsg(gw), lsg(NGW), lsg(wave), lvg(lane));
        }
        SEAM(pb + 7);
        for (int rep = 0; rep < NREP(8); ++rep) { if (rep) xcd_barrier(bar);
        if (INP(pb + 8, 8)) {
            pg8::Gemm g{(const pg8::bf16_t*)(P.ws + WS_YHY), (const pg8::bf16_t*)(P.ws + WS_WBH), MMAIN, DM, DYC}; pg8::StaticOrder S; S.init(MMAIN, DM, lsg(G), lsg((int)blockIdx.x), W2_WGM, W2_REV);
            pg8::EpiGate2 E{(pg8::bf16_t*)(P.ws + WS_G), DM, PROJ + COL_G, NIN};
            gemm_tail2(ldsl, (const bf16*)(P.ws + WS_YHY) + (size_t)MTAIL0 * DYC, (const bf16*)(P.ws + WS_WBH), DM, DYC, DHY, MTAIL0, E, lsg(G), lsg((int)blockIdx.x));
            pg8::gemm_phase<pg8::EpiGate2, pg8::StaticOrder, true, true>(ldsl, g, S, E);
        }
        }
        SEAM(pb + 8);
        if (INP(pb + 9, 9)) {
            pg8::Gemm g{(const pg8::bf16_t*)(P.ws + WS_G), (const pg8::bf16_t*)(P.ws + WS_WOUT), MMAIN, DM, DM}; pg8::StaticOrder S; S.init(MMAIN, DM, lsg(G), lsg((int)blockIdx.x), W2_WGM, W2_REV);
            pg8::EpiResid E{(pg8::bf16_t*)(P.ws + WS_H32), (pg8::bf16_t*)RBw, DM, ALPHA, 1.0f, STAT(sI), ln_gain(P, lnI), ln_bias(P, lnI), STAT(sB)};
            gemm_tail(ldsl, (const bf16*)(P.ws + WS_G) + (size_t)MTAIL0 * DM, (const bf16*)(P.ws + WS_WOUT), DM, DM, MTAIL0, E, lsg(G), lsg((int)blockIdx.x));
            pg8::gemm_phase<pg8::EpiResid, pg8::StaticOrder, true, true>(ldsl, g, S, E);
        }
        SEAM(pb + 9);
        for (int rep = 0; rep < NREP(11); ++rep) { if (rep) xcd_barrier(bar);
        if (INP(pb + 11, 11)) {
            pg8::Gemm g{HB, (const pg8::bf16_t*)(P.ws + WS_W13B), MPAD, 2 * DFF, DM}; pg8::StaticOrder S; S.init(MPAD, 2 * DFF, lsg(G), lsg((int)blockIdx.x));
            pg8::EpiSwiglu E{PROJ, DFF, STAT(sB), CSl + CS_W13B, CBl + CS_W13B};
            pg8::gemm_phase<pg8::EpiSwiglu, pg8::StaticOrder, true, true, MMA_F16 != 0>(ldsl, g, S, E);
        }
        }
        SEAM(pb + 11);
        if (INP(pb + 12, 12)) {
            pg8::Gemm g{PROJ, (const pg8::bf16_t*)(P.ws + WS_W2B), MMAIN, DM, DFF}; pg8::StaticOrder S; S.init(MMAIN, DM, lsg(G), lsg((int)blockIdx.x), W2_WGM, W2_REV);
            pg8::EpiResid E{(pg8::bf16_t*)(P.ws + WS_H32), (pg8::bf16_t*)(layer == DEPTH - 1 ? (bf16*)nullptr : RBw), DM, ALPHA, 0.5f, STAT(sB), ln_gain(P, lnB), ln_bias(P, lnB), STAT(sC)};
            gemm_tail(ldsl, (const bf16*)PROJ + (size_t)MTAIL0 * DFF, (const bf16*)(P.ws + WS_W2B), DM, DFF, MTAIL0, E, lsg(G), lsg((int)blockIdx.x));
            pg8::gemm_phase<pg8::EpiResid, pg8::StaticOrder, true, true>(ldsl, g, S, E);
        }
        SEAM(pb + 12);
        if (layer == DEPTH - 1 && INP(pb + 13, 13)) phase_ln_out(P, P.ln_g + ((size_t)layer * 3 + 2) * DM, P.ln_b + ((size_t)layer * 3 + 2) * DM, lsg(gw), lsg(NGW), lvg(lane));
    }
#undef STAT
#undef IN
#undef SEAM
#undef P
}

#ifndef MK_N_LAUNCHES
#define MK_N_LAUNCHES 1
#endif
extern "C" void kernel_launch(void* const* d_in, const int* in_sizes, int n_in, void* d_out, int out_size, void* d_ws, size_t ws_size, hipStream_t stream) {
    static int grid = 0;
    if (grid == 0) {
        if (n_in != 25 || ws_size < WS_END) { fprintf(stderr, "kernel_launch: n_in %d ws %zu need %zu\n", n_in, ws_size, (size_t)WS_END); grid = -1; return; }
        int dev = 0, cus = 0, per_cu = 0;
        if (hipGetDevice(&dev) != hipSuccess || hipDeviceGetAttribute(&cus, hipDeviceAttributeMultiprocessorCount, dev) != hipSuccess) { grid = -1; return; }
        if (hipFuncSetAttribute((const void*)fwd, hipFuncAttributeMaxDynamicSharedMemorySize, LDS_BYTES) != hipSuccess) { fprintf(stderr, "kernel_launch: hipFuncSetAttribute failed\n"); grid = -1; return; }
        if (hipOccupancyMaxActiveBlocksPerMultiprocessor(&per_cu, (const void*)fwd, 512, LDS_BYTES) != hipSuccess || per_cu < 1) { fprintf(stderr, "kernel_launch: occupancy query says %d\n", per_cu); grid = -1; (void)hipGetLastError(); return; }
        grid = cus;
    }
    if (grid < 0) return;
    if (hipMemsetAsync((char*)d_ws + WS_CTL, 0, CTL_ZERO_BYTES, stream) != hipSuccess) return;
    Args a{};
    const float** pp = (const float**)&a.p;
    for (int i = 0; i < 25; ++i) pp[i] = (const float*)d_in[i];
    a.p.out = (float*)d_out; a.p.ws = (unsigned char*)d_ws;
#if MK_N_LAUNCHES == 1
    a.ph_lo = 0; a.ph_hi = NPHASES;
    hipLaunchKernelGGL(fwd, dim3(grid), dim3(512), LDS_BYTES, stream, a);
#else
    for (int ph = 0; ph < NPHASES; ++ph) { a.ph_lo = ph; a.ph_hi = ph + 1; hipLaunchKernelGGL(fwd, dim3(grid), dim3(512), LDS_BYTES, stream, a); }
#endif
}
```

```cpp
#ifndef REP_MASK
#define REP_MASK 0u
#endif
#include <hip/hip_runtime.h>
#include <cstdio>
#include <cstdint>
#include <math.h>

constexpr int DM = 2048, DEPTH = 4, NMETA = 16, DFF = 5632, NIN = 10240, DHY = 1024, HD = 128, NQH = 16, NKVH = 4;
constexpr int SP = 8192, SS = 4096, LP = SP + NMETA, LS = SS + NMETA;
constexpr int NTOK = 2 * LP + 2 * LS;
constexpr int MPAD = 24832;
constexpr int COL_Q = 3072, COL_K = 5120, COL_V = 5632, COL_G = 6144;
constexpr float LN_EPS = 1e-5f, QK_EPS = 1e-6f;
constexpr float ALPHA = 1.6817928305074290f;
constexpr int FILT_EMB = 33, FILT_W = 64;
__host__ __device__ __forceinline__ int seq_row0(int s) { return s == 0 ? 0 : (s == 1 ? LP : (s == 2 ? 2 * LP : 2 * LP + LS)); }
__host__ __device__ __forceinline__ int seq_len(int s) { return s < 2 ? LP : LS; }

constexpr size_t MiB = 1u << 20;
constexpr size_t al256(size_t x) { return (x + 255) / 256 * 256; }
constexpr size_t WS_CTL = 0, CTL_ZERO_BYTES = 1 * MiB;
constexpr size_t W13_E = (size_t)2 * DFF * DM, W2_E = (size_t)DM * DFF, WIN_E = (size_t)NIN * DM, WBH_E = (size_t)DM * DHY, WBA_E = (size_t)DM * DM, WOUT_E = (size_t)DM * DM;
constexpr size_t WS_W13A = 1 * MiB, WS_W2A = WS_W13A + 2 * W13_E, WS_WIN = WS_W2A + 2 * W2_E, WS_WBH = WS_WIN + 2 * WIN_E, WS_WBA = WS_WBH + 2 * WBH_E, WS_WOUT = WS_WBA + 2 * WBA_E,
                 WS_W13B = WS_WOUT + 2 * WOUT_E, WS_W2B = WS_W13B + 2 * W13_E, WS_WEND = WS_W2B + 2 * W2_E;
constexpr size_t WS_H32 = al256(WS_WEND);
constexpr size_t WS_HB = WS_H32 + (size_t)MPAD * DM * 4;
constexpr size_t WS_PROJ = WS_HB + (size_t)MPAD * DM * 2;
constexpr size_t WS_ZT = WS_PROJ + (size_t)MPAD * NIN * 2;
constexpr size_t ZT_E = (size_t)2 * DHY * LP + (size_t)2 * DHY * LS;
constexpr int DYC = DHY + DM;
constexpr size_t WS_YHY = al256(WS_ZT + ZT_E * 4);
constexpr size_t WS_YAT = WS_YHY + (size_t)MPAD * DHY * 2;
constexpr size_t WS_G = WS_YAT + (size_t)MPAD * DM * 2;
constexpr size_t WS_H2 = WS_G + (size_t)MPAD * DM * 2;
constexpr size_t WS_W3T = WS_H2 + (size_t)DEPTH * 2 * LP * FILT_W * 2;
static_assert((size_t)2 * DHY * (LP + LS) * 4 <= (size_t)MPAD * DM * 2, "taps fit in G");
constexpr int LPP = 130 * 64, LSP = 66 * 64;
constexpr size_t KC_E = (size_t)(2 * LPP + 2 * LSP) * NKVH * HD;
constexpr size_t WS_KC = al256(WS_W3T + (size_t)DEPTH * 2 * DHY * FILT_W * 2);
constexpr size_t WS_VC = WS_KC + KC_E * 2;
constexpr size_t WS_ST = al256(WS_VC + KC_E * 2);
constexpr int NSTAT = 1 + 3 * DEPTH;
constexpr size_t WS_CS = WS_ST + (size_t)NSTAT * MPAD * 2 * 8;
constexpr int NCS = 2 * DFF + NIN + 2 * DFF, CS_W13A = 0, CS_WIN = 2 * DFF, CS_W13B = 2 * DFF + NIN;
constexpr size_t WS_CB = WS_CS + (size_t)DEPTH * NCS * 8;
constexpr size_t WS_ONE = WS_CB + (size_t)DEPTH * NCS * 8;
constexpr size_t WS_END = WS_ONE + 2 * DM * 4;
__host__ __device__ __forceinline__ size_t kc_row(int s, int kvh) { return (s < 2 ? (size_t)s * NKVH * LPP + (size_t)kvh * LPP : (size_t)2 * NKVH * LPP + (size_t)(s - 2) * NKVH * LSP + (size_t)kvh * LSP); }
typedef _Float16 zt_t;
__host__ __device__ __forceinline__ size_t zt_off(int s) { return s == 0 ? 0 : (s == 1 ? (size_t)DHY * LP : (s == 2 ? (size_t)2 * DHY * LP : (size_t)2 * DHY * LP + (size_t)DHY * LS)); }
constexpr int CW_BAR = 4096;
constexpr int CW_Q = 16384;

constexpr int LDS_FFT_BYTES = (16384 + 16384 / 32) * 8;
constexpr int LDS_SIDE = LDS_FFT_BYTES;
constexpr int LDS_MISC = LDS_SIDE + 2048;
constexpr int LDS_BYTES = 147456;
static_assert(LDS_MISC + 256 <= LDS_BYTES, "LDS map");

#define GAS __attribute__((address_space(1)))
#define LAS __attribute__((address_space(3)))
typedef unsigned short bf16;
typedef unsigned v4u __attribute__((ext_vector_type(4)));
typedef unsigned v2u __attribute__((ext_vector_type(2)));
typedef float f32x4 __attribute__((ext_vector_type(4)));
typedef short bf16x8 __attribute__((ext_vector_type(8)));
#define LDS_WAIT() asm volatile("s_waitcnt lgkmcnt(0)" ::: "memory")
#define VM_WAIT() asm volatile("s_waitcnt vmcnt(0)" ::: "memory")
__device__ __forceinline__ unsigned pk2(float lo, float hi) { unsigned r; asm volatile("v_cvt_pk_bf16_f32 %0, %1, %2" : "=v"(r) : "v"(lo), "v"(hi)); return r; }
__device__ __forceinline__ unsigned f2bf(float f) { return pk2(f, 0.f) & 0xffffu; }
__device__ __forceinline__ float bf2f(unsigned short b) { return __builtin_bit_cast(float, ((unsigned)b) << 16); }
__device__ __forceinline__ float bflo(unsigned w) { return __builtin_bit_cast(float, w << 16); }
__device__ __forceinline__ float bfhi(unsigned w) { return __builtin_bit_cast(float, w & 0xffff0000u); }
__device__ __forceinline__ unsigned mix_issue(unsigned* qctr) {
    unsigned v = 0u; int t = threadIdx.x; asm volatile("" : "+v"(t));
    if (t == 0) v = __hip_atomic_fetch_add(qctr, 1u, __ATOMIC_RELAXED, __HIP_MEMORY_SCOPE_AGENT);
    return v;
}
template <int O> __device__ __forceinline__ float xshfl(float x) { return __builtin_bit_cast(float, __builtin_amdgcn_ds_swizzle(__builtin_bit_cast(int, x), (O << 10) | 0x1f)); }
__device__ __forceinline__ float xadd32(float x) {
    int l = (int)__builtin_amdgcn_mbcnt_hi(~0u, __builtin_amdgcn_mbcnt_lo(~0u, 0u)); asm volatile("" : "+v"(l));
    return x + __builtin_bit_cast(float, __builtin_amdgcn_ds_bpermute((l ^ 32) << 2, __builtin_bit_cast(int, x)));
}
__device__ __forceinline__ float wave_sum(float v) {
    v += xshfl<1>(v); v += xshfl<2>(v); v += xshfl<4>(v); v += xshfl<8>(v); v += xshfl<16>(v);
    return xadd32(v);
}
#ifdef __HIPCC__
#define FHD __host__ __device__ __forceinline__
#else
#define FHD inline
#endif

#if defined(__clang__)
typedef float cf __attribute__((ext_vector_type(2)));
FHD cf cmulc(cf a, cf b) { const cf t = a.xx * b; const cf s = a.yy * b.yx; cf r; r.x = t.x - s.x; r.y = t.y + s.y; return r; }
FHD cf cmul(cf a, cf b) {
#if defined(__HIP_DEVICE_COMPILE__)
    cf t, r;
    asm("v_pk_mul_f32 %0, %1, %2 op_sel:[0,0] op_sel_hi:[0,1]" : "=v"(t) : "v"(a), "v"(b));
    asm("v_pk_fma_f32 %0, %1, %2, %3 op_sel:[1,1,0] op_sel_hi:[1,0,1] neg_lo:[1,0,0]" : "=v"(r) : "v"(a), "v"(b), "v"(t));
    return r;
#else
    return cmulc(a, b);
#endif
}
FHD cf cadd(cf a, cf b) { return a + b; }
FHD cf csub(cf a, cf b) { return a - b; }
FHD cf cmulnegi(cf a) { cf r; r.x = a.y; r.y = -a.x; return r; }
#else
struct cf { float x, y; };
FHD cf cmul(cf a, cf b) { cf r; r.x = a.x * b.x - a.y * b.y; r.y = a.x * b.y + a.y * b.x; return r; }
FHD cf cadd(cf a, cf b) { cf r; r.x = a.x + b.x; r.y = a.y + b.y; return r; }
FHD cf csub(cf a, cf b) { cf r; r.x = a.x - b.x; r.y = a.y - b.y; return r; }
FHD cf cmulnegi(cf a) { cf r; r.x = a.y; r.y = -a.x; return r; }
#endif
FHD int fphys(int i) { return i + (i >> 5); }

FHD cf twid(float frac) {
    cf r;
#if defined(__HIP_DEVICE_COMPILE__)
    r.x = __builtin_amdgcn_cosf(frac); r.y = -__builtin_amdgcn_sinf(frac);
#else
    r.x = cosf(6.283185307179586f * frac); r.y = -sinf(6.283185307179586f * frac);
#endif
    return r;
}

FHD void dft4(cf& a0, cf& a1, cf& a2, cf& a3) {
    const cf s02 = cadd(a0, a2), d02 = csub(a0, a2), s13 = cadd(a1, a3), d13 = cmulnegi(csub(a1, a3));
    a0 = cadd(s02, s13); a2 = csub(s02, s13); a1 = cadd(d02, d13); a3 = csub(d02, d13);
}
template <int R> struct Dft;
template <> struct Dft<2> { static FHD void run(cf (&u)[2]) { const cf a = u[0], b = u[1]; u[0] = cadd(a, b); u[1] = csub(a, b); } };
template <> struct Dft<4> { static FHD void run(cf (&u)[4]) { dft4(u[0], u[1], u[2], u[3]); } };
template <> struct Dft<16> {
    static FHD void run(cf (&u)[16]) {
#pragma unroll
        for (int a = 0; a < 4; ++a) dft4(u[a], u[a + 4], u[a + 8], u[a + 12]);
        const float c1 = 0.92387953251128674f, s1 = 0.38268343236508978f, h = 0.70710678118654752f;
        const cf W1 = {c1, -s1}, W2 = {h, -h}, W3 = {s1, -c1}, W6 = {-h, -h}, W9 = {-c1, s1};
        u[1 + 4] = cmulc(u[1 + 4], W1); u[1 + 8] = cmulc(u[1 + 8], W2); u[1 + 12] = cmulc(u[1 + 12], W3);
        u[2 + 4] = cmulc(u[2 + 4], W2); u[2 + 8] = cmulnegi(u[2 + 8]);  u[2 + 12] = cmulc(u[2 + 12], W6);
        u[3 + 4] = cmulc(u[3 + 4], W3); u[3 + 8] = cmulc(u[3 + 8], W6); u[3 + 12] = cmulc(u[3 + 12], W9);
#pragma unroll
        for (int q = 0; q < 4; ++q) dft4(u[4 * q], u[4 * q + 1], u[4 * q + 2], u[4 * q + 3]);
#pragma unroll
        for (int q = 0; q < 4; ++q)
#pragma unroll
            for (int s = q + 1; s < 4; ++s) { const cf t = u[4 * q + s]; u[4 * q + s] = u[4 * s + q]; u[4 * s + q] = t; }
    }
};

FHD int launder(int t) {
#if defined(__HIP_DEVICE_COMPILE__)
    asm volatile("" : "+v"(t));
#endif
    return t;
}
template <int N, int R, int NT, int P> struct FPass {
    static constexpr int T = N / R, B = T / NT;
    static_assert(T % 32 == 0 && (P == 1 || P == 16 || P % 32 == 0), "offset algebra");
    static FHD void load(const cf* buf, int tid0, cf (&u)[B][R]) {
        const int tid = launder(tid0);
#pragma unroll
        for (int b = 0; b < B; ++b) { const cf* pb = buf + fphys(tid + b * NT);
#pragma unroll
            for (int r = 0; r < R; ++r) u[b][r] = pb[r * (T + T / 32)]; }
    }
    static FHD void compute(int tid0, cf (&u)[B][R]) {
        const int tid = launder(tid0);
#pragma unroll
        for (int b = 0; b < B; ++b) {
            const int i = tid + b * NT, k = i & (P - 1);
            if (P > 1) {
                cf w1 = twid((float)k * (1.0f / (float)(P * R)));
#if defined(__HIP_DEVICE_COMPILE__)
                { float one = 1.0f; asm volatile("" : "+v"(one)); w1 = w1 * one; }
#endif
                cf w = w1;
#pragma unroll
                for (int r = 1; r < R; ++r) { u[b][r] = cmul(u[b][r], w); if (r + 1 < R) w = cmul(w, w1); }
            }
            Dft<R>::run(u[b]);
        }
    }
    static FHD void store(cf* buf, int tid0, const cf (&u)[B][R]) {
        const int tid = launder(tid0);
#pragma unroll
        for (int b = 0; b < B; ++b) {
            const int i = tid + b * NT, k = i & (P - 1), j = (i - k) * R + k;
            cf* q = buf + fphys(j);
            if (P == 1) {
#pragma unroll
                for (int r = 0; r < R; ++r) q[r] = u[b][r];
            } else if (P == 16) {
                cf* qo = q + ((j >> 4) & 1);
#pragma unroll
                for (int r = 0; r < R; ++r) { if (r & 1) qo[16 * r + (r >> 1)] = u[b][r]; else q[16 * r + (r >> 1)] = u[b][r]; }
            } else {
#pragma unroll
                for (int r = 0; r < R; ++r) q[r * (P + P / 32)] = u[b][r];
            }
        }
    }
};
namespace pg8 {
#define PG8_LAS __attribute__((address_space(3)))
typedef unsigned short bf16_t;
typedef short bf16x8 __attribute__((ext_vector_type(8)));
typedef _Float16 f16x8 __attribute__((ext_vector_type(8)));
typedef float f32x4 __attribute__((ext_vector_type(4)));
typedef unsigned u32x4 __attribute__((ext_vector_type(4)));
constexpr int NCS_STRIDE = 2 * 5632 + 10240 + 2 * 5632;
constexpr int BM = 256, BK = 64, HALF = 128, HTB = HALF * BK * 2  , STAGE_BYTES = 8 * HTB, NXCD = 8;

__host__ __device__ __forceinline__ int lds_byte(int r, int c) { const int st = (r >> 4) * 2 + (c >> 5), rr = r & 15, cc = c & 31, ob = rr * 64 + cc * 2; return st * 1024 + (ob ^ (((ob >> 9) & 1) << 5)); }
__host__ __device__ __forceinline__ void stage_rc(int b, int& R, int& C) { const int st = b / 1024, sb = b % 1024, swz = sb ^ (((sb >> 9) & 1) << 5); R = (st >> 1) * 16 + swz / 64; C = (st & 1) * 32 + (swz % 64) / 2; }
__host__ __device__ __forceinline__ int perm32(int rho) { const int n = rho >> 4, i = rho & 15; return 8 * (i >> 2) + 4 * n + (i & 3); }

struct Unit { int pm, pn; };
struct Gemm { const bf16_t* A; const bf16_t* Bt; int M, N, K; };

struct StaticOrder {
    int nM, nN, nwg, G, c, WGM, rev;
    __host__ __device__ void init(int M, int N, int G_, int c_, int wgm = 8, int rev_ = 0) { nM = M / BM; nN = N / BM; nwg = nM * nN; G = G_; c = c_; WGM = wgm; rev = rev_; }
    __host__ __device__ bool next(int i, Unit& u) const {
        const int L = i * G + c; if (L >= nwg) return false;
        int wgid = L; { const int q = nwg / NXCD, r = nwg % NXCD, xcd = wgid % NXCD, off = wgid / NXCD; wgid = (xcd < r ? xcd * (q + 1) : r * (q + 1) + (xcd - r) * q) + off; }
        const int nig = WGM * nN, gid = wgid / nig, fm = gid * WGM, gsz = (nM - fm) < WGM ? (nM - fm) : WGM;
        u.pm = fm + ((wgid % nig) % gsz); u.pn = (wgid % nig) / gsz; if (rev) u.pm = nM - 1 - u.pm; return true;
    }
    __device__ __forceinline__ void a_ready(const Unit&) const {}
    __device__ __forceinline__ void done(const Unit&) const {}
};


__device__ __forceinline__ unsigned cvt_pk_bf16(float lo, float hi) { unsigned r; asm volatile("v_cvt_pk_bf16_f32 %0, %1, %2" : "=v"(r) : "v"(lo), "v"(hi)); return r; }
typedef float f32x2 __attribute__((ext_vector_type(2)));
__device__ __forceinline__ float ubf_lo(unsigned w) { return __builtin_bit_cast(float, w << 16); }
__device__ __forceinline__ float ubf_hi(unsigned w) { return __builtin_bit_cast(float, w & 0xffff0000u); }
__device__ __forceinline__ float silu_f(float x) { return x * __builtin_amdgcn_rcpf(1.0f + __builtin_amdgcn_exp2f(-1.4426950408889634f * x)); }
__device__ __forceinline__ float sigm_f(float x) { return __builtin_amdgcn_rcpf(1.0f + __builtin_amdgcn_exp2f(-1.4426950408889634f * x)); }

constexpr float STAT_SCALE = 1048576.0f, STAT_INV = 1.0f / 1048576.0f;
__device__ __forceinline__ f32x4 cs_load4(const float* p) { return *(const f32x4*)p + *(const f32x4*)(p + NCS_STRIDE); }
__device__ __forceinline__ void stat_add(float* Sn, int row, float ps, float pq) {
    long long* p = (long long*)Sn + 2 * (size_t)row;
    __hip_atomic_fetch_add(p, (long long)__builtin_rintf(ps * STAT_SCALE), __ATOMIC_RELAXED, __HIP_MEMORY_SCOPE_AGENT); __hip_atomic_fetch_add(p + 1, (long long)__builtin_rintf(pq * STAT_SCALE), __ATOMIC_RELAXED, __HIP_MEMORY_SCOPE_AGENT);
}
__device__ __forceinline__ void stat_mr(long long s1i, long long s2i, float& rstd, float& mr) {
    const float mean = (float)s1i * (STAT_INV / 2048.0f); float var = (float)s2i * (STAT_INV / 2048.0f) - mean * mean; var = var < 0.f ? 0.f : var;
    rstd = __builtin_amdgcn_rsqf(var + 1e-5f); mr = mean * rstd;
}
__device__ __forceinline__ void row_mr(const float* S, int row, float& rstd, float& mr) {
    const long long* p = (const long long*)S + 2 * (size_t)row; stat_mr(p[0], p[1], rstd, mr);
}
__device__ __forceinline__ void rows_mr(const float* S, int row0, float (&rstd)[2][4], float (&mr)[2][4]) {
    typedef long long i64x2 __attribute__((ext_vector_type(2)));
#pragma unroll
    for (int ai = 0; ai < 2; ++ai)
#pragma unroll
        for (int m = 0; m < 4; ++m) { const i64x2 st = *(const i64x2*)((const long long*)S + 2 * (size_t)(row0 + ai * HALF + m * 16)); stat_mr(st[0], st[1], rstd[ai][m], mr[ai][m]); }
}
struct EpiSwiglu {
    static constexpr bool PERM = true, AFTER_DRAIN = false; static constexpr int HOOK_T = 0;
    bf16_t* O; int ldc; const float* S; const float* cs; const float* cb;
    __device__ __forceinline__ void operator()(const f32x4 (&acc)[2][2][4][2], const Unit& u, int wr, int wc, int fr, int fq) const {
        const int row0 = u.pm * BM + wr * 64 + fr, col0 = u.pn * HALF + wc * 32 + 8 * fq, wcol0 = u.pn * BM + wc * 32 + 8 * fq;
        f32x4 csv[2][2], cbv[2][2]; float rstdv[2][4], mrv[2][4]; rows_mr(S, row0, rstdv, mrv);
        constexpr float KG = -1.4426950408889634f, KU = -0.6931471805599453f;
#pragma unroll
        for (int bj = 0; bj < 2; ++bj)
#pragma unroll
            for (int n = 0; n < 2; ++n) { csv[bj][n] = cs_load4(cs + wcol0 + bj * HALF + 4 * n); cbv[bj][n] = cs_load4(cb + wcol0 + bj * HALF + 4 * n) * (bj ? KU : KG); }
#pragma unroll
        for (int ai = 0; ai < 2; ++ai)
#pragma unroll
            for (int m = 0; m < 4; ++m) { const int row = row0 + ai * HALF + m * 16; const float rg = rstdv[ai][m] * KG, ru = rstdv[ai][m] * KU, ng = -mrv[ai][m] * KG, nu = -mrv[ai][m] * KU;
                bf16_t* rowp = O + (size_t)row * ldc + col0;
                const f32x4 g0 = acc[ai][0][m][0] * rg + (csv[0][0] * ng + cbv[0][0]), g1 = acc[ai][0][m][1] * rg + (csv[0][1] * ng + cbv[0][1]);
                const f32x4 u0 = acc[ai][1][m][0] * ru + (csv[1][0] * nu + cbv[1][0]), u1 = acc[ai][1][m][1] * ru + (csv[1][1] * nu + cbv[1][1]);
#define SWG(G, U) ((G) * (U) * __builtin_amdgcn_rcpf(1.0f + __builtin_amdgcn_exp2f(G)))
                u32x4 w; w.x = cvt_pk_bf16(SWG(g0[0], u0[0]), SWG(g0[1], u0[1])); w.y = cvt_pk_bf16(SWG(g0[2], u0[2]), SWG(g0[3], u0[3]));
                w.z = cvt_pk_bf16(SWG(g1[0], u1[0]), SWG(g1[1], u1[1])); w.w = cvt_pk_bf16(SWG(g1[2], u1[2]), SWG(g1[3], u1[3]));
#undef SWG
                *(u32x4*)rowp = w; }
    }
};
typedef _Float16 f16x2 __attribute__((ext_vector_type(2)));
__device__ __forceinline__ unsigned pk_f16(float lo, float hi) { unsigned a, b; asm volatile("v_cvt_f16_f32 %0, %1" : "=v"(a) : "v"(lo)); asm volatile("v_cvt_f16_f32 %0, %1" : "=v"(b) : "v"(hi)); return (a & 0xffffu) | (b << 16); }
__device__ __forceinline__ float f16_lo(unsigned w) { return (float)__builtin_bit_cast(f16x2, w)[0]; }
__device__ __forceinline__ float f16_hi(unsigned w) { return (float)__builtin_bit_cast(f16x2, w)[1]; }
struct EpiResid {
    static constexpr bool PERM = true, AFTER_DRAIN = false; static constexpr int HOOK_T = 0;
    bf16_t* R; bf16_t* RB; int ldc; float alpha, s; const float* So; const float* go; const float* bo; float* Sn;
    __device__ __forceinline__ void operator()(const f32x4 (&acc)[2][2][4][2], const Unit& u, int wr, int wc, int fr, int fq) const {
        const int row0 = u.pm * BM + wr * 64 + fr, col0 = u.pn * BM + wc * 32 + 8 * fq;
        f32x4 gv[2][2], bv[2][2]; float rstdv[2][4], mrv[2][4]; rows_mr(So, row0, rstdv, mrv);
#pragma unroll
        for (int bj = 0; bj < 2; ++bj)
#pragma unroll
            for (int n = 0; n < 2; ++n) { gv[bj][n] = *(const f32x4*)(go + col0 + bj * HALF + 4 * n); bv[bj][n] = *(const f32x4*)(bo + col0 + bj * HALF + 4 * n); }
#pragma unroll
        for (int ai = 0; ai < 2; ++ai)
#pragma unroll
            for (int m = 0; m < 4; ++m) { const int row = row0 + ai * HALF + m * 16; const float rstd = rstdv[ai][m], mr = mrv[ai][m];
                const unsigned off = (unsigned)(row * ldc + col0) * 2u; char* rowp = (char*)R + off; char* rbp = (char*)RB + off; float ps = 0.f, pq = 0.f;
#pragma unroll
                for (int bj = 0; bj < 2; ++bj) { const u32x4 hw = *(const u32x4*)(rowp + bj * HALF * 2);
                    const f32x4 h0 = {f16_lo(hw.x), f16_hi(hw.x), f16_lo(hw.y), f16_hi(hw.y)}, h1 = {f16_lo(hw.z), f16_hi(hw.z), f16_lo(hw.w), f16_hi(hw.w)};
                    const f32x4 r0 = ((h0 * rstd - mr) * gv[bj][0] + bv[bj][0]) * alpha + acc[ai][bj][m][0] * s, r1 = ((h1 * rstd - mr) * gv[bj][1] + bv[bj][1]) * alpha + acc[ai][bj][m][1] * s;
                    u32x4 w; w.x = pk_f16(r0[0], r0[1]); w.y = pk_f16(r0[2], r0[3]); w.z = pk_f16(r1[0], r1[1]); w.w = pk_f16(r1[2], r1[3]);
                    *(u32x4*)(rowp + bj * HALF * 2) = w;
                    if (RB) { u32x4 wb; wb.x = cvt_pk_bf16(r0[0], r0[1]); wb.y = cvt_pk_bf16(r0[2], r0[3]); wb.z = cvt_pk_bf16(r1[0], r1[1]); wb.w = cvt_pk_bf16(r1[2], r1[3]);
                        *(u32x4*)(rbp + bj * HALF * 2) = wb; }
                    ps += ((r0[0] + r0[1]) + (r0[2] + r0[3])) + ((r1[0] + r1[1]) + (r1[2] + r1[3]));
                    pq += ((r0[0] * r0[0] + r0[1] * r0[1]) + (r0[2] * r0[2] + r0[3] * r0[3])) + ((r1[0] * r1[0] + r1[1] * r1[1]) + (r1[2] * r1[2] + r1[3] * r1[3])); }
                ps += ::xshfl<16>(ps); ps = ::xadd32(ps); pq += ::xshfl<16>(pq); pq = ::xadd32(pq);
                if (fq == 0) stat_add(Sn, row, ps, pq);
                asm volatile("" ::: "memory"); }
    }
    __device__ __forceinline__ void tail(int row, int col, float s0, float s1) const {
        float rstd, mr; row_mr(So, row, rstd, mr);
        const unsigned hw = *(const unsigned*)(R + (size_t)row * ldc + col);
        const float r0 = ((f16_lo(hw) * rstd - mr) * go[col] + bo[col]) * alpha + s0 * s, r1 = ((f16_hi(hw) * rstd - mr) * go[col + 1] + bo[col + 1]) * alpha + s1 * s;
        *(unsigned*)(R + (size_t)row * ldc + col) = pk_f16(r0, r1); if (RB) *(unsigned*)(RB + (size_t)row * ldc + col) = cvt_pk_bf16(r0, r1);
        float ps = r0 + r1, pq = r0 * r0 + r1 * r1;
        ps += ::xshfl<1>(ps); ps += ::xshfl<2>(ps); ps += ::xshfl<4>(ps); pq += ::xshfl<1>(pq); pq += ::xshfl<2>(pq); pq += ::xshfl<4>(pq);
        if ((threadIdx.x & 7) == 0) stat_add(Sn, row, ps, pq);
    }
};
struct EpiProj {
    static constexpr bool PERM = true, AFTER_DRAIN = false; static constexpr int HOOK_T = 0;
    bf16_t* O; int ldc; const float* bias; int gate_col0; const float* S; const float* cs; const float* cb;
    __device__ __forceinline__ void operator()(const f32x4 (&acc)[2][2][4][2], const Unit& u, int wr, int wc, int fr, int fq) const {
        const int row0 = u.pm * BM + wr * 64 + fr, col0 = u.pn * BM + wc * 32 + 8 * fq;
        const bool gate = (u.pn * BM >= gate_col0);
        f32x4 csv[2][2], cbv[2][2]; float rstdv[2][4], mrv[2][4]; rows_mr(S, row0, rstdv, mrv);
#pragma unroll
        for (int bj = 0; bj < 2; ++bj)
#pragma unroll
            for (int n = 0; n < 2; ++n) { csv[bj][n] = cs_load4(cs + col0 + bj * HALF + 4 * n); cbv[bj][n] = cs_load4(cb + col0 + bj * HALF + 4 * n);
                if (gate) cbv[bj][n] += *(const f32x4*)(bias + (col0 - gate_col0) + bj * HALF + 4 * n); }
#pragma unroll
        for (int ai = 0; ai < 2; ++ai)
#pragma unroll
            for (int m = 0; m < 4; ++m) { const int row = row0 + ai * HALF + m * 16; const float rstd = rstdv[ai][m], mr = mrv[ai][m];
                bf16_t* rowp = O + (size_t)row * ldc + col0;
#pragma unroll
                for (int bj = 0; bj < 2; ++bj) { f32x4 v0 = acc[ai][bj][m][0] * rstd - csv[bj][0] * mr + cbv[bj][0], v1 = acc[ai][bj][m][1] * rstd - csv[bj][1] * mr + cbv[bj][1];
                    if (gate) {
#pragma unroll
                        for (int j = 0; j < 4; ++j) { v0[j] = sigm_f(v0[j]); v1[j] = sigm_f(v1[j]); } }
                    u32x4 w; w.x = cvt_pk_bf16(v0[0], v0[1]); w.y = cvt_pk_bf16(v0[2], v0[3]); w.z = cvt_pk_bf16(v1[0], v1[1]); w.w = cvt_pk_bf16(v1[2], v1[3]);
                    *(u32x4*)(rowp + bj * HALF) = w; } }
    }
};
__device__ __forceinline__ void epiproj_tail(const EpiProj& E, int row, int col, float s0, float s1) {
    float rstd, mr; row_mr(E.S, row, rstd, mr);
    float c0 = E.cs[col] + E.cs[col + NCS_STRIDE], c1 = E.cs[col + 1] + E.cs[col + 1 + NCS_STRIDE], b0 = E.cb[col] + E.cb[col + NCS_STRIDE], b1 = E.cb[col + 1] + E.cb[col + 1 + NCS_STRIDE];
    float v0 = s0 * rstd - c0 * mr + b0, v1 = s1 * rstd - c1 * mr + b1;
    if (col >= E.gate_col0) { v0 = sigm_f(v0 + E.bias[col - E.gate_col0]); v1 = sigm_f(v1 + E.bias[col + 1 - E.gate_col0]); }
    *(unsigned*)(E.O + (size_t)row * E.ldc + col) = cvt_pk_bf16(v0, v1);
}
struct EpiProjTail { const EpiProj& E; __device__ __forceinline__ void tail(int row, int col, float s0, float s1) const { epiproj_tail(E, row, col, s0, s1); } };
struct EpiGate2 {
    static constexpr bool PERM = true, AFTER_DRAIN = false; static constexpr int HOOK_T = DHY / BK;
    bf16_t* G; int ldc; const bf16_t* Gate; int ldg;
    static __device__ __forceinline__ float gcl(float g) { return g < 1e-30f ? 1e-30f : g; }
    __device__ __forceinline__ void mid(f32x4 (&acc)[2][2][4][2], const Unit& u, int wr, int wc, int fr, int fq) const {
        const int row0 = u.pm * BM + wr * 64 + fr, col0 = u.pn * BM + wc * 32 + 8 * fq;
#pragma unroll
        for (int ai = 0; ai < 2; ++ai)
#pragma unroll
          for (int mp = 0; mp < 2; ++mp) {
            u32x4 hv[2][2], av[2][2];
#pragma unroll
            for (int mm = 0; mm < 2; ++mm) { const bf16_t* gp = Gate + (size_t)(row0 + ai * HALF + (2 * mp + mm) * 16) * ldg + col0;
#pragma unroll
                for (int bj = 0; bj < 2; ++bj) { hv[mm][bj] = *(const u32x4*)(gp + bj * HALF); av[mm][bj] = *(const u32x4*)(gp + DM + bj * HALF); } }
#pragma unroll
            for (int mm = 0; mm < 2; ++mm) { const int m = 2 * mp + mm;
#pragma unroll
                for (int bj = 0; bj < 2; ++bj) { const u32x4 h = hv[mm][bj], a = av[mm][bj];
                    const f32x4 r0 = {ubf_lo(h.x) * __builtin_amdgcn_rcpf(gcl(ubf_lo(a.x))), ubf_hi(h.x) * __builtin_amdgcn_rcpf(gcl(ubf_hi(a.x))), ubf_lo(h.y) * __builtin_amdgcn_rcpf(gcl(ubf_lo(a.y))), ubf_hi(h.y) * __builtin_amdgcn_rcpf(gcl(ubf_hi(a.y)))};
                    const f32x4 r1 = {ubf_lo(h.z) * __builtin_amdgcn_rcpf(gcl(ubf_lo(a.z))), ubf_hi(h.z) * __builtin_amdgcn_rcpf(gcl(ubf_hi(a.z))), ubf_lo(h.w) * __builtin_amdgcn_rcpf(gcl(ubf_lo(a.w))), ubf_hi(h.w) * __builtin_amdgcn_rcpf(gcl(ubf_hi(a.w)))};
                    acc[ai][bj][m][0] *= r0; acc[ai][bj][m][1] *= r1; } }
            asm volatile("" ::: "memory"); }
    }
    __device__ __forceinline__ void operator()(const f32x4 (&acc)[2][2][4][2], const Unit& u, int wr, int wc, int fr, int fq) const {
        const int row0 = u.pm * BM + wr * 64 + fr, col0 = u.pn * BM + wc * 32 + 8 * fq;
#pragma unroll
        for (int ai = 0; ai < 2; ++ai) {
            u32x4 av[4][2];
#pragma unroll
            for (int m = 0; m < 4; ++m)
#pragma unroll
                for (int bj = 0; bj < 2; ++bj) av[m][bj] = *(const u32x4*)(Gate + (size_t)(row0 + ai * HALF + m * 16) * ldg + col0 + DM + bj * HALF);
#pragma unroll
            for (int m = 0; m < 4; ++m) { bf16_t* rowp = G + (size_t)(row0 + ai * HALF + m * 16) * ldc + col0;
#pragma unroll
                for (int bj = 0; bj < 2; ++bj) { const u32x4 a = av[m][bj]; const f32x4 a0 = acc[ai][bj][m][0], a1 = acc[ai][bj][m][1];
                    u32x4 w; w.x = cvt_pk_bf16(gcl(ubf_lo(a.x)) * a0[0], gcl(ubf_hi(a.x)) * a0[1]); w.y = cvt_pk_bf16(gcl(ubf_lo(a.y)) * a0[2], gcl(ubf_hi(a.y)) * a0[3]);
                    w.z = cvt_pk_bf16(gcl(ubf_lo(a.z)) * a1[0], gcl(ubf_hi(a.z)) * a1[1]); w.w = cvt_pk_bf16(gcl(ubf_lo(a.w)) * a1[2], gcl(ubf_hi(a.w)) * a1[3]);
                    *(u32x4*)(rowp + bj * HALF) = w; } }
            asm volatile("" ::: "memory"); }
    }
    __device__ __forceinline__ void tail(int row, int col, float h0, float h1, float a0, float a1) const {
        const unsigned gh = *(const unsigned*)(Gate + (size_t)row * ldg + col), ga = *(const unsigned*)(Gate + (size_t)row * ldg + col + DM);
        *(unsigned*)(G + (size_t)row * ldc + col) = cvt_pk_bf16(ubf_lo(gh) * h0 + ubf_lo(ga) * a0, ubf_hi(gh) * h1 + ubf_hi(ga) * a1);
    }
};
template <class Epi, class Sched, bool ALIGN_EPI = false, bool SP2 = false, bool F16 = false  >
__device__ __forceinline__ void gemm_phase(PG8_LAS unsigned char* lds, const Gemm g, const Sched& S, const Epi& E) {
    int tid_ = threadIdx.x; asm volatile("" : "+v"(tid_));
    const int tid = tid_, wid = __builtin_amdgcn_readfirstlane(tid >> 6), lane = tid & 63, wr = wid >> 2, wc = wid & 3, fr = lane & 15, fq = lane >> 4;
    const int K = g.K, nt = K / BK;
    unsigned voffA[2], voffB[2]; int aoff, boff;
    auto lane_offsets = [&](int t) {
        const int l = t & 63;
#pragma unroll
        for (int i = 0; i < 2; ++i) { int R, C; stage_rc(t * 16 + i * 8192, R, C); const int Rb = Epi::PERM ? ((R & ~31) + perm32(R & 31)) : R;
            voffA[i] = (unsigned)(R * K + C) * 2u; voffB[i] = (unsigned)(Rb * K + C) * 2u; }
        aoff = lds_byte(wr * 64 + (l & 15), (l >> 4) * 8); boff = lds_byte(wc * 32 + (l & 15), (l >> 4) * 8); };
    lane_offsets(tid);
    const size_t kstep = (size_t)(BK * 2);
    const size_t hstep = (size_t)HALF * K * 2;
    const size_t tstep = 2 * hstep;
    const unsigned ldsw = (unsigned)wid * 1024u;
#define PG8_SA(b, h) (((b) * 2 + (h)) * HTB)
#define PG8_SB(b, h) ((4 + (b) * 2 + (h)) * HTB)
#define PG8_STAGE(bufoff, gbase, voff) do { _Pragma("unroll") for (int _i = 0; _i < 2; ++_i) \
        __builtin_amdgcn_global_load_lds((const unsigned*)((const char*)(gbase) + (voff)[_i]), (PG8_LAS unsigned*)(lds + (bufoff) + ldsw + _i * 8192), 16, 0, 0); } while (0)
#define PG8_LDA(dst, b, h) do { _Pragma("unroll") for (int m = 0; m < 4; ++m) _Pragma("unroll") for (int k = 0; k < 2; ++k) dst[m][k] = *(const PG8_LAS bf16x8*)(lds + PG8_SA(b, h) + aoff + m * 2048 + k * 1024); } while (0)
#define PG8_LDB(dst, b, h) do { _Pragma("unroll") for (int n = 0; n < 2; ++n) _Pragma("unroll") for (int k = 0; k < 2; ++k) dst[n][k] = *(const PG8_LAS bf16x8*)(lds + PG8_SB(b, h) + boff + n * 2048 + k * 1024); } while (0)
#define PG8_MMA(ai, bj, At, Bt) do { __builtin_amdgcn_s_setprio(1); _Pragma("unroll") for (int m = 0; m < 4; ++m) _Pragma("unroll") for (int n = 0; n < 2; ++n) _Pragma("unroll") for (int k = 0; k < 2; ++k) \
        acc[ai][bj][m][n] = F16 ? __builtin_amdgcn_mfma_f32_16x16x32_f16(__builtin_bit_cast(f16x8, Bt[n][k]), __builtin_bit_cast(f16x8, At[m][k]), acc[ai][bj][m][n], 0, 0, 0) \
                                : __builtin_amdgcn_mfma_f32_16x16x32_bf16(Bt[n][k], At[m][k], acc[ai][bj][m][n], 0, 0, 0); __builtin_amdgcn_s_setprio(0); } while (0)
#define PG8_WAIT_V(n) asm volatile("s_waitcnt vmcnt(" #n ")" ::: "memory")
#define PG8_WAIT_L(n) asm volatile("s_waitcnt lgkmcnt(" #n ")" ::: "memory")
#define PG8_BAR __builtin_amdgcn_s_barrier()
#define PG8_SCHED __builtin_amdgcn_sched_barrier(0)
    Unit cur, nxt; int ui = 0;
    if (!S.next(0, cur)) return;
    f32x4 acc[2][2][4][2];
#pragma unroll
    for (int a = 0; a < 2; ++a)
#pragma unroll
        for (int b = 0; b < 2; ++b)
#pragma unroll
            for (int m = 0; m < 4; ++m)
#pragma unroll
                for (int n = 0; n < 2; ++n) acc[a][b][m][n] = (f32x4){0.f, 0.f, 0.f, 0.f};
    bf16x8 At[4][2], B0[2][2], B1[2][2];
    const char* cA = (const char*)g.A + (size_t)cur.pm * tstep; const char* cB = (const char*)g.Bt + (size_t)cur.pn * tstep;
    S.a_ready(cur);
    if constexpr (SP2) {
        PG8_STAGE(PG8_SB(0, 0), cB, voffB); PG8_STAGE(PG8_SB(0, 1), cB + hstep, voffB); PG8_STAGE(PG8_SA(0, 0), cA, voffA); PG8_STAGE(PG8_SA(0, 1), cA + hstep, voffA);
        if (wr == 1) PG8_BAR;
        PG8_WAIT_V(2); PG8_BAR;
        PG8_STAGE(PG8_SB(1, 0), cB + kstep, voffB); PG8_STAGE(PG8_SA(1, 0), cA + kstep, voffA); PG8_STAGE(PG8_SB(1, 1), cB + hstep + kstep, voffB);
        PG8_WAIT_V(6); PG8_BAR;
    } else {
        PG8_STAGE(PG8_SB(0, 0), cB, voffB); PG8_STAGE(PG8_SA(0, 0), cA, voffA); PG8_STAGE(PG8_SB(0, 1), cB + hstep, voffB); PG8_STAGE(PG8_SA(0, 1), cA + hstep, voffA);
        if (wr == 1) PG8_BAR;
        PG8_WAIT_V(4); PG8_BAR;
        PG8_STAGE(PG8_SB(1, 0), cB + kstep, voffB); PG8_STAGE(PG8_SA(1, 0), cA + kstep, voffA); PG8_STAGE(PG8_SB(1, 1), cB + hstep + kstep, voffB);
        PG8_WAIT_V(6); PG8_BAR;
    }
    for (;;) {
        const bool has_next = S.next(ui + 1, nxt);
        const char* nA = has_next ? (const char*)g.A + (size_t)nxt.pm * tstep : cA; const char* nB = has_next ? (const char*)g.Bt + (size_t)nxt.pn * tstep : cB;
        for (int t = 0; t < nt; t += 2) {
            const bool last = (t == nt - 2);
            const char* a1 = cA + (size_t)(t + 1) * kstep;
            const char* a2 = last ? nA : cA + (size_t)(t + 2) * kstep; const char* b2 = last ? nB : cB + (size_t)(t + 2) * kstep;
            const char* a3 = a2 + kstep; const char* b3 = b2 + kstep;
            if (last && has_next) S.a_ready(nxt);
            if constexpr (Epi::HOOK_T > 0) { if (t == Epi::HOOK_T) { int lh; asm volatile("v_mbcnt_lo_u32_b32 %0, -1, 0\n\tv_mbcnt_hi_u32_b32 %0, -1, %0" : "=v"(lh));
                E.mid(acc, cur, wr, wc, lh & 15, lh >> 4); } }
            if constexpr (SP2) {
            PG8_LDB(B0, 0, 0); PG8_LDB(B1, 0, 1); PG8_SCHED; PG8_LDA(At, 0, 0); PG8_STAGE(PG8_SA(1, 1), a1 + hstep, voffA);
            PG8_WAIT_V(8); PG8_WAIT_L(0); PG8_BAR; PG8_MMA(0, 0, At, B0); PG8_MMA(0, 1, At, B1); PG8_BAR; PG8_SCHED;
            PG8_LDA(At, 0, 1); PG8_STAGE(PG8_SB(0, 0), b2, voffB); PG8_STAGE(PG8_SB(0, 1), b2 + hstep, voffB); PG8_STAGE(PG8_SA(0, 0), a2, voffA);
            PG8_WAIT_V(8); PG8_WAIT_L(0); PG8_BAR; PG8_MMA(1, 0, At, B0); PG8_MMA(1, 1, At, B1); PG8_BAR; PG8_SCHED;
            PG8_LDB(B0, 1, 0); PG8_LDB(B1, 1, 1); PG8_SCHED; PG8_LDA(At, 1, 0); PG8_STAGE(PG8_SA(0, 1), a2 + hstep, voffA);
            PG8_WAIT_V(8); PG8_WAIT_L(0); PG8_BAR; PG8_MMA(0, 0, At, B0); PG8_MMA(0, 1, At, B1); PG8_BAR; PG8_SCHED;
            PG8_LDA(At, 1, 1); PG8_STAGE(PG8_SB(1, 0), b3, voffB); PG8_STAGE(PG8_SB(1, 1), b3 + hstep, voffB); PG8_STAGE(PG8_SA(1, 0), a3, voffA);
            PG8_WAIT_V(8); PG8_WAIT_L(0); PG8_BAR; PG8_MMA(1, 0, At, B0); PG8_MMA(1, 1, At, B1); PG8_BAR; PG8_SCHED;
            } else {
            PG8_LDB(B0, 0, 0); PG8_SCHED; PG8_LDA(At, 0, 0); PG8_STAGE(PG8_SA(1, 1), a1 + hstep, voffA);
            PG8_WAIT_L(8); PG8_BAR; PG8_WAIT_L(0); PG8_MMA(0, 0, At, B0); PG8_BAR; PG8_SCHED;
            PG8_LDB(B1, 0, 1); PG8_STAGE(PG8_SB(0, 0), b2, voffB);
            PG8_BAR; PG8_WAIT_L(0); PG8_MMA(0, 1, At, B1); PG8_BAR;
            PG8_LDA(At, 0, 1); PG8_STAGE(PG8_SA(0, 0), a2, voffA);
            PG8_BAR; PG8_WAIT_L(0); PG8_MMA(1, 0, At, B0); PG8_BAR; PG8_SCHED;
            PG8_STAGE(PG8_SB(0, 1), b2 + hstep, voffB);
            PG8_WAIT_V(6); PG8_BAR; PG8_MMA(1, 1, At, B1); PG8_BAR;
            PG8_LDB(B0, 1, 0); PG8_SCHED; PG8_LDA(At, 1, 0); PG8_STAGE(PG8_SA(0, 1), a2 + hstep, voffA);
            PG8_WAIT_L(8); PG8_BAR; PG8_WAIT_L(0); PG8_MMA(0, 0, At, B0); PG8_BAR; PG8_SCHED;
            PG8_LDB(B1, 1, 1); PG8_STAGE(PG8_SB(1, 0), b3, voffB);
            PG8_BAR; PG8_WAIT_L(0); PG8_MMA(0, 1, At, B1); PG8_BAR;
            PG8_LDA(At, 1, 1); PG8_STAGE(PG8_SA(1, 0), a3, voffA);
            PG8_BAR; PG8_WAIT_L(0); PG8_MMA(1, 0, At, B0); PG8_BAR; PG8_SCHED;
            PG8_STAGE(PG8_SB(1, 1), b3 + hstep, voffB);
            PG8_WAIT_V(6); PG8_BAR; PG8_MMA(1, 1, At, B1); PG8_BAR;
            }
        }
        if constexpr (ALIGN_EPI) { if (wr == 0) PG8_BAR; }
        if constexpr (!Epi::AFTER_DRAIN) { int le; asm volatile("v_mbcnt_lo_u32_b32 %0, -1, 0\n\tv_mbcnt_hi_u32_b32 %0, -1, %0" : "=v"(le));
            E(acc, cur, wr, wc, le & 15, le >> 4); S.done(cur); }
        if (!has_next) break;
#pragma unroll
        for (int a = 0; a < 2; ++a)
#pragma unroll
            for (int b = 0; b < 2; ++b)
#pragma unroll
                for (int m = 0; m < 4; ++m)
#pragma unroll
                    for (int n = 0; n < 2; ++n) acc[a][b][m][n] = (f32x4){0.f, 0.f, 0.f, 0.f};
        cur = nxt; cA = nA; cB = nB; ++ui;
        { int l2; asm volatile("v_mbcnt_lo_u32_b32 %0, -1, 0\n\tv_mbcnt_hi_u32_b32 %0, -1, %0" : "=v"(l2)); lane_offsets(wid * 64 + l2); }
        if constexpr (ALIGN_EPI) { if (wr == 1) PG8_BAR; }
    }
    PG8_WAIT_V(0);
    if constexpr (!ALIGN_EPI) { if (wr == 0) PG8_BAR; }
    PG8_BAR;
    if constexpr (Epi::AFTER_DRAIN) { E.fused(acc, cur, wr, wc, fr, fq, lds, wid, lane); S.done(cur); }
#undef PG8_SA
#undef PG8_SB
#undef PG8_STAGE
#undef PG8_LDA
#undef PG8_LDB
#undef PG8_MMA
#undef PG8_WAIT_V
#undef PG8_WAIT_L
#undef PG8_BAR
#undef PG8_SCHED
}
}

template <class TEpi>
__device__ __forceinline__ void gemm_tail(LAS unsigned char* lds, const bf16* A  , const bf16* Bt  , int N, int K, int R0, const TEpi& E, int G, int bid) {
    int tid_ = threadIdx.x; asm volatile("" : "+v"(tid_));
    const int tid = tid_, wave = __builtin_amdgcn_readfirstlane(tid >> 6), lane = tid & 63, fr = lane & 15, fq = lane >> 4, kw = K >> 3;
    LAS float* red = (LAS float*)lds;
    for (int nt = bid; nt < (N >> 4); nt += G) {
        f32x4 acc[4];
#pragma unroll
        for (int mt = 0; mt < 4; ++mt) acc[mt] = (f32x4){0.f, 0.f, 0.f, 0.f};
        const bf16* ap = A + (size_t)fr * K + wave * kw + fq * 8;
        const bf16* bp = Bt + (size_t)(nt * 16 + fr) * K + wave * kw + fq * 8;
#pragma unroll 4
        for (int k = 0; k < kw; k += 32) {
            const bf16x8 b = *(const bf16x8*)(bp + k);
#pragma unroll
            for (int mt = 0; mt < 4; ++mt) { const bf16x8 a = *(const bf16x8*)(ap + (size_t)(mt * 16) * K + k); acc[mt] = __builtin_amdgcn_mfma_f32_16x16x32_bf16(a, b, acc[mt], 0, 0, 0); }
        }
#pragma unroll
        for (int mt = 0; mt < 4; ++mt)
#pragma unroll
            for (int i = 0; i < 4; ++i) red[(wave * 64 + mt * 16 + fq * 4 + i) * 17 + fr] = acc[mt][i];
        __syncthreads();
        { const int m = tid >> 3, n2 = (tid & 7) * 2; float s0 = 0.f, s1 = 0.f;
#pragma unroll
          for (int w = 0; w < 8; ++w) { s0 += red[(w * 64 + m) * 17 + n2]; s1 += red[(w * 64 + m) * 17 + n2 + 1]; }
          E.tail(R0 + m, nt * 16 + n2, s0, s1); }
        __syncthreads();
    }
}

template <class TEpi>
__device__ __forceinline__ void gemm_tail2(LAS unsigned char* lds, const bf16* A  , const bf16* Bt  , int N, int K, int K1, int R0, const TEpi& E, int G, int bid) {
    int tid_ = threadIdx.x; asm volatile("" : "+v"(tid_));
    const int tid = tid_, wave = __builtin_amdgcn_readfirstlane(tid >> 6), lane = tid & 63, fr = lane & 15, fq = lane >> 4;
    LAS float* red = (LAS float*)lds;
    for (int nt = bid; nt < (N >> 4); nt += G) {
        float sv[2][2];
#pragma unroll
        for (int seg = 0; seg < 2; ++seg) {
            const int kb = seg ? K1 : 0, kw = (seg ? K - K1 : K1) >> 3;
            f32x4 acc[4];
#pragma unroll
            for (int mt = 0; mt < 4; ++mt) acc[mt] = (f32x4){0.f, 0.f, 0.f, 0.f};
            const bf16* ap = A + (size_t)fr * K + kb + wave * kw + fq * 8;
            const bf16* bp = Bt + (size_t)(nt * 16 + fr) * K + kb + wave * kw + fq * 8;
#pragma unroll 4
            for (int k = 0; k < kw; k += 32) {
                const bf16x8 b = *(const bf16x8*)(bp + k);
#pragma unroll
                for (int mt = 0; mt < 4; ++mt) { const bf16x8 a = *(const bf16x8*)(ap + (size_t)(mt * 16) * K + k); acc[mt] = __builtin_amdgcn_mfma_f32_16x16x32_bf16(a, b, acc[mt], 0, 0, 0); }
            }
#pragma unroll
            for (int mt = 0; mt < 4; ++mt)
#pragma unroll
                for (int i = 0; i < 4; ++i) red[(wave * 64 + mt * 16 + fq * 4 + i) * 17 + fr] = acc[mt][i];
            __syncthreads();
            { const int m = tid >> 3, n2 = (tid & 7) * 2; float s0 = 0.f, s1 = 0.f;
#pragma unroll
              for (int w = 0; w < 8; ++w) { s0 += red[(w * 64 + m) * 17 + n2]; s1 += red[(w * 64 + m) * 17 + n2 + 1]; }
              sv[seg][0] = s0; sv[seg][1] = s1; }
            __syncthreads();
        }
        E.tail(R0 + (tid >> 3), nt * 16 + (tid & 7) * 2, sv[0][0], sv[0][1], sv[1][0], sv[1][1]);
    }
}

template <int NS, class TEpi>
__device__ __forceinline__ void gemm_tailn(LAS unsigned char* lds, const bf16* A, const bf16* Bt, int N, int K, int R0, const TEpi& E, int G, int bid) {
    int tid_ = threadIdx.x; asm volatile("" : "+v"(tid_));
    const int tid = tid_, wave = __builtin_amdgcn_readfirstlane(tid >> 6), lane = tid & 63, fr = lane & 15, fq = lane >> 4, kw = K >> 3;
    constexpr int PITCH = NS * 16 + 1;
    LAS float* red = (LAS float*)lds;
    const int nsl = N >> 4, nitems = (nsl + NS - 1) / NS;
    for (int it = bid; it < nitems; it += G) {
        f32x4 acc[NS][4];
#pragma unroll
        for (int s = 0; s < NS; ++s)
#pragma unroll
            for (int mt = 0; mt < 4; ++mt) acc[s][mt] = (f32x4){0.f, 0.f, 0.f, 0.f};
        const bf16* ap = A + (size_t)fr * K + wave * kw + fq * 8;
        const bf16* bp[NS];
#pragma unroll
        for (int s = 0; s < NS; ++s) { int sl = it * NS + s; sl = sl < nsl ? sl : nsl - 1; bp[s] = Bt + (size_t)(sl * 16 + fr) * K + wave * kw + fq * 8; }
#pragma unroll 2
        for (int k = 0; k < kw; k += 32) {
            bf16x8 a[4];
#pragma unroll
            for (int mt = 0; mt < 4; ++mt) a[mt] = *(const bf16x8*)(ap + (size_t)(mt * 16) * K + k);
#pragma unroll
            for (int s = 0; s < NS; ++s) { const bf16x8 b = *(const bf16x8*)(bp[s] + k);
#pragma unroll
                for (int mt = 0; mt < 4; ++mt) acc[s][mt] = __builtin_amdgcn_mfma_f32_16x16x32_bf16(a[mt], b, acc[s][mt], 0, 0, 0); }
        }
#pragma unroll
        for (int s = 0; s < NS; ++s)
#pragma unroll
            for (int mt = 0; mt < 4; ++mt)
#pragma unroll
                for (int i = 0; i < 4; ++i) red[(wave * 64 + mt * 16 + fq * 4 + i) * PITCH + s * 16 + fr] = acc[s][mt][i];
        __syncthreads();
        { const int m = tid >> 3, c2 = (tid & 7) * 2;
#pragma unroll
          for (int s = 0; s < NS; ++s) { float s0 = 0.f, s1 = 0.f;
#pragma unroll
              for (int w = 0; w < 8; ++w) { s0 += red[(w * 64 + m) * PITCH + s * 16 + c2]; s1 += red[(w * 64 + m) * PITCH + s * 16 + c2 + 1]; }
              const int sl = it * NS + s; if (sl < nsl) E.tail(R0 + m, sl * 16 + c2, s0, s1); } }
        __syncthreads();
    }
}

namespace att {
#ifndef ATT_SDEPTH
#define ATT_SDEPTH 1
#endif
constexpr int D = 128, NW = 8, QBLK = 32, KVBLK = 64;
constexpr float SCALE = 0.088388347648318440f;
constexpr float THR = 8.f;
__device__ constexpr float ROTF[32] = {1.000000000e+00f, 7.498942093e-01f, 5.623413252e-01f, 4.216965034e-01f, 3.162277660e-01f, 2.371373706e-01f, 1.778279410e-01f, 1.333521432e-01f, 1.000000000e-01f, 7.498942093e-02f, 5.623413252e-02f, 4.216965034e-02f, 3.162277660e-02f, 2.371373706e-02f, 1.778279410e-02f, 1.333521432e-02f, 1.000000000e-02f, 7.498942093e-03f, 5.623413252e-03f, 4.216965034e-03f, 3.162277660e-03f, 2.371373706e-03f, 1.778279410e-03f, 1.333521432e-03f, 1.000000000e-03f, 7.498942093e-04f, 5.623413252e-04f, 4.216965034e-04f, 3.162277660e-04f, 2.371373706e-04f, 1.778279410e-04f, 1.333521432e-04f};
constexpr int LDQ = NIN, LDK = HD, LDV = NIN, LDO = DYC;
constexpr int KPITCH = D * 2 + 16;
constexpr size_t SHM_V = KVBLK * D * 2, SHM_K = KVBLK * KPITCH, SHM_ATTN = 2 * SHM_V + 2 * SHM_K + NW * 64 * 4;
using s16x4  = __attribute__((ext_vector_type(4))) short;
using f32x16 = __attribute__((ext_vector_type(16))) float;
#define KSWZ(row, colB) ((row) * KPITCH + (colB))
#define SBAR() __builtin_amdgcn_sched_barrier(0)
__device__ __forceinline__ int crow(int r, int hi) { return (r & 3) + 8 * (r >> 2) + 4 * hi; }
__device__ __forceinline__ unsigned cvtpk(float lo, float hi) { unsigned r; asm volatile("v_cvt_pk_bf16_f32 %0, %1, %2" : "=v"(r) : "v"(lo), "v"(hi)); return r; }

__device__ __forceinline__ void partialSM(f32x16& p0, f32x16& p1, float& m_reg, float& mn, float& alpha) {
  constexpr float C = SCALE * 1.4426950408889634f;
  float pmax = p0[0]; for (int r = 1; r < 16; ++r) pmax = fmaxf(pmax, p0[r]); for (int r = 0; r < 16; ++r) pmax = fmaxf(pmax, p1[r]);
  { auto rr = __builtin_amdgcn_permlane32_swap(__float_as_uint(pmax), __float_as_uint(pmax), false, false);
    pmax = fmaxf(__uint_as_float(rr[0]), __uint_as_float(rr[1])); }
  if (__builtin_expect(__all(pmax - m_reg <= THR / SCALE), 1)) { mn = m_reg; alpha = 1.f; }
  else { mn = fmaxf(m_reg, pmax); alpha = __builtin_amdgcn_exp2f((m_reg - mn) * C); m_reg = mn; }
  float mnC = -mn * C;
  for (int r = 0; r < 16; ++r) p0[r] = fmaf(p0[r], C, mnC); for (int r = 0; r < 16; ++r) p1[r] = fmaf(p1[r], C, mnC);
}
__device__ __forceinline__ void expP0(f32x16& p0) { for (int r = 0; r < 16; ++r) { float e = __builtin_amdgcn_exp2f(p0[r]); asm volatile("" : "+v"(e)); p0[r] = e; } }
__device__ __forceinline__ void finishSM(f32x16& p0, f32x16& p1, float alpha, float& l_reg, bf16x8& pa0, bf16x8& pa1, bf16x8& pa2, bf16x8& pa3) {
  for (int r = 0; r < 16; ++r) p1[r] = __builtin_amdgcn_exp2f(p1[r]);
  float ps = 0; for (int r = 0; r < 16; ++r) ps += p0[r]; for (int r = 0; r < 16; ++r) ps += p1[r];
  { auto rr = __builtin_amdgcn_permlane32_swap(__float_as_uint(ps), __float_as_uint(ps), false, false);
    ps = __uint_as_float(rr[0]) + __uint_as_float(rr[1]); }
  l_reg = l_reg * alpha + ps;
#define PK4(P, BASE, OUT) do { unsigned a0 = cvtpk(P[BASE + 0], P[BASE + 1]), a1 = cvtpk(P[BASE + 2], P[BASE + 3]);   \
    unsigned b0 = cvtpk(P[BASE + 4], P[BASE + 5]), b1 = cvtpk(P[BASE + 6], P[BASE + 7]);                              \
    auto r0 = __builtin_amdgcn_permlane32_swap(a0, b0, false, false); auto r1 = __builtin_amdgcn_permlane32_swap(a1, b1, false, false); \
    v4u w = {r0[0], r1[0], r0[1], r1[1]}; OUT = *reinterpret_cast<bf16x8*>(&w); } while (0)
  PK4(p0, 0, pa0); PK4(p0, 8, pa1); PK4(p1, 0, pa2); PK4(p1, 8, pa3);
#undef PK4
}
template <int BUF> __device__ __forceinline__ void qkt(f32x16& p0, f32x16& p1, const char* kp, const bf16x8* qr) {
  const char* k0 = kp + BUF * (int)SHM_K; const char* k1 = k0 + 32 * KPITCH;
  bf16x8 b0[8], b1[8];
#pragma unroll
  for (int d0 = 0; d0 < 8; ++d0) { b0[d0] = *reinterpret_cast<const bf16x8*>(k0 + d0 * 32); b1[d0] = *reinterpret_cast<const bf16x8*>(k1 + d0 * 32); }
  p0 = f32x16{}; p1 = f32x16{};
#pragma unroll
  for (int d0 = 0; d0 < 8; ++d0) { p0 = __builtin_amdgcn_mfma_f32_32x32x16_bf16(b0[d0], qr[d0], p0, 0, 0, 0); p1 = __builtin_amdgcn_mfma_f32_32x32x16_bf16(b1[d0], qr[d0], p1, 0, 0, 0); }
}
template <int NE> __device__ __forceinline__ void qkt_order() {
  __builtin_amdgcn_sched_group_barrier(0x100, 4, 0);
  if (NE) __builtin_amdgcn_sched_group_barrier(0x400, NE, 0);
#pragma unroll
  for (int d0 = 0; d0 < 6; ++d0) { __builtin_amdgcn_sched_group_barrier(0x100, 2, 0); __builtin_amdgcn_sched_group_barrier(0x008, 2, 0); }
  __builtin_amdgcn_sched_group_barrier(0x008, 4, 0);
}
__device__ __forceinline__ void kmask(f32x16& p0, f32x16& p1, int kbase, int nvalid, int hi) {
#pragma unroll
  for (int r = 0; r < 16; ++r) { const int k = kbase + crow(r, hi); if (k >= nvalid) p0[r] = -1e30f; if (k + 32 >= nvalid) p1[r] = -1e30f; }
}
__device__ __forceinline__ int v_st(int k, int c) { const int kk = (k & ~0xC) | ((k & 4) << 1) | ((k & 8) >> 1); return ((kk >> 3) * 4 + (c >> 5)) * 512 + ((kk & 7) * 32 + (c & 31)) * 2; }
__device__ __forceinline__ int v_rd_base(int lane) { return ((lane & 3) << 3) | (((lane >> 2) & 3) << 6) | (((lane >> 4) & 1) << 5) | (((lane >> 5) & 1) << 8); }
constexpr int v_rd_off(int d0, int ks, int half) { return d0 * 512 + ks * 4096 + half * 2048; }
template <int OFF> __device__ __forceinline__ s16x4 tr_read(int vb) {
  s16x4 r; asm volatile("ds_read_b64_tr_b16 %0, %1 offset:%2" : "=&v"(r) : "v"(vb), "i"(OFF) : "memory"); return r;
}
template <int D0> __device__ __forceinline__ void pv_one(f32x16& od, int vb, bf16x8 pa0, bf16x8 pa1, bf16x8 pa2, bf16x8 pa3) {
  const s16x4 l0 = tr_read<v_rd_off(D0, 0, 0)>(vb), h0 = tr_read<v_rd_off(D0, 0, 1)>(vb), l1 = tr_read<v_rd_off(D0, 1, 0)>(vb), h1 = tr_read<v_rd_off(D0, 1, 1)>(vb);
  const s16x4 l2 = tr_read<v_rd_off(D0, 2, 0)>(vb), h2 = tr_read<v_rd_off(D0, 2, 1)>(vb), l3 = tr_read<v_rd_off(D0, 3, 0)>(vb), h3 = tr_read<v_rd_off(D0, 3, 1)>(vb);
  asm volatile("s_waitcnt lgkmcnt(0)" ::: "memory"); SBAR();
#define PK(L, H) (bf16x8){L[0], L[1], L[2], L[3], H[0], H[1], H[2], H[3]}
  od = __builtin_amdgcn_mfma_f32_32x32x16_bf16(pa0, PK(l0, h0), od, 0, 0, 0);
  od = __builtin_amdgcn_mfma_f32_32x32x16_bf16(pa1, PK(l1, h1), od, 0, 0, 0);
  od = __builtin_amdgcn_mfma_f32_32x32x16_bf16(pa2, PK(l2, h2), od, 0, 0, 0);
  od = __builtin_amdgcn_mfma_f32_32x32x16_bf16(pa3, PK(l3, h3), od, 0, 0, 0);
#undef PK
}
__device__ __forceinline__ void pv_d0(f32x16* o, int vb, bf16x8 pa0, bf16x8 pa1, bf16x8 pa2, bf16x8 pa3) {
  pv_one<0>(o[0], vb, pa0, pa1, pa2, pa3); pv_one<1>(o[1], vb, pa0, pa1, pa2, pa3); pv_one<2>(o[2], vb, pa0, pa1, pa2, pa3); pv_one<3>(o[3], vb, pa0, pa1, pa2, pa3);
}

__device__ __forceinline__ void attn_unit(const bf16* __restrict__ Qb, int qvalid, int packed, const bf16* __restrict__ Kh, const bf16* __restrict__ Vh,
                                          bf16* __restrict__ Ob, int nvalid, int NT, char* lds, unsigned* qctr, unsigned& nxt  , const float* __restrict__ qg  , int tq0  ) {
  int tid_ = threadIdx.x; asm volatile("" : "+v"(tid_));
  const int tid = tid_, wid = tid >> 6, lane = tid & 63, r32 = lane & 31, hi = lane >> 5;
  bf16* V_lds = (bf16*)lds; bf16* K_lds = (bf16*)(lds + 2 * SHM_V);
  float* ws = (float*)(lds + 2 * SHM_V + 2 * SHM_K) + wid * 64; float* li_l = ws; float* al_l = ws + 32;
  float m_reg = -1e30f, l_reg = 0; f32x16 o[4] = {}; bf16x8 qr[8];
  { int qrow = wid * QBLK + r32; qrow = qrow < qvalid ? qrow : qvalid - 1;
    const bf16* Qw = Qb + (packed ? (long)(qrow & 15) * LDQ + (qrow >> 4) * HD : (long)qrow * LDQ) + hi * 8;
#pragma unroll
    for (int d0 = 0; d0 < 8; ++d0) qr[d0] = *reinterpret_cast<const bf16x8*>(Qw + d0 * 16);
    float qf[8][8]; float ss = 0.f;
#pragma unroll
    for (int d0 = 0; d0 < 8; ++d0)
#pragma unroll
        for (int e = 0; e < 8; ++e) { qf[d0][e] = __builtin_bit_cast(float, (unsigned)(unsigned short)qr[d0][e] << 16); ss += qf[d0][e] * qf[d0][e]; }
    ss = ::xadd32(ss);
    const float rstd = __builtin_amdgcn_rsqf(ss * (1.0f / HD) + QK_EPS);
#pragma unroll
    for (int d0 = 0; d0 < 8; ++d0) { const f32x4 g0 = *(const f32x4*)(qg + d0 * 16 + hi * 8), g1 = *(const f32x4*)(qg + d0 * 16 + hi * 8 + 4);
#pragma unroll
        for (int e = 0; e < 4; ++e) { qf[d0][e] *= rstd * g0[e]; qf[d0][4 + e] *= rstd * g1[e]; } }
    const int tq = tq0 + (packed ? (qrow & 15) : qrow);
    float rowp, colp; if (tq < NMETA) { rowp = -1.0f; colp = (float)tq; } else { const int jj = tq - NMETA; rowp = (float)(jj >> 6); colp = (float)(jj & 63); }
    const float hsc = hi ? 0.1f * 0.15915494309189535f : 0.15915494309189535f;
#pragma unroll
    for (int sg = 0; sg < 2; ++sg) { const float ph = (sg ? colp : rowp) * hsc;
#pragma unroll
        for (int dd = 0; dd < 2; ++dd)
#pragma unroll
            for (int e = 0; e < 8; ++e) { const float ang = ph * ROTF[16 * dd + e];
                const float sn = __builtin_amdgcn_sinf(ang), cs = __builtin_amdgcn_cosf(ang), a = qf[4 * sg + dd][e], b = qf[4 * sg + dd + 2][e];
                qf[4 * sg + dd][e] = a * cs - b * sn; qf[4 * sg + dd + 2][e] = b * cs + a * sn; } }
#pragma unroll
    for (int d0 = 0; d0 < 8; ++d0) { v4u w; w.x = ::pk2(qf[d0][0], qf[d0][1]); w.y = ::pk2(qf[d0][2], qf[d0][3]); w.z = ::pk2(qf[d0][4], qf[d0][5]); w.w = ::pk2(qf[d0][6], qf[d0][7]);
        qr[d0] = __builtin_bit_cast(bf16x8, w); } }
  const int sr = tid >> 4, sc = (tid & 15) * 8, vst0 = v_st(sr, sc), vst1 = v_st(32 + sr, sc);
  const int vb0 = (int)(uintptr_t)V_lds + v_rd_base(lane);
  constexpr int SDEPTH = ATT_SDEPTH;
  struct { bf16x8 vs0, vs1, ks0, ks1; } sr_[SDEPTH];
  const unsigned goff0 = (unsigned)(sr * LDK + sc) * 2u, goff1 = goff0 + 32u * LDK * 2u;
  const unsigned gofv0 = (unsigned)(sr * LDV + sc) * 2u, gofv1 = gofv0 + 32u * LDV * 2u;
#define SLOAD(i, k0) do { const char* vbp = (const char*)Vh + (size_t)(k0) * (LDV * 2); const char* kbp = (const char*)Kh + (size_t)(k0) * (LDK * 2); \
    sr_[i].vs0 = *reinterpret_cast<const bf16x8*>(vbp + gofv0); sr_[i].vs1 = *reinterpret_cast<const bf16x8*>(vbp + gofv1); \
    sr_[i].ks0 = *reinterpret_cast<const bf16x8*>(kbp + goff0); sr_[i].ks1 = *reinterpret_cast<const bf16x8*>(kbp + goff1); } while (0)
#define SWRITE(b, i) do { *(bf16x8*)((char*)V_lds + (b) * SHM_V + vst0) = sr_[i].vs0;          \
    *(bf16x8*)((char*)V_lds + (b) * SHM_V + vst1) = sr_[i].vs1; int kc = sc * 2;               \
    *(bf16x8*)((char*)K_lds + (b) * SHM_K + KSWZ(sr, kc)) = sr_[i].ks0;                       \
    *(bf16x8*)((char*)K_lds + (b) * SHM_K + KSWZ(32 + sr, kc)) = sr_[i].ks1; } while (0)
#define SWAIT() do { if constexpr (SDEPTH == 2) asm volatile("s_waitcnt vmcnt(4)" ::: "memory"); else asm volatile("s_waitcnt vmcnt(0)" ::: "memory"); } while (0)
#define RESC(a) do { if (__any((a) < 1.f)) { if (hi == 0) al_l[r32] = (a); asm volatile("s_waitcnt lgkmcnt(0)" ::: "memory"); \
    for (int d = 0; d < 4; ++d) for (int r = 0; r < 16; ++r) o[d][r] *= al_l[crow(r, hi)]; } } while (0)
  f32x16 pA0, pA1, pB0, pB1; float mnA, mnB, alA, alB; bf16x8 pa0, pa1, pa2, pa3;
  constexpr int SE = 0, SO = SDEPTH - 1;
  SLOAD(SE, 0); asm volatile("s_waitcnt vmcnt(0)" ::: "memory"); SWRITE(0, SE); __syncthreads();
  const char* kb0 = (const char*)K_lds + r32 * KPITCH + hi * 16;
  qkt<0>(pA0, pA1, kb0, qr); qkt_order<0>(); SBAR(); partialSM(pA0, pA1, m_reg, mnA, alA);
  SLOAD(SO, KVBLK); if constexpr (SDEPTH == 2) { if (2 < NT) SLOAD(SE, 2 * KVBLK); }
  SWAIT(); SWRITE(1, SO); __syncthreads();
  for (int j = 1; j + 1 < NT; j += 2) {
    SBAR(); qkt<1>(pB0, pB1, kb0, qr); expP0(pA0); qkt_order<16>(); SBAR();
    if (__builtin_expect((j + 1) * KVBLK > nvalid, 0)) kmask(pB0, pB1, j * KVBLK, nvalid, hi);
    finishSM(pA0, pA1, alA, l_reg, pa0, pa1, pa2, pa3); SBAR();
    SLOAD(SO, (j + SDEPTH) * KVBLK); SBAR();
    pv_d0(o, vb0, pa0, pa1, pa2, pa3); partialSM(pB0, pB1, m_reg, mnB, alB);
    __syncthreads(); SWAIT(); SWRITE(0, SE);
    RESC(alB); __syncthreads();
    SBAR(); qkt<0>(pA0, pA1, kb0, qr); expP0(pB0); qkt_order<16>(); SBAR();
    if (__builtin_expect((j + 2) * KVBLK > nvalid, 0)) kmask(pA0, pA1, (j + 1) * KVBLK, nvalid, hi);
    finishSM(pB0, pB1, alB, l_reg, pa0, pa1, pa2, pa3); SBAR();
    if (SDEPTH == 1 || j + 3 < NT) SLOAD(SE, (j + 1 + SDEPTH) * KVBLK); SBAR();
    pv_d0(o, vb0 + (int)SHM_V, pa0, pa1, pa2, pa3); partialSM(pA0, pA1, m_reg, mnA, alA);
    __syncthreads(); SWAIT(); SWRITE(1, SO);
    RESC(alA); __syncthreads();
  }
  nxt = ::mix_issue(qctr);
  expP0(pA0); finishSM(pA0, pA1, alA, l_reg, pa0, pa1, pa2, pa3); SBAR();
  pv_d0(o, vb0, pa0, pa1, pa2, pa3);
  if (hi == 0) li_l[r32] = l_reg; asm volatile("s_waitcnt lgkmcnt(0)" ::: "memory");
  const int rbase = wid * QBLK; const bool odd = (lane & 1);
#pragma unroll
  for (int r = 0; r < 16; r += 2) {
    const int rowA = crow(r, hi), rowB = crow(r + 1, hi);
    const float ia = __builtin_amdgcn_rcpf(li_l[rowA]), ib = __builtin_amdgcn_rcpf(li_l[rowB]);
    const int myrow = odd ? rowB : rowA;
#pragma unroll
    for (int d0 = 0; d0 < 4; ++d0) {
      const float va = o[d0][r] * ia, vb = o[d0][r + 1] * ib;
      const float send = odd ? va : vb, got = ::xshfl<1>(send);
      const unsigned w = odd ? cvtpk(got, vb) : cvtpk(va, got);
      const int orow = rbase + myrow;
      if (orow < qvalid) *(unsigned*)(Ob + (packed ? (long)(orow & 15) * LDO + (orow >> 4) * HD : (long)orow * LDO) + d0 * 32 + (r32 & ~1)) = w;
    }
  }
#undef SLOAD
#undef SWRITE
#undef SWAIT
#undef RESC
}
#undef KSWZ
#undef SBAR
}

struct FiltArgs { const zt_t* tf; const zt_t* tb; const float* skip; };
template <int N, int RL>
__device__ __forceinline__ void conv_unit(bool dostore, int skip  , char* ldsg, const FiltArgs fa, int c, int L, zt_t* z0p, zt_t* z1p  , unsigned* qctr, unsigned& nxt  ) {
    constexpr int NT = 512, PER = N / NT;
    int tid_ = threadIdx.x; asm volatile("" : "+v"(tid_));
    const int tid = tid_;
    cf* buf = (cf*)ldsg;
    float* side = (float*)(ldsg + LDS_SIDE);
    float* exf = side + 128;
    float* exb = side + 160;
    float* zh0 = side + 192, *zh1 = side + 224, *zt0 = side + 256, *zt1 = side + 288;
    float* red = side + 320;
    const int lo = N - L + 1;
    constexpr int LC = (N == 16384) ? LP : LS, PZ = (LC + NT - 1) / NT, PT = (LC / 4 + NT - 1) / NT;
    float zr0[PZ], zr1[PZ];
    { int t0 = tid; asm volatile("" : "+v"(t0));
#pragma unroll
    for (int i = 0; i < PZ; ++i) { const int t = t0 + i * NT; const bool ok = ((i + 1) * NT <= LC) || t < L; zr0[i] = ok ? (float)z0p[t] : 0.f; zr1[i] = ok ? (float)z1p[t] : 0.f; } }
    const float delta = 3.0701134573253945f + (float)c * (12.280453829301578f / 1023.0f);
    const float tinv = 1.0f / (float)(L - 1);
    float asum = 0.f;
    if (!(skip & 1)) for (int q = tid; q < (L >> 2); q += NT) {
        typedef _Float16 h4 __attribute__((ext_vector_type(4)));
        const h4 sfh = *(const h4*)(fa.tf + 4 * q), sbh = *(const h4*)(fa.tb + 4 * q);
        const f32x4 sf4 = {(float)sfh[0], (float)sfh[1], (float)sfh[2], (float)sfh[3]}, sb4 = {(float)sbh[0], (float)sbh[1], (float)sbh[2], (float)sbh[3]};
#pragma unroll
        for (int i = 0; i < 4; ++i) {
            const int k = 4 * q + i;
            const float dec = __expf(-(float)k * tinv * delta);
            const float sf = sf4[i] * dec, sb = sb4[i] * dec;
            asum += fabsf(sf) + (k >= 1 ? fabsf(sb) : 0.f);
            if (k < lo) { cf v; v.x = sf; v.y = 0.f; buf[fphys(k)] = v; if (k >= 1) { cf w; w.x = sb; w.y = 0.f; buf[fphys(N - k)] = w; } }
            else { float zz = 0.f; asm volatile("" : "+v"(zz)); cf v; v.x = zz; v.y = zz; buf[fphys(k)] = v; exf[k - lo] = sf; exb[k - lo] = sb; }
        }
    }
    asum = wave_sum(asum);
    if ((tid & 63) == 0) red[tid >> 6] = asum;
    __syncthreads();
    float norm = __builtin_amdgcn_rcpf(((red[0] + red[1]) + (red[2] + red[3])) + ((red[4] + red[5]) + (red[6] + red[7])));
    asm volatile("" : "+v"(norm));
    cf Hreg[PER / RL][RL];
    {
        if (!(skip & 2)) {
        { using FP = FPass<N, 16, NT, 1>; cf u[FP::B][16]; FP::load(buf, tid, u); __syncthreads(); FP::compute(tid, u); FP::store(buf, tid, u); __syncthreads(); }
        { using FP = FPass<N, 16, NT, 16>; cf u[FP::B][16]; FP::load(buf, tid, u); __syncthreads(); FP::compute(tid, u); FP::store(buf, tid, u); __syncthreads(); }
        { using FP = FPass<N, 16, NT, 256>; cf u[FP::B][16]; FP::load(buf, tid, u); __syncthreads(); FP::compute(tid, u); FP::store(buf, tid, u); __syncthreads(); }
        }
        FPass<N, RL, NT, 4096>::load(buf, tid, Hreg); __syncthreads(); FPass<N, RL, NT, 4096>::compute(tid, Hreg);
    }
#pragma unroll
    for (int i = 0; i < PZ; ++i) { const int t = tid + i * NT; cf v; v.x = zr0[i]; v.y = zr1[i];
        if (i == 0) { if (t <= 30) { zh0[t] = v.x; zh1[t] = v.y; } }
        if ((i + 1) * NT > N - LC + 1) { if (t >= lo && t < L) { zt0[t - lo] = v.x; zt1[t - lo] = v.y; } }
        buf[fphys(t)] = v; }
    for (int t = tid + PZ * NT; t < N; t += NT) { float zz = 0.f; asm volatile("" : "+v"(zz)); cf v; v.x = zz; v.y = zz; buf[fphys(t)] = v; }
    __syncthreads();
    if (!(skip & 4)) {
        { using FP = FPass<N, 16, NT, 1>; cf u[FP::B][16]; FP::load(buf, tid, u); __syncthreads(); FP::compute(tid, u); FP::store(buf, tid, u); __syncthreads(); }
        { using FP = FPass<N, 16, NT, 16>; cf u[FP::B][16]; FP::load(buf, tid, u); __syncthreads(); FP::compute(tid, u); FP::store(buf, tid, u); __syncthreads(); }
        { using FP = FPass<N, 16, NT, 256>; cf u[FP::B][16]; FP::load(buf, tid, u); __syncthreads(); FP::compute(tid, u); FP::store(buf, tid, u); __syncthreads(); }
        { cf u[PER / RL][RL]; FPass<N, RL, NT, 4096>::load(buf, tid, u); __syncthreads(); FPass<N, RL, NT, 4096>::compute(tid, u);
#pragma unroll
          for (int b = 0; b < PER / RL; ++b)
#pragma unroll
              for (int r = 0; r < RL; ++r) { cf w = cmul(u[b][r], Hreg[b][r]); w.y = -w.y; u[b][r] = w; }
          FPass<N, RL, NT, 4096>::store(buf, tid, u); __syncthreads(); }
    }
    if (dostore) nxt = mix_issue(qctr);
    if (!(skip & 4)) {
        { using FP = FPass<N, 16, NT, 1>; cf u[FP::B][16]; FP::load(buf, tid, u); __syncthreads(); FP::compute(tid, u); FP::store(buf, tid, u); __syncthreads(); }
        { using FP = FPass<N, 16, NT, 16>; cf u[FP::B][16]; FP::load(buf, tid, u); __syncthreads(); FP::compute(tid, u); FP::store(buf, tid, u); __syncthreads(); }
        { using FP = FPass<N, 16, NT, 256>; cf u[FP::B][16]; FP::load(buf, tid, u); __syncthreads(); FP::compute(tid, u); FP::store(buf, tid, u); __syncthreads(); }
        { cf u[PER / RL][RL]; FPass<N, RL, NT, 4096>::load(buf, tid, u); __syncthreads(); FPass<N, RL, NT, 4096>::compute(tid, u); FPass<N, RL, NT, 4096>::store(buf, tid, u); __syncthreads(); }
    }
    const float sk = fa.skip[c], sc = norm * (1.0f / (float)N);
    if (!(skip & 8)) {
        float y0[PZ], y1[PZ];
        int tf = tid; asm volatile("" : "+v"(tf));
#pragma unroll
        for (int i = 0; i < PZ; ++i) { const int t = tf + i * NT; const bool ok = ((i + 1) * NT <= LC) || t < L; y0[i] = ok ? (float)z0p[t] : 0.f; y1[i] = ok ? (float)z1p[t] : 0.f; }
#pragma unroll
        for (int i = 0; i < PZ; ++i) { const int t = tf + i * NT;
            if (((i + 1) * NT <= LC) || t < L) {
                const cf v = buf[fphys(t)];
                float a = v.x * sc, b = -v.y * sc;
                if (i == 0 || (i + 1) * NT > N - LC + 1) {
                    float ca = 0.f, cb = 0.f;
                    if (t >= lo) for (int k = lo; k <= t; ++k) { const float h = exf[k - lo]; ca += h * zh0[t - k]; cb += h * zh1[t - k]; }
                    if (t <= L - 1 - lo) for (int k = lo; k <= L - 1 - t; ++k) { const float h = exb[k - lo]; ca += h * zt0[t + k - lo]; cb += h * zt1[t + k - lo]; }
                    a += ca * norm; b += cb * norm; }
                a += sk * y0[i]; b += sk * y1[i];
                if (dostore) { z0p[t] = (zt_t)a; z1p[t] = (zt_t)b; } } }
    }
    __syncthreads();
}

#define XB_TMO      128
#define XB_XCNT(j)  (256  + 64 * (j))
#define XB_XSUB(j)  (1280 + 64 * (j))
#define XB_XGEN(j)  (2304 + 64 * (j))
#define XB_TOP      3328
#define XB_TOPGEN   3392
#define XCD_BAR_WORDS 3456
#define XB_SPIN_CAP (1u << 18)
__device__ __forceinline__ unsigned xb_ld(unsigned* p)              { return __hip_atomic_load(p, __ATOMIC_RELAXED, __HIP_MEMORY_SCOPE_AGENT); }
__device__ __forceinline__ unsigned xb_add(unsigned* p, unsigned v) { return __hip_atomic_fetch_add(p, v, __ATOMIC_RELAXED, __HIP_MEMORY_SCOPE_AGENT); }
__device__ __forceinline__ unsigned xb_xcc_id() { return (unsigned)__builtin_amdgcn_s_getreg((3 << 11) | 20) & 0xFu; }
#define XB_SPIN(cond, bar) do { unsigned _sp = 0; while (cond) { __builtin_amdgcn_s_sleep(1); \
    if ((++_sp & 255u) == 0u) { if (xb_ld(&(bar)[XB_TMO])) break; if (_sp > XB_SPIN_CAP) { atomicAdd(&(bar)[XB_TMO], 1u); break; } } } } while (0)
struct XcdBarrier { unsigned* bar; unsigned x; volatile LAS unsigned* st; };
__device__ __forceinline__ XcdBarrier xcd_barrier_post(unsigned* bar, volatile LAS unsigned* st) {
    XcdBarrier b; b.bar = bar; b.x = xb_xcc_id(); b.st = st;
    if (threadIdx.x == 0) (void)xb_add(&bar[XB_XCNT(b.x)], 1u);
    return b;
}
__device__ __forceinline__ void xcd_barrier_complete(unsigned* bar, unsigned x, unsigned& nloc, unsigned& nx) {
    const unsigned G = gridDim.x * gridDim.y * gridDim.z;
    unsigned sum, cnt, mine, sp = 0u;
    for (;;) {
        sum = 0u; cnt = 0u; mine = 0u;
#pragma unroll
        for (unsigned j = 0; j < 16; ++j) { const unsigned c = xb_ld(&bar[XB_XCNT(j)]); sum += c; cnt += (c > 0u) ? 1u : 0u; mine = (j == x) ? c : mine; }
        if (sum == G) break;
        __builtin_amdgcn_s_sleep(1);
        if ((++sp & 255u) == 0u) { if (xb_ld(&bar[XB_TMO])) break; if (sp > XB_SPIN_CAP) { atomicAdd(&bar[XB_TMO], 1u); break; } }
    }
    nloc = mine > 0u ? mine : 1u; nx = cnt > 0u ? cnt : 1u;
}
__device__ __forceinline__ void xcd_barrier(const XcdBarrier& b) {
    asm volatile("s_waitcnt vmcnt(0)" ::: "memory");
    __syncthreads();
    if (threadIdx.x == 0) {
        unsigned* bar = b.bar; unsigned bx = b.x;
        asm volatile("" : "+s"(bar), "+s"(bx));
        __builtin_amdgcn_s_waitcnt(0);
        unsigned nloc = b.st[0], nx = b.st[1];
        if (nloc == 0u) { xcd_barrier_complete(bar, bx, nloc, nx); b.st[0] = nloc; b.st[1] = nx; }
        const unsigned old = xb_add(&bar[XB_XSUB(bx)], 1u);
        const unsigned gen = old / nloc;
        if (old + 1u == (gen + 1u) * nloc) {
            __builtin_amdgcn_fence(__ATOMIC_RELEASE, "agent");
            asm volatile("s_waitcnt vmcnt(0)" ::: "memory");
            const unsigned og = xb_add(&bar[XB_TOP], 1u);
            const unsigned tg = og / nx;
            if (og + 1u == (tg + 1u) * nx) xb_add(&bar[XB_TOPGEN], 1u);
            else XB_SPIN(xb_ld(&bar[XB_TOPGEN]) == tg, bar);
            __builtin_amdgcn_fence(__ATOMIC_ACQUIRE, "agent");
            xb_add(&bar[XB_XGEN(bx)], 1u);
            asm volatile("s_waitcnt vmcnt(0)" ::: "memory");
        } else {
            XB_SPIN(xb_ld(&bar[XB_XGEN(bx)]) == gen, bar);
            __builtin_amdgcn_fence(__ATOMIC_ACQUIRE, "agent");
            asm volatile("s_waitcnt vmcnt(0)" ::: "memory");
        }
    }
    __syncthreads();
}

struct Ptrs {
    const float *x_prompt, *x_sample, *meta, *ln_g, *ln_b, *ffa_w13, *ffa_w2, *w_in, *b_gate, *conv_w, *conv_b, *f_w1, *f_b1, *f_freq, *f_w2, *f_b2, *f_w3, *skip, *q_norm, *k_norm,
                *w_br_hy, *w_br_attn, *w_out, *ffb_w13, *ffb_w2;
    float* out; unsigned char* ws;
};
typedef const __attribute__((address_space(4))) Ptrs CPtrs;
__device__ __forceinline__ unsigned pkh16(float lo, float hi) { unsigned a, b; asm volatile("v_cvt_f16_f32 %0, %1" : "=v"(a) : "v"(lo)); asm volatile("v_cvt_f16_f32 %0, %1" : "=v"(b) : "v"(hi)); return (a & 0xffffu) | (b << 16); }
#ifndef MMA_F16
#define MMA_F16 0
#endif
#if MMA_F16
__device__ __forceinline__ unsigned pkh2(float lo, float hi) { return pkh16(lo, hi); }
__device__ __forceinline__ float hsum2(unsigned w) { return pg8::f16_lo(w) + pg8::f16_hi(w); }
#else
__device__ __forceinline__ unsigned pkh2(float lo, float hi) { return pk2(lo, hi); }
__device__ __forceinline__ float hsum2(unsigned w) { return bflo(w) + bfhi(w); }
#endif
__device__ __forceinline__ void transpose_item(const float* W, int K, int N, bf16* WT, int k0, int n0, int dst_row0, LAS float* scr, int lane, const float* gk, const float* bk, float (&csum)[4], float (&bsum)[4], int ldw  ) {
#pragma unroll 8
    for (int i = 0; i < 32; ++i) { const int kk = 2 * i + (lane >> 5); scr[kk * 33 + (lane & 31)] = W[(size_t)(k0 + kk) * N + n0 + (lane & 31)]; }
    LDS_WAIT(); asm volatile("" ::: "memory");
    const int c = lane & 7;
    float gq[8], bq[8];
#pragma unroll
    for (int q = 0; q < 8; ++q) { gq[q] = gk ? gk[k0 + 8 * c + q] : 1.0f; bq[q] = gk ? bk[k0 + 8 * c + q] : 0.0f; }
#pragma unroll
    for (int j = 0; j < 4; ++j) { const int n = (lane >> 3) + 8 * j; const LAS float* s = scr + (8 * c) * 33 + n;
        float w[8]; float bs = 0.f;
#pragma unroll
        for (int q = 0; q < 8; ++q) { const float x = s[q * 33]; bs += bq[q] * x; w[q] = x * gq[q]; }
        v4u o; if (gk) { o.x = pkh2(w[0], w[1]); o.y = pkh2(w[2], w[3]); o.z = pkh2(w[4], w[5]); o.w = pkh2(w[6], w[7]); } else { o.x = pk2(w[0], w[1]); o.y = pk2(w[2], w[3]); o.z = pk2(w[4], w[5]); o.w = pk2(w[6], w[7]); }
        *(GAS v4u*)(WT + (size_t)(dst_row0 + n) * ldw + k0 + 8 * c) = o;
        if (gk) { csum[j] += (hsum2(o.x) + hsum2(o.y)) + (hsum2(o.z) + hsum2(o.w)); bsum[j] += bs; } }
    LDS_WAIT(); asm volatile("" ::: "memory");
}
__device__ __forceinline__ int swiglu_row(int n0) { const int up = n0 >= DFF, j = up ? n0 - DFF : n0; return 256 * (j >> 7) + (up ? 128 : 0) + (j & 127); }
__device__ __forceinline__ void convert_one(const float* W, int K, int N, bf16* WT, int item, LAS float* scr, int lane, int ldw = 0  ) {
    const int nblk = N / 32, kb = item / nblk, nb = item % nblk; float cd[4], bd[4];
    transpose_item(W, K, N, WT, 64 * kb, 32 * nb, 32 * nb, scr, lane, nullptr, nullptr, cd, bd, ldw ? ldw : K);
}
__device__ __forceinline__ void convert_folded(const float* W, int N, bf16* WT, int item, bool swiglu, LAS float* scr, int lane, const float* gk, const float* bk, float* cs, float* cb) {
    const int nb = item >> 1, half = item & 1, n0 = 32 * nb, dst = swiglu ? swiglu_row(n0) : n0;
    float csum[4] = {0.f, 0.f, 0.f, 0.f}, bsum[4] = {0.f, 0.f, 0.f, 0.f};
    for (int kb = half * (DM / 128); kb < (half + 1) * (DM / 128); ++kb) transpose_item(W, DM, N, WT, 64 * kb, n0, dst, scr, lane, gk, bk, csum, bsum, DM);
#pragma unroll
    for (int j = 0; j < 4; ++j) { float a = csum[j], b = bsum[j];
        a += xshfl<1>(a); a += xshfl<2>(a); a += xshfl<4>(a); b += xshfl<1>(b); b += xshfl<2>(b); b += xshfl<4>(b);
        if ((lane & 7) == 0) { const int n = (lane >> 3) + 8 * j; cs[(size_t)half * NCS + dst + n] = a; cb[(size_t)half * NCS + dst + n] = b; } }
}
__device__ __forceinline__ const float* ln_gain(CPtrs& P, int idx) { return idx < 0 ? (const float*)(P.ws + WS_ONE) : P.ln_g + (size_t)idx * DM; }
__device__ __forceinline__ const float* ln_bias(CPtrs& P, int idx) { return idx < 0 ? (const float*)(P.ws + WS_ONE) + DM : P.ln_b + (size_t)idx * DM; }
__device__ __forceinline__ void phase_convert(CPtrs& P, int layer, LAS unsigned char* lds, int gw, int NGW, int wave, int lane) {
    LAS float* scr = (LAS float*)(lds + wave * 16384);
    constexpr int F13 = 2 * (2 * DFF / 32), FIN = 2 * (NIN / 32), NFOLD = 2 * F13 + FIN;
    constexpr int I2 = (DFF / 64) * (DM / 32), IBH = (DHY / 64) * (DM / 32), IBA = (DM / 64) * (DM / 32), NSHORT = 2 * I2 + IBH + 2 * IBA;
    unsigned char* ws = P.ws;
    float* CS = (float*)(ws + WS_CS) + (size_t)layer * 2 * NCS; float* CB = (float*)(ws + WS_CB) + (size_t)layer * 2 * NCS;
    const int lnA = layer == 0 ? -1 : (layer - 1) * 3 + 2, lnI = layer * 3 + 0, lnB = layer * 3 + 1;
    for (int it = gw; it < NFOLD + NSHORT; it += NGW) {
        int r = it;
        if (r < F13) { convert_folded(P.ffa_w13 + (size_t)layer * DM * 2 * DFF, 2 * DFF, (bf16*)(ws + WS_W13A), r, true, scr, lane, ln_gain(P, lnA), ln_bias(P, lnA), CS + CS_W13A, CB + CS_W13A); continue; } r -= F13;
        if (r < FIN) { convert_folded(P.w_in + (size_t)layer * DM * NIN, NIN, (bf16*)(ws + WS_WIN), r, false, scr, lane, ln_gain(P, lnI), ln_bias(P, lnI), CS + CS_WIN, CB + CS_WIN); continue; } r -= FIN;
        if (r < F13) { convert_folded(P.ffb_w13 + (size_t)layer * DM * 2 * DFF, 2 * DFF, (bf16*)(ws + WS_W13B), r, true, scr, lane, ln_gain(P, lnB), ln_bias(P, lnB), CS + CS_W13B, CB + CS_W13B); continue; } r -= F13;
        if (r < I2) { convert_one(P.ffa_w2 + (size_t)layer * DFF * DM, DFF, DM, (bf16*)(ws + WS_W2A), r, scr, lane); continue; } r -= I2;
        if (r < IBH) { convert_one(P.w_br_hy + (size_t)layer * DHY * DM, DHY, DM, (bf16*)(ws + WS_WBH), r, scr, lane, DYC); continue; } r -= IBH;
        if (r < IBA) { convert_one(P.w_br_attn + (size_t)layer * DM * DM, DM, DM, (bf16*)(ws + WS_WBH) + DHY, r, scr, lane, DYC); continue; } r -= IBA;
        if (r < IBA) { convert_one(P.w_out + (size_t)layer * DM * DM, DM, DM, (bf16*)(ws + WS_WOUT), r, scr, lane); continue; } r -= IBA;
        convert_one(P.ffb_w2 + (size_t)layer * DFF * DM, DFF, DM, (bf16*)(ws + WS_W2B), r, scr, lane);
    }
}
__device__ __forceinline__ void row_to_seq(int m, int& s, int& t) { s = m < LP ? 0 : (m < 2 * LP ? 1 : (m < 2 * LP + LS ? 2 : 3)); t = m - seq_row0(s); }
__device__ __forceinline__ void phase_init(CPtrs& P, int gw, int NGW, int lane) {
    bf16* HB = (bf16*)(P.ws + WS_HB); bf16* R16 = (bf16*)(P.ws + WS_H32);
    { long long* ST = (long long*)(P.ws + WS_ST); float* ONE = (float*)(P.ws + WS_ONE);
      const size_t t0 = (size_t)gw * 64 + lane, ts = (size_t)NGW * 64;
      for (size_t e = t0; e < (size_t)MPAD * 2; e += ts) ST[e] = (e & 1) ? (long long)(2048.0 * (1.0 - 1e-5) * 1048576.0) : 0ll;
      for (size_t e = (size_t)MPAD * 2 + t0; e < (size_t)NSTAT * MPAD * 2; e += ts) ST[e] = 0ll;
      for (size_t e = t0; e < (size_t)2 * DM; e += ts) ONE[e] = e < DM ? 1.0f : 0.0f; }
    for (int m = gw; m < MPAD; m += NGW) {
        const float* src = nullptr;
        if (m < NTOK) { int s, t; row_to_seq(m, s, t);
            if (t < NMETA) src = P.meta + (size_t)t * DM;
            else src = (s < 2 ? P.x_prompt + ((size_t)s * SP + (t - NMETA)) * DM : P.x_sample + ((size_t)(s - 2) * SS + (t - NMETA)) * DM); }
#pragma unroll
        for (int j = 0; j < 4; ++j) { const int e = 8 * lane + 512 * j;
            f32x4 a = {0.f, 0.f, 0.f, 0.f}, b = {0.f, 0.f, 0.f, 0.f};
            if (src) { a = *(const f32x4*)(src + e); b = *(const f32x4*)(src + e + 4); }
            v4u o; o.x = pk2(a[0], a[1]); o.y = pk2(a[2], a[3]); o.z = pk2(b[0], b[1]); o.w = pk2(b[2], b[3]);
            if (!MMA_F16) *(v4u*)(HB + (size_t)m * DM + e) = o;
            v4u h; h.x = pkh16(a[0], a[1]); h.y = pkh16(a[2], a[3]); h.z = pkh16(b[0], b[1]); h.w = pkh16(b[2], b[3]);
            *(v4u*)(R16 + (size_t)m * DM + e) = h; }
    }
}
__device__ __forceinline__ void phase_filter_hidden(CPtrs& P, int gw, int NGW, int lane) {
    bf16* H2 = (bf16*)(P.ws + WS_H2);
    { bf16* W3T = (bf16*)(P.ws + WS_W3T);
      for (int e = gw * 64 + lane; e < DEPTH * 2 * DHY * FILT_W; e += NGW * 64) { const int j = e & 63, cc = (e >> 6) & (2 * DHY - 1), ly = e >> 17; W3T[e] = (bf16)f2bf(P.f_w3[((size_t)ly * FILT_W + j) * 2 * DHY + cc]); } }
    for (int layer = 0; layer < DEPTH; ++layer) {
        float w1c[FILT_EMB], w2c[FILT_W];
#pragma unroll
        for (int f = 0; f < FILT_EMB; ++f) w1c[f] = P.f_w1[((size_t)layer * FILT_EMB + f) * FILT_W + lane];
#pragma unroll
        for (int i = 0; i < FILT_W; ++i) w2c[i] = P.f_w2[((size_t)layer * FILT_W + i) * FILT_W + lane];
        const float b1 = P.f_b1[layer * FILT_W + lane], b2 = P.f_b2[layer * FILT_W + lane], fq = P.f_freq[layer * FILT_W + lane];
        for (int rr = gw; rr < LP + LS; rr += NGW) {
            const int grp = rr < LP ? 0 : 1, k = grp ? rr - LP : rr, L = grp ? LS : LP;
            float zf;
            { const float w = 6.283185307179586f * (float)k / (float)L;
              if (lane == 0) zf = (float)k / (float)(L - 1);
              else { const int mm = (lane - 1) & 15; const float fr = 1e-4f + (float)mm * ((15.0f - 1e-4f) / 15.0f); const float rv = __builtin_amdgcn_fractf(fr * (float)k / (float)L); zf = (lane <= 16) ? __builtin_amdgcn_cosf(rv) : -__builtin_amdgcn_sinf(rv); } }
            float a = b1;
#pragma unroll
            for (int f = 0; f < FILT_EMB; ++f) a += __builtin_bit_cast(float, __builtin_amdgcn_readlane(__builtin_bit_cast(int, zf), f)) * w1c[f];
            const float h1 = __builtin_amdgcn_sinf(__builtin_amdgcn_fractf(fq * a * 0.15915494309189535f));
            float c = b2;
#pragma unroll
            for (int i = 0; i < FILT_W; ++i) c += __builtin_bit_cast(float, __builtin_amdgcn_readlane(__builtin_bit_cast(int, h1), i)) * w2c[i];
            H2[(((size_t)layer * 2 + grp) * LP + k) * FILT_W + lane] = (bf16)f2bf(__builtin_amdgcn_sinf(__builtin_amdgcn_fractf(fq * c * 0.15915494309189535f)));
        }
    }
}
__device__ __forceinline__ void phase_taps(CPtrs& P, int layer, int gw, int NGW, int lane) {
    const bf16* W3T = (const bf16*)(P.ws + WS_W3T) + (size_t)layer * 2 * DHY * FILT_W; zt_t* TAPS = (zt_t*)(P.ws + WS_G);
    const int fr = lane & 15, fq = lane >> 4;
    constexpr int NKP = (LP + 63) / 64, NKS = (LS + 63) / 64, NITEM = (NKP + NKS) * 8;
    for (int it = gw; it < NITEM; it += NGW) {
        const int kb = it >> 3, cb = it & 7, grp = kb >= NKP ? 1 : 0, L = grp ? LS : LP, k0 = (grp ? kb - NKP : kb) * 64;
        const bf16* hb = (const bf16*)(P.ws + WS_H2) + ((size_t)layer * 2 + grp) * LP * FILT_W;
        bf16x8 a[4][2];
#pragma unroll
        for (int mt = 0; mt < 4; ++mt) { int row = k0 + 16 * mt + fr; row = row < L ? row : L - 1;
#pragma unroll
            for (int ks = 0; ks < 2; ++ks) a[mt][ks] = *(const bf16x8*)(hb + (size_t)row * FILT_W + 32 * ks + 8 * fq); }
        zt_t* tb = TAPS + (grp ? (size_t)2 * DHY * LP : 0);
#pragma unroll 4
        for (int ct = 0; ct < 16; ++ct) {
            const int cc = cb * 256 + ct * 16 + fr;
            const bf16x8 b0 = *(const bf16x8*)(W3T + (size_t)cc * FILT_W + 8 * fq), b1 = *(const bf16x8*)(W3T + (size_t)cc * FILT_W + 32 + 8 * fq);
#pragma unroll
            for (int mt = 0; mt < 4; ++mt) { f32x4 acc = {0.f, 0.f, 0.f, 0.f};
                acc = __builtin_amdgcn_mfma_f32_16x16x32_bf16(a[mt][0], b0, acc, 0, 0, 0); acc = __builtin_amdgcn_mfma_f32_16x16x32_bf16(a[mt][1], b1, acc, 0, 0, 0);
                const int kk = k0 + 16 * mt + 4 * fq;
                if (kk < L) { typedef _Float16 h4 __attribute__((ext_vector_type(4))); const h4 hv = {(_Float16)acc[0], (_Float16)acc[1], (_Float16)acc[2], (_Float16)acc[3]}; *(h4*)(tb + (size_t)cc * L + kk) = hv; } }
        }
    }
}
__device__ __forceinline__ void phase_ln_out(CPtrs& P, const float* g, const float* b, int gw, int NGW, int lane) {
    const bf16* HB = (const bf16*)(P.ws + WS_H32);
    f32x4 gv[8], bv[8];
#pragma unroll
    for (int j = 0; j < 4; ++j) { const int e = 8 * lane + 512 * j; gv[2 * j] = *(const f32x4*)(g + e); gv[2 * j + 1] = *(const f32x4*)(g + e + 4); bv[2 * j] = *(const f32x4*)(b + e); bv[2 * j + 1] = *(const f32x4*)(b + e + 4); }
    typedef _Float16 h2 __attribute__((ext_vector_type(2)));
    for (int m = gw; m < NTOK; m += NGW) {
        int s, t; row_to_seq(m, s, t); if (t < NMETA) continue;
        float* orow = P.out + (s < 2 ? ((size_t)s * SP + (t - NMETA)) * DM : (size_t)2 * SP * DM + ((size_t)(s - 2) * SS + (t - NMETA)) * DM);
        f32x4 v[8]; float sm = 0.f;
#pragma unroll
        for (int j = 0; j < 4; ++j) { const v4u w = *(const v4u*)(HB + (size_t)m * DM + 8 * lane + 512 * j);
            v[2 * j] = (f32x4){pg8::f16_lo(w.x), pg8::f16_hi(w.x), pg8::f16_lo(w.y), pg8::f16_hi(w.y)}; v[2 * j + 1] = (f32x4){pg8::f16_lo(w.z), pg8::f16_hi(w.z), pg8::f16_lo(w.w), pg8::f16_hi(w.w)}; }
#pragma unroll
        for (int j = 0; j < 8; ++j) sm += (v[j][0] + v[j][1]) + (v[j][2] + v[j][3]);
        const float mean = wave_sum(sm) * (1.0f / DM); float s2 = 0.f;
#pragma unroll
        for (int j = 0; j < 8; ++j) { v[j] = v[j] - mean; s2 += (v[j][0] * v[j][0] + v[j][1] * v[j][1]) + (v[j][2] * v[j][2] + v[j][3] * v[j][3]); }
        const float rstd = __builtin_amdgcn_rsqf(wave_sum(s2) * (1.0f / DM) + LN_EPS);
#pragma unroll
        for (int j = 0; j < 4; ++j) { const int e = 8 * lane + 512 * j;
            *(f32x4*)(orow + e) = v[2 * j] * rstd * gv[2 * j] + bv[2 * j]; *(f32x4*)(orow + e + 4) = v[2 * j + 1] * rstd * gv[2 * j + 1] + bv[2 * j + 1]; }
    }
}
__device__ __forceinline__ void phase_qkprep(CPtrs& P, int layer, int gw, int NGW, int lane) {
    bf16* PR = (bf16*)(P.ws + WS_PROJ); bf16* KC = (bf16*)(P.ws + WS_KC);
    const int h2 = lane >> 5, l = lane & 31, seg = l >> 4, j = l & 15, idxA = seg * 64 + 2 * j, idxB = idxA + 32;
    const float invf0 = exp2f(-(float)(2 * j) * (13.287712379549449f / 32.0f)), invf1 = exp2f(-(float)(2 * j + 1) * (13.287712379549449f / 32.0f));
    const float gqA0 = P.q_norm[layer * HD + idxA], gqA1 = P.q_norm[layer * HD + idxA + 1], gqB0 = P.q_norm[layer * HD + idxB], gqB1 = P.q_norm[layer * HD + idxB + 1];
    const float gkA0 = P.k_norm[layer * HD + idxA], gkA1 = P.k_norm[layer * HD + idxA + 1], gkB0 = P.k_norm[layer * HD + idxB], gkB1 = P.k_norm[layer * HD + idxB + 1];
    for (int m = gw; m < NTOK; m += NGW) {
        int s, t; row_to_seq(m, s, t);
        float rowp, colp; if (t < NMETA) { rowp = -1.0f; colp = (float)t; } else { const int jj = t - NMETA; rowp = (float)(jj >> 6); colp = (float)(jj & 63); }
        const float pos = seg ? colp : rowp;
        const float rv0 = pos * invf0 * 0.15915494309189535f, rv1 = pos * invf1 * 0.15915494309189535f;
        const float sn0 = __builtin_amdgcn_sinf(rv0), cs0 = __builtin_amdgcn_cosf(rv0), sn1 = __builtin_amdgcn_sinf(rv1), cs1 = __builtin_amdgcn_cosf(rv1);
        bf16* rowb = PR + (size_t)m * NIN;
        unsigned wA[10], wB[10];
#pragma unroll
        for (int it = 8; it < 10; ++it) { const int hd = 2 * it + h2; const bf16* hp = rowb + (it < 8 ? COL_Q + hd * HD : COL_K + (hd - NQH) * HD);
            wA[it] = *(const unsigned*)(hp + idxA); wB[it] = *(const unsigned*)(hp + idxB); }
#pragma unroll
        for (int it = 8; it < 10; ++it) { const int hd = 2 * it + h2; bf16* hp = (it < 8) ? rowb + COL_Q + hd * HD : KC + (kc_row(s, hd - NQH) + t) * HD;
            const float a0 = bflo(wA[it]), a1 = bfhi(wA[it]), b0 = bflo(wB[it]), b1 = bfhi(wB[it]);
            float ss = (a0 * a0 + a1 * a1) + (b0 * b0 + b1 * b1);
            ss += xshfl<1>(ss); ss += xshfl<2>(ss); ss += xshfl<4>(ss); ss += xshfl<8>(ss); ss += xshfl<16>(ss);
            const float rstd = __builtin_amdgcn_rsqf(ss * (1.0f / HD) + QK_EPS);
            const float n1a = a0 * rstd * (it < 8 ? gqA0 : gkA0), n1b = a1 * rstd * (it < 8 ? gqA1 : gkA1), n2a = b0 * rstd * (it < 8 ? gqB0 : gkB0), n2b = b1 * rstd * (it < 8 ? gqB1 : gkB1);
            *(unsigned*)(hp + idxA) = pk2(n1a * cs0 - n2a * sn0, n1b * cs1 - n2b * sn1);
            *(unsigned*)(hp + idxB) = pk2(n2a * cs0 + n1a * sn0, n2b * cs1 + n1b * sn1); }
    }
}
__device__ __forceinline__ void phase_vcopy(CPtrs& P, int gw, int NGW, int lane) {
    const bf16* PR = (const bf16*)(P.ws + WS_PROJ); bf16* KC = (bf16*)(P.ws + WS_KC); bf16* VC = (bf16*)(P.ws + WS_VC);
    const int kvh = lane >> 4, e = (lane & 15) * 8;
    (void)kvh; (void)e; (void)PR;
    constexpr int PADP = LPP - LP, PADS = LSP - LS, NPAD = 2 * NKVH * PADP + 2 * NKVH * PADS;
    for (int r = gw; r < NPAD; r += NGW) { int s, q = r; if (q < 2 * NKVH * PADP) { s = q / (NKVH * PADP); q -= s * NKVH * PADP; } else { q -= 2 * NKVH * PADP; s = 2 + q / (NKVH * PADS); q -= (s - 2) * NKVH * PADS; }
        const int pad = s < 2 ? PADP : PADS, kv = q / pad, t = seq_len(s) + q % pad;
        if (lane < 16) { unsigned z0 = 0u; asm volatile("" : "+v"(z0)); const v4u z = {z0, z0, z0, z0}; *(v4u*)(KC + (kc_row(s, kv) + t) * HD + lane * 8) = z; } }
}
__device__ __forceinline__ void hy_item(int it, int& s, int& tt, int& ct) {
    constexpr int NTP = (LP + 31) / 32, NTS = (LS + 31) / 32;
    int r = it; if (r < 2 * NTP * 8) { s = r / (NTP * 8); r -= s * NTP * 8; } else { r -= 2 * NTP * 8; s = 2 + r / (NTS * 8); r -= (s - 2) * NTS * 8; }
    ct = r & 7; tt = r >> 3;
}
constexpr int HY_NITEM = 2 * ((LP + 31) / 32) * 8 + 2 * ((LS + 31) / 32) * 8;
__device__ __forceinline__ void phase_hy_pre(CPtrs& P, int layer, LAS unsigned char* lds, int gw, int NGW, int wave, int lane) {
    const bf16* PR = (const bf16*)(P.ws + WS_PROJ); zt_t* ZT = (zt_t*)(P.ws + WS_ZT);
    LAS float* tile = (LAS float*)(lds + wave * 16896);
    const float* cw = P.conv_w + (size_t)layer * 3 * 3 * DHY; const float* cb = P.conv_b + (size_t)layer * 3 * DHY;
    const int half = lane >> 5, tl5 = lane & 31;
    for (int it = gw; it < HY_NITEM; it += NGW) {
        int s, tt, ct; hy_item(it, s, tt, ct);
        const int L = seq_len(s), row0 = seq_row0(s), t0 = tt * 32, c0 = ct * 128 + 2 * lane;
        unsigned xr[34], vr[34];
#pragma unroll
        for (int i = 0; i < 34; ++i) { const int t = t0 - 1 + i; const bool ok = (t >= 0 && t < L); const bf16* rp = PR + (size_t)(row0 + (ok ? t : 0)) * NIN + c0;
            const unsigned xa = *(const unsigned*)(rp + DHY), va = *(const unsigned*)(rp + 2 * DHY); xr[i] = ok ? xa : 0u; vr[i] = ok ? va : 0u; }
        float wx[3][2], wv[3][2], bx[2], bv[2];
#pragma unroll
        for (int k = 0; k < 3; ++k) { wx[k][0] = cw[k * 3 * DHY + DHY + c0]; wx[k][1] = cw[k * 3 * DHY + DHY + c0 + 1]; wv[k][0] = cw[k * 3 * DHY + 2 * DHY + c0]; wv[k][1] = cw[k * 3 * DHY + 2 * DHY + c0 + 1]; }
        bx[0] = cb[DHY + c0]; bx[1] = cb[DHY + c0 + 1]; bv[0] = cb[2 * DHY + c0]; bv[1] = cb[2 * DHY + c0 + 1];
#pragma unroll
        for (int q = 0; q < 32; ++q) {
            const float x0 = wx[0][0] * bflo(xr[q]) + wx[1][0] * bflo(xr[q + 1]) + wx[2][0] * bflo(xr[q + 2]) + bx[0], x1 = wx[0][1] * bfhi(xr[q]) + wx[1][1] * bfhi(xr[q + 1]) + wx[2][1] * bfhi(xr[q + 2]) + bx[1];
            const float v0 = wv[0][0] * bflo(vr[q]) + wv[1][0] * bflo(vr[q + 1]) + wv[2][0] * bflo(vr[q + 2]) + bv[0], v1 = wv[0][1] * bfhi(vr[q]) + wv[1][1] * bfhi(vr[q + 1]) + wv[2][1] * bfhi(vr[q + 2]) + bv[1];
            tile[lane * 33 + q] = x0 * v0; tile[2112 + lane * 33 + q] = x1 * v1;
        }
        LDS_WAIT(); asm volatile("" ::: "memory");
        zt_t* zb = ZT + zt_off(s) + (size_t)(ct * 128 + half) * L + t0 + tl5;
        if (t0 + tl5 < L) {
#pragma unroll 16
            for (int cc = 0; cc < 64; ++cc) zb[(size_t)(2 * cc) * L] = (zt_t)tile[half * 2112 + cc * 33 + tl5];
        }
        LDS_WAIT(); asm volatile("" ::: "memory");
    }
}
__device__ __forceinline__ void phase_hy_post(CPtrs& P, int layer, LAS unsigned char* lds, int gw, int NGW, int wave, int lane) {
    const bf16* PR = (const bf16*)(P.ws + WS_PROJ); const zt_t* ZT = (const zt_t*)(P.ws + WS_ZT); bf16* YH = (bf16*)(P.ws + WS_YHY);
    LAS float* tile = (LAS float*)(lds + wave * 16896);
    const float* cw = P.conv_w + (size_t)layer * 3 * 3 * DHY; const float* cb = P.conv_b + (size_t)layer * 3 * DHY;
    const int half = lane >> 5, tl5 = lane & 31;
    for (int it = gw; it < HY_NITEM; it += NGW) {
        int s, tt, ct; hy_item(it, s, tt, ct);
        const int L = seq_len(s), row0 = seq_row0(s), t0 = tt * 32, c0 = ct * 128 + 2 * lane;
        unsigned xr[34];
#pragma unroll
        for (int i = 0; i < 34; ++i) { const int t = t0 - 1 + i; const bool ok = (t >= 0 && t < L); const unsigned xa = *(const unsigned*)(PR + (size_t)(row0 + (ok ? t : 0)) * NIN + c0); xr[i] = ok ? xa : 0u; }
        { const bool okt = (t0 + tl5 < L); const zt_t* zb = ZT + zt_off(s) + (size_t)(ct * 128 + half) * L + (okt ? t0 + tl5 : 0);
#pragma unroll 16
          for (int cc = 0; cc < 64; ++cc) { const float z = (float)zb[(size_t)(2 * cc) * L]; tile[half * 2112 + cc * 33 + tl5] = okt ? z : 0.f; } }
        float wx[3][2], bx[2];
#pragma unroll
        for (int k = 0; k < 3; ++k) { wx[k][0] = cw[k * 3 * DHY + c0]; wx[k][1] = cw[k * 3 * DHY + c0 + 1]; }
        bx[0] = cb[c0]; bx[1] = cb[c0 + 1];
        LDS_WAIT(); asm volatile("" ::: "memory");
#pragma unroll
        for (int q = 0; q < 32; ++q) {
            const float x0 = wx[0][0] * bflo(xr[q]) + wx[1][0] * bflo(xr[q + 1]) + wx[2][0] * bflo(xr[q + 2]) + bx[0], x1 = wx[0][1] * bfhi(xr[q]) + wx[1][1] * bfhi(xr[q + 1]) + wx[2][1] * bfhi(xr[q + 2]) + bx[1];
            if (t0 + q < L) *(unsigned*)(YH + (size_t)(row0 + t0 + q) * DYC + c0) = pk2(x0 * tile[lane * 33 + q], x1 * tile[2112 + lane * 33 + q]);
        }
        LDS_WAIT(); asm volatile("" ::: "memory");
    }
}
constexpr int NFB_P = LP / 256, NFB_S = LS / 256;
static_assert(LP - NFB_P * 256 == 16 && LS - NFB_S * 256 == 16 && ((LP + 63) / 64) % 2 == 1 && ((LS + 63) / 64) % 2 == 1, "attention unit geometry (odd tile counts)");
constexpr int NU_SP = NQH * NFB_P + NKVH, NU_SS = NQH * NFB_S + NKVH;
constexpr int NU_AP = 2 * NU_SP, NU_AS = 2 * NU_SS, NU_ATT = NU_AP + NU_AS;
constexpr int NU_MIX = NU_ATT + 2 * DHY;
__device__ __forceinline__ int mix_fetch(volatile LAS unsigned* MISC, unsigned* qctr) {
    __syncthreads();
    if (threadIdx.x == 0) MISC[16] = __hip_atomic_fetch_add(qctr, 1u, __ATOMIC_RELAXED, __HIP_MEMORY_SCOPE_AGENT);
    __syncthreads();
    return __builtin_amdgcn_readfirstlane((int)MISC[16]);
}
__device__ __forceinline__ int mix_complete(volatile LAS unsigned* MISC, unsigned v) {
    __syncthreads();
    int t = threadIdx.x; asm volatile("" : "+v"(t));
    if (t == 0) MISC[16] = v;
    __syncthreads();
    return __builtin_amdgcn_readfirstlane((int)MISC[16]);
}
#ifndef MIX_MASK
#define MIX_MASK 7
#endif
#define FFT_REPS ((REP_MASK >> 16 & 1u) ? 2 : 1)
#define PROBE_SKIP ((int)(REP_MASK >> 24 & 15u))
template <int MODE  >
__device__ __forceinline__ void phase_mix(CPtrs& P, int layer, unsigned char* ldsg, volatile LAS unsigned* MISC, unsigned* qctr) {
    int u = mix_fetch(MISC, qctr); unsigned nxt = 0u;
    while (u < NU_ATT) {
        if (MIX_MASK & 1) {
            const bf16* PR = (const bf16*)(P.ws + WS_PROJ); bf16* YA = (bf16*)(P.ws + WS_YHY) + DHY; const bf16* KC = (const bf16*)(P.ws + WS_KC); const bf16* VC = (const bf16*)(P.ws + WS_VC);
            int s, r, L, nfb;
            if (u < NU_AP) { s = u / NU_SP; r = u % NU_SP; L = LP; nfb = NFB_P; } else { const int v = u - NU_AP; s = 2 + v / NU_SS; r = v % NU_SS; L = LS; nfb = NFB_S; }
            int hd, q0, qvalid, packed;
            if (r < NQH * nfb) { hd = r / nfb; q0 = (r % nfb) * 256; qvalid = 256; packed = 0; } else { hd = 4 * (r - NQH * nfb); q0 = nfb * 256; qvalid = 64; packed = 1; }
            const int row0 = seq_row0(s), kvh = hd >> 2, NT = (L + 63) / 64;
            att::attn_unit(PR + (size_t)(row0 + q0) * NIN + COL_Q + hd * HD, qvalid, packed, KC + kc_row(s, kvh) * HD, PR + (size_t)row0 * NIN + COL_V + kvh * HD,
                           YA + (size_t)(row0 + q0) * DYC + hd * HD, L, NT, (char*)ldsg, qctr, nxt, P.q_norm + layer * HD, q0);
        }
        u = mix_complete(MISC, nxt);
    }
    if (MODE == 1) return;
    while (u < NU_ATT + DHY) {
        if (MIX_MASK & 2) {
            zt_t* ZT = (zt_t*)(P.ws + WS_ZT); const int c = u - NU_ATT;
            FiltArgs fa; fa.tf = (const zt_t*)(P.ws + WS_G) + (size_t)c * LP; fa.tb = fa.tf + (size_t)DHY * LP; fa.skip = P.skip + (size_t)layer * DHY;
            for (int rp = 0; rp < FFT_REPS; ++rp) conv_unit<16384, 4>(rp == FFT_REPS - 1, rp == FFT_REPS - 1 ? 0 : PROBE_SKIP, (char*)ldsg, fa, c, LP, ZT + zt_off(0) + (size_t)c * LP, ZT + zt_off(1) + (size_t)c * LP, qctr, nxt);
        }
        u = mix_complete(MISC, nxt);
    }
    while (u < NU_MIX) {
        if (MIX_MASK & 4) {
            zt_t* ZT = (zt_t*)(P.ws + WS_ZT); const int c = u - NU_ATT - DHY;
            FiltArgs fa; fa.tf = (const zt_t*)(P.ws + WS_G) + (size_t)2 * DHY * LP + (size_t)c * LS; fa.tb = fa.tf + (size_t)DHY * LS; fa.skip = P.skip + (size_t)layer * DHY;
            for (int rp = 0; rp < FFT_REPS; ++rp) conv_unit<8192, 2>(rp == FFT_REPS - 1, rp == FFT_REPS - 1 ? 0 : PROBE_SKIP, (char*)ldsg, fa, c, LS, ZT + zt_off(2) + (size_t)c * LS, ZT + zt_off(3) + (size_t)c * LS, qctr, nxt);
        }
        u = mix_complete(MISC, nxt);
    }
}

__device__ __forceinline__ CPtrs* lsp(CPtrs* p) { asm volatile("" : "+s"(p)); return p; }
__device__ __forceinline__ int lvg(int v) { asm volatile("" : "+v"(v)); return v; }
__device__ __forceinline__ int lsg(int v) { asm volatile("" : "+s"(v)); return v; }
#ifndef W2_WGM
#define W2_WGM 4
#endif
#ifndef W2_REV
#define W2_REV 0
#endif
constexpr int MMAIN = 24576, MTAIL0 = MMAIN;
static_assert(NTOK - MMAIN == 64, "tail panel is exactly 64 rows");
constexpr int NPH_LAYER = 14, NPHASES = 1 + DEPTH * NPH_LAYER;
struct Args { Ptrs p; int ph_lo, ph_hi; };
__global__ void __launch_bounds__(512, 2) fwd(Args args) {
    extern __shared__ __attribute__((aligned(16))) unsigned char lds[];
    CPtrs* Pk = (CPtrs*)__builtin_amdgcn_kernarg_segment_ptr();
#define P (*lsp(Pk))
    LAS unsigned char* ldsl = (LAS unsigned char*)lds;
    volatile LAS unsigned* MISC = (volatile LAS unsigned*)(ldsl + LDS_MISC);
    const int tid = threadIdx.x, lane = tid & 63, wave = __builtin_amdgcn_readfirstlane(tid >> 6);
    const int G = gridDim.x, gw = blockIdx.x * 8 + wave, NGW = G * 8;
    if (tid < 64) MISC[tid] = 0u;
    __syncthreads();
    unsigned* ctl = (unsigned*)(P.ws + WS_CTL);
    const int lo = args.ph_lo, hi = args.ph_hi;
    const bool multi = (hi - lo) > 1;
    XcdBarrier bar; bar.bar = ctl + CW_BAR; bar.x = 0; bar.st = nullptr;
    if (multi) bar = xcd_barrier_post(ctl + CW_BAR, MISC + 8);
#ifndef PH_MASK
#define PH_MASK 0xFFFFFFFFu
#endif
#ifndef REP_MASK
#define REP_MASK 0u
#endif
#define NREP(j) ((REP_MASK >> (j) & 1u) ? 2 : 1)
#define INP(k, j) ((PH_MASK >> (j) & 1u) && lo <= (k) && (k) < hi)
#define IN(k) (lo <= (k) && (k) < hi)
#define SEAM(k) do { if (IN(k) && (k) + 1 < hi) xcd_barrier(bar); } while (0)
    if (INP(0, 14)) { phase_init(P, gw, NGW, lane); phase_filter_hidden(P, gw, NGW, lane); }
    SEAM(0);
    const pg8::bf16_t* HB = (const pg8::bf16_t*)(P.ws + (MMA_F16 ? WS_H32 : WS_HB));
    pg8::bf16_t* PROJ = (pg8::bf16_t*)(P.ws + WS_PROJ);
    bf16* RBw = MMA_F16 ? (bf16*)nullptr : (bf16*)(P.ws + WS_HB);
#define STAT(i) ((float*)((long long*)(P.ws + WS_ST) + (size_t)(i) * MPAD * 2))
    for (int layer = 0; layer < DEPTH; ++layer) {
        const int pb = 1 + layer * NPH_LAYER;
        const int sA = layer == 0 ? 0 : 3 * layer, sI = 1 + 3 * layer, sB = 2 + 3 * layer, sC = 3 + 3 * layer;
        const int lnA = layer == 0 ? -1 : (layer - 1) * 3 + 2, lnI = layer * 3, lnB = layer * 3 + 1;
        const float* CSl = (const float*)(P.ws + WS_CS) + (size_t)layer * 2 * NCS; const float* CBl = (const float*)(P.ws + WS_CB) + (size_t)layer * 2 * NCS;
        for (int rep = 0; rep < NREP(0); ++rep) { if (rep) xcd_barrier(bar);
        if (INP(pb + 0, 0)) { phase_convert(P, layer, ldsl, lsg(gw), lsg(NGW), lsg(wave), lvg(lane)); phase_taps(P, layer, lsg(gw), lsg(NGW), lvg(lane)); }
        }
        SEAM(pb + 0);
        for (int rep = 0; rep < NREP(1); ++rep) { if (rep) xcd_barrier(bar);
        if (INP(pb + 1, 1)) {
            pg8::Gemm g{HB, (const pg8::bf16_t*)(P.ws + WS_W13A), MPAD, 2 * DFF, DM}; pg8::StaticOrder S; S.init(MPAD, 2 * DFF, lsg(G), lsg((int)blockIdx.x));
            pg8::EpiSwiglu E{PROJ, DFF, STAT(sA), CSl + CS_W13A, CBl + CS_W13A};
            pg8::gemm_phase<pg8::EpiSwiglu, pg8::StaticOrder, true, true, MMA_F16 != 0>(ldsl, g, S, E);
        }
        }
        SEAM(pb + 1);
        if (INP(pb + 2, 2)) {
            pg8::Gemm g{PROJ, (const pg8::bf16_t*)(P.ws + WS_W2A), MMAIN, DM, DFF}; pg8::StaticOrder S; S.init(MMAIN, DM, lsg(G), lsg((int)blockIdx.x), W2_WGM, W2_REV);
            pg8::EpiResid E{(pg8::bf16_t*)(P.ws + WS_H32), (pg8::bf16_t*)RBw, DM, ALPHA, 0.5f, STAT(sA), ln_gain(P, lnA), ln_bias(P, lnA), STAT(sI)};
            gemm_tail(ldsl, (const bf16*)PROJ + (size_t)MTAIL0 * DFF, (const bf16*)(P.ws + WS_W2A), DM, DFF, MTAIL0, E, lsg(G), lsg((int)blockIdx.x));
            pg8::gemm_phase<pg8::EpiResid, pg8::StaticOrder, true, true>(ldsl, g, S, E);
        }
        SEAM(pb + 2);
        for (int rep = 0; rep < NREP(4); ++rep) { if (rep) xcd_barrier(bar);
        if (INP(pb + 4, 4)) {
            pg8::Gemm g{HB, (const pg8::bf16_t*)(P.ws + WS_WIN), MMAIN, NIN, DM}; pg8::StaticOrder S; S.init(MMAIN, NIN, lsg(G), lsg((int)blockIdx.x));
            pg8::EpiProj E{PROJ, NIN, P.b_gate + (size_t)layer * 2 * DM, COL_G, STAT(sI), CSl + CS_WIN, CBl + CS_WIN};
            { pg8::EpiProjTail ET{E}; gemm_tailn<3>(ldsl, (const bf16*)HB + (size_t)MTAIL0 * DM, (const bf16*)(P.ws + WS_WIN), NIN, DM, MTAIL0, ET, lsg(G), lsg((int)blockIdx.x)); }
            pg8::gemm_phase<pg8::EpiProj, pg8::StaticOrder, true, true, MMA_F16 != 0>(ldsl, g, S, E);
        }
        }
        SEAM(pb + 4);
        if (INP(pb + 5, 5)) {
            if (wave & 1) { phase_hy_pre(P, layer, ldsl, lsg(gw), lsg(NGW), lsg(wave), lvg(lane)); phase_vcopy(P, lsg(gw), lsg(NGW), lvg(lane)); phase_qkprep(P, layer, lsg(gw), lsg(NGW), lvg(lane)); }
            else { phase_qkprep(P, layer, lsg(gw), lsg(NGW), lvg(lane)); phase_vcopy(P, lsg(gw), lsg(NGW), lvg(lane)); phase_hy_pre(P, layer, ldsl, lsg(gw), lsg(NGW), lsg(wave), lvg(lane)); }
            if (NREP(5) > 1) { xcd_barrier(bar); phase_vcopy(P, lsg(gw), lsg(NGW), lvg(lane)); phase_hy_pre(P, layer, ldsl, lsg(gw), lsg(NGW), lsg(wave), lvg(lane)); } }
        SEAM(pb + 5);
        if (INP(pb + 6, 6)) { phase_mix<0>(P, layer, lds, MISC, ctl + CW_Q + 64 * layer);
            if (NREP(6) > 1) { xcd_barrier(bar); phase_mix<1>(P, layer, lds, MISC, ctl + CW_Q + 64 * (DEPTH + layer)); } }
        SEAM(pb + 6);
        for (int rep = 0; rep < NREP(7); ++rep) { if (rep) xcd_barrier(bar);
        if (INP(pb + 7, 7)) phase_hy_post(P, layer, ldsl, lsg(gw), lsg(NGW), lsg(wave), lvg(lane));
        }
        SEAM(pb + 7);
        for (int rep = 0; rep < NREP(8); ++rep) { if (rep) xcd_barrier(bar);
        if (INP(pb + 8, 8)) {
            pg8::Gemm g{(const pg8::bf16_t*)(P.ws + WS_YHY), (const pg8::bf16_t*)(P.ws + WS_WBH), MMAIN, DM, DYC}; pg8::StaticOrder S; S.init(MMAIN, DM, lsg(G), lsg((int)blockIdx.x), W2_WGM, W2_REV);
            pg8::EpiGate2 E{(pg8::bf16_t*)(P.ws + WS_G), DM, PROJ + COL_G, NIN};
            gemm_tail2(ldsl, (const bf16*)(P.ws + WS_YHY) + (size_t)MTAIL0 * DYC, (const bf16*)(P.ws + WS_WBH), DM, DYC, DHY, MTAIL0, E, lsg(G), lsg((int)blockIdx.x));
            pg8::gemm_phase<pg8::EpiGate2, pg8::StaticOrder, true, true>(ldsl, g, S, E);
        }
        }
        SEAM(pb + 8);
        if (INP(pb + 9, 9)) {
            pg8::Gemm g{(const pg8::bf16_t*)(P.ws + WS_G), (const pg8::bf16_t*)(P.ws + WS_WOUT), MMAIN, DM, DM}; pg8::StaticOrder S; S.init(MMAIN, DM, lsg(G), lsg((int)blockIdx.x), W2_WGM, W2_REV);
            pg8::EpiResid E{(pg8::bf16_t*)(P.ws + WS_H32), (pg8::bf16_t*)RBw, DM, ALPHA, 1.0f, STAT(sI), ln_gain(P, lnI), ln_bias(P, lnI), STAT(sB)};
            gemm_tail(ldsl, (const bf16*)(P.ws + WS_G) + (size_t)MTAIL0 * DM, (const bf16*)(P.ws + WS_WOUT), DM, DM, MTAIL0, E, lsg(G), lsg((int)blockIdx.x));
            pg8::gemm_phase<pg8::EpiResid, pg8::StaticOrder, true, true>(ldsl, g, S, E);
        }
        SEAM(pb + 9);
        for (int rep = 0; rep < NREP(11); ++rep) { if (rep) xcd_barrier(bar);
        if (INP(pb + 11, 11)) {
            pg8::Gemm g{HB, (const pg8::bf16_t*)(P.ws + WS_W13B), MPAD, 2 * DFF, DM}; pg8::StaticOrder S; S.init(MPAD, 2 * DFF, lsg(G), lsg((int)blockIdx.x));
            pg8::EpiSwiglu E{PROJ, DFF, STAT(sB), CSl + CS_W13B, CBl + CS_W13B};
            pg8::gemm_phase<pg8::EpiSwiglu, pg8::StaticOrder, true, true, MMA_F16 != 0>(ldsl, g, S, E);
        }
        }
        SEAM(pb + 11);
        if (INP(pb + 12, 12)) {
            pg8::Gemm g{PROJ, (const pg8::bf16_t*)(P.ws + WS_W2B), MMAIN, DM, DFF}; pg8::StaticOrder S; S.init(MMAIN, DM, lsg(G), lsg((int)blockIdx.x), W2_WGM, W2_REV);
            pg8::EpiResid E{(pg8::bf16_t*)(P.ws + WS_H32), (pg8::bf16_t*)(layer == DEPTH - 1 ? (bf16*)nullptr : RBw), DM, ALPHA, 0.5f, STAT(sB), ln_gain(P, lnB), ln_bias(P, lnB), STAT(sC)};
            gemm_tail(ldsl, (const bf16*)PROJ + (size_t)MTAIL0 * DFF, (const bf16*)(P.ws + WS_W2B), DM, DFF, MTAIL0, E, lsg(G), lsg((int)blockIdx.x));
            pg8::gemm_phase<pg8::EpiResid, pg8::StaticOrder, true, true>(ldsl, g, S, E);
        }
        SEAM(pb + 12);
        if (layer == DEPTH - 1 && INP(pb + 13, 13)) phase_ln_out(P, P.ln_g + ((size_t)layer * 3 + 2) * DM, P.ln_b + ((size_t)layer * 3 + 2) * DM, lsg(gw), lsg(NGW), lvg(lane));
    }
#undef STAT
#undef IN
#undef SEAM
#undef P
}

#ifndef MK_N_LAUNCHES
#define MK_N_LAUNCHES 1
#endif
extern "C" void kernel_launch(void* const* d_in, const int* in_sizes, int n_in, void* d_out, int out_size, void* d_ws, size_t ws_size, hipStream_t stream) {
    static int grid = 0;
    if (grid == 0) {
        if (n_in != 25 || ws_size < WS_END) { fprintf(stderr, "kernel_launch: n_in %d ws %zu need %zu\n", n_in, ws_size, (size_t)WS_END); grid = -1; return; }
        int dev = 0, cus = 0, per_cu = 0;
        if (hipGetDevice(&dev) != hipSuccess || hipDeviceGetAttribute(&cus, hipDeviceAttributeMultiprocessorCount, dev) != hipSuccess) { grid = -1; return; }
        if (hipFuncSetAttribute((const void*)fwd, hipFuncAttributeMaxDynamicSharedMemorySize, LDS_BYTES) != hipSuccess) { fprintf(stderr, "kernel_launch: hipFuncSetAttribute failed\n"); grid = -1; return; }
        if (hipOccupancyMaxActiveBlocksPerMultiprocessor(&per_cu, (const void*)fwd, 512, LDS_BYTES) != hipSuccess || per_cu < 1) { fprintf(stderr, "kernel_launch: occupancy query says %d\n", per_cu); grid = -1; (void)hipGetLastError(); return; }
        grid = cus;
    }
    if (grid < 0) return;
    if (hipMemsetAsync((char*)d_ws + WS_CTL, 0, CTL_ZERO_BYTES, stream) != hipSuccess) return;
    Args a{};
    const float** pp = (const float**)&a.p;
    for (int i = 0; i < 25; ++i) pp[i] = (const float*)d_in[i];
    a.p.out = (float*)d_out; a.p.ws = (unsigned char*)d_ws;
#if MK_N_LAUNCHES == 1
    a.ph_lo = 0; a.ph_hi = NPHASES;
    hipLaunchKernelGGL(fwd, dim3(grid), dim3(512), LDS_BYTES, stream, a);
#else
    for (int ph = 0; ph < NPHASES; ++ph) { a.ph_lo = ph; a.ph_hi = ph + 1; hipLaunchKernelGGL(fwd, dim3(grid), dim3(512), LDS_BYTES, stream, a); }
#endif
}
```

```cpp
#ifndef REP_MASK
#define REP_MASK 0u
#endif
#include <hip/hip_runtime.h>
#include <cstdio>
#include <cstdint>
#include <math.h>

constexpr int DM = 2048, DEPTH = 4, NMETA = 16, DFF = 5632, NIN = 10240, DHY = 1024, HD = 128, NQH = 16, NKVH = 4;
constexpr int SP = 8192, SS = 4096, LP = SP + NMETA, LS = SS + NMETA;
constexpr int NTOK = 2 * LP + 2 * LS;
constexpr int MPAD = 24832;
constexpr int COL_Q = 3072, COL_K = 5120, COL_V = 5632, COL_G = 6144;
constexpr float LN_EPS = 1e-5f, QK_EPS = 1e-6f;
constexpr float ALPHA = 1.6817928305074290f;
constexpr int FILT_EMB = 33, FILT_W = 64;
__host__ __device__ __forceinline__ int seq_row0(int s) { return s == 0 ? 0 : (s == 1 ? LP : (s == 2 ? 2 * LP : 2 * LP + LS)); }
__host__ __device__ __forceinline__ int seq_len(int s) { return s < 2 ? LP : LS; }

constexpr size_t MiB = 1u << 20;
constexpr size_t al256(size_t x) { return (x + 255) / 256 * 256; }
constexpr size_t WS_CTL = 0, CTL_ZERO_BYTES = 1 * MiB;
constexpr size_t W13_E = (size_t)2 * DFF * DM, W2_E = (size_t)DM * DFF, WIN_E = (size_t)NIN * DM, WBH_E = (size_t)DM * DHY, WBA_E = (size_t)DM * DM, WOUT_E = (size_t)DM * DM;
constexpr size_t WS_W13A = 1 * MiB, WS_W2A = WS_W13A + 2 * W13_E, WS_WIN = WS_W2A + 2 * W2_E, WS_WBH = WS_WIN + 2 * WIN_E, WS_WBA = WS_WBH + 2 * WBH_E, WS_WOUT = WS_WBA + 2 * WBA_E,
                 WS_W13B = WS_WOUT + 2 * WOUT_E, WS_W2B = WS_W13B + 2 * W13_E, WS_WEND = WS_W2B + 2 * W2_E;
constexpr size_t WS_H32 = al256(WS_WEND);
constexpr size_t WS_HB = WS_H32 + (size_t)MPAD * DM * 4;
constexpr size_t WS_PROJ = WS_HB + (size_t)MPAD * DM * 2;
constexpr size_t WS_ZT = WS_PROJ + (size_t)MPAD * NIN * 2;
constexpr size_t ZT_E = (size_t)2 * DHY * LP + (size_t)2 * DHY * LS;
constexpr int DYC = DHY + DM;
constexpr size_t WS_YHY = al256(WS_ZT + ZT_E * 4);
constexpr size_t WS_YAT = WS_YHY + (size_t)MPAD * DHY * 2;
constexpr size_t WS_G = WS_YAT + (size_t)MPAD * DM * 2;
constexpr size_t WS_H2 = WS_G + (size_t)MPAD * DM * 2;
constexpr size_t WS_W3T = WS_H2 + (size_t)DEPTH * 2 * LP * FILT_W * 2;
static_assert((size_t)2 * DHY * (LP + LS) * 4 <= (size_t)MPAD * DM * 2, "taps fit in G");
constexpr int LPP = 130 * 64, LSP = 66 * 64;
constexpr size_t KC_E = (size_t)(2 * LPP + 2 * LSP) * NKVH * HD;
constexpr size_t WS_KC = al256(WS_W3T + (size_t)DEPTH * 2 * DHY * FILT_W * 2);
constexpr size_t WS_VC = WS_KC + KC_E * 2;
constexpr size_t WS_ST = al256(WS_VC + KC_E * 2);
constexpr int NSTAT = 1 + 3 * DEPTH;
constexpr size_t WS_CS = WS_ST + (size_t)NSTAT * MPAD * 2 * 8;
constexpr int NCS = 2 * DFF + NIN + 2 * DFF, CS_W13A = 0, CS_WIN = 2 * DFF, CS_W13B = 2 * DFF + NIN;
constexpr size_t WS_CB = WS_CS + (size_t)DEPTH * NCS * 8;
constexpr size_t WS_ONE = WS_CB + (size_t)DEPTH * NCS * 8;
constexpr size_t WS_END = WS_ONE + 2 * DM * 4;
__host__ __device__ __forceinline__ size_t kc_row(int s, int kvh) { return (s < 2 ? (size_t)s * NKVH * LPP + (size_t)kvh * LPP : (size_t)2 * NKVH * LPP + (size_t)(s - 2) * NKVH * LSP + (size_t)kvh * LSP); }
typedef _Float16 zt_t;
__host__ __device__ __forceinline__ size_t zt_off(int s) { return s == 0 ? 0 : (s == 1 ? (size_t)DHY * LP : (s == 2 ? (size_t)2 * DHY * LP : (size_t)2 * DHY * LP + (size_t)DHY * LS)); }
constexpr int CW_BAR = 4096;
constexpr int CW_Q = 16384;

constexpr int LDS_FFT_BYTES = (16384 + 16384 / 32) * 8;
constexpr int LDS_SIDE = LDS_FFT_BYTES;
constexpr int LDS_MISC = LDS_SIDE + 2048;
constexpr int LDS_BYTES = 147456;
static_assert(LDS_MISC + 256 <= LDS_BYTES, "LDS map");

#define GAS __attribute__((address_space(1)))
#define LAS __attribute__((address_space(3)))
typedef unsigned short bf16;
typedef unsigned v4u __attribute__((ext_vector_type(4)));
typedef unsigned v2u __attribute__((ext_vector_type(2)));
typedef float f32x4 __attribute__((ext_vector_type(4)));
typedef short bf16x8 __attribute__((ext_vector_type(8)));
#define LDS_WAIT() asm volatile("s_waitcnt lgkmcnt(0)" ::: "memory")
#define VM_WAIT() asm volatile("s_waitcnt vmcnt(0)" ::: "memory")
__device__ __forceinline__ unsigned pk2(float lo, float hi) { unsigned r; asm volatile("v_cvt_pk_bf16_f32 %0, %1, %2" : "=v"(r) : "v"(lo), "v"(hi)); return r; }
__device__ __forceinline__ unsigned f2bf(float f) { return pk2(f, 0.f) & 0xffffu; }
__device__ __forceinline__ float bf2f(unsigned short b) { return __builtin_bit_cast(float, ((unsigned)b) << 16); }
__device__ __forceinline__ float bflo(unsigned w) { return __builtin_bit_cast(float, w << 16); }
__device__ __forceinline__ float bfhi(unsigned w) { return __builtin_bit_cast(float, w & 0xffff0000u); }
__device__ __forceinline__ unsigned mix_issue(unsigned* qctr) {
    unsigned v = 0u; int t = threadIdx.x; asm volatile("" : "+v"(t));
    if (t == 0) v = __hip_atomic_fetch_add(qctr, 1u, __ATOMIC_RELAXED, __HIP_MEMORY_SCOPE_AGENT);
    return v;
}
template <int O> __device__ __forceinline__ float xshfl(float x) { return __builtin_bit_cast(float, __builtin_amdgcn_ds_swizzle(__builtin_bit_cast(int, x), (O << 10) | 0x1f)); }
__device__ __forceinline__ float xadd32(float x) {
    int l = (int)__builtin_amdgcn_mbcnt_hi(~0u, __builtin_amdgcn_mbcnt_lo(~0u, 0u)); asm volatile("" : "+v"(l));
    return x + __builtin_bit_cast(float, __builtin_amdgcn_ds_bpermute((l ^ 32) << 2, __builtin_bit_cast(int, x)));
}
__device__ __forceinline__ float wave_sum(float v) {
    v += xshfl<1>(v); v += xshfl<2>(v); v += xshfl<4>(v); v += xshfl<8>(v); v += xshfl<16>(v);
    return xadd32(v);
}
#ifdef __HIPCC__
#define FHD __host__ __device__ __forceinline__
#else
#define FHD inline
#endif

#if defined(__clang__)
typedef float cf __attribute__((ext_vector_type(2)));
FHD cf cmulc(cf a, cf b) { const cf t = a.xx * b; const cf s = a.yy * b.yx; cf r; r.x = t.x - s.x; r.y = t.y + s.y; return r; }
FHD cf cmul(cf a, cf b) {
#if defined(__HIP_DEVICE_COMPILE__)
    cf t, r;
    asm("v_pk_mul_f32 %0, %1, %2 op_sel:[0,0] op_sel_hi:[0,1]" : "=v"(t) : "v"(a), "v"(b));
    asm("v_pk_fma_f32 %0, %1, %2, %3 op_sel:[1,1,0] op_sel_hi:[1,0,1] neg_lo:[1,0,0]" : "=v"(r) : "v"(a), "v"(b), "v"(t));
    return r;
#else
    return cmulc(a, b);
#endif
}
FHD cf cadd(cf a, cf b) { return a + b; }
FHD cf csub(cf a, cf b) { return a - b; }
FHD cf cmulnegi(cf a) { cf r; r.x = a.y; r.y = -a.x; return r; }
#else
struct cf { float x, y; };
FHD cf cmul(cf a, cf b) { cf r; r.x = a.x * b.x - a.y * b.y; r.y = a.x * b.y + a.y * b.x; return r; }
FHD cf cadd(cf a, cf b) { cf r; r.x = a.x + b.x; r.y = a.y + b.y; return r; }
FHD cf csub(cf a, cf b) { cf r; r.x = a.x - b.x; r.y = a.y - b.y; return r; }
FHD cf cmulnegi(cf a) { cf r; r.x = a.y; r.y = -a.x; return r; }
#endif
FHD int fphys(int i) { return i + (i >> 5); }

FHD cf twid(float frac) {
    cf r;
#if defined(__HIP_DEVICE_COMPILE__)
    r.x = __builtin_amdgcn_cosf(frac); r.y = -__builtin_amdgcn_sinf(frac);
#else
    r.x = cosf(6.283185307179586f * frac); r.y = -sinf(6.283185307179586f * frac);
#endif
    return r;
}

FHD void dft4(cf& a0, cf& a1, cf& a2, cf& a3) {
    const cf s02 = cadd(a0, a2), d02 = csub(a0, a2), s13 = cadd(a1, a3), d13 = cmulnegi(csub(a1, a3));
    a0 = cadd(s02, s13); a2 = csub(s02, s13); a1 = cadd(d02, d13); a3 = csub(d02, d13);
}
template <int R> struct Dft;
template <> struct Dft<2> { static FHD void run(cf (&u)[2]) { const cf a = u[0], b = u[1]; u[0] = cadd(a, b); u[1] = csub(a, b); } };
template <> struct Dft<4> { static FHD void run(cf (&u)[4]) { dft4(u[0], u[1], u[2], u[3]); } };
template <> struct Dft<16> {
    static FHD void run(cf (&u)[16]) {
#pragma unroll
        for (int a = 0; a < 4; ++a) dft4(u[a], u[a + 4], u[a + 8], u[a + 12]);
        const float c1 = 0.92387953251128674f, s1 = 0.38268343236508978f, h = 0.70710678118654752f;
        const cf W1 = {c1, -s1}, W2 = {h, -h}, W3 = {s1, -c1}, W6 = {-h, -h}, W9 = {-c1, s1};
        u[1 + 4] = cmulc(u[1 + 4], W1); u[1 + 8] = cmulc(u[1 + 8], W2); u[1 + 12] = cmulc(u[1 + 12], W3);
        u[2 + 4] = cmulc(u[2 + 4], W2); u[2 + 8] = cmulnegi(u[2 + 8]);  u[2 + 12] = cmulc(u[2 + 12], W6);
        u[3 + 4] = cmulc(u[3 + 4], W3); u[3 + 8] = cmulc(u[3 + 8], W6); u[3 + 12] = cmulc(u[3 + 12], W9);
#pragma unroll
        for (int q = 0; q < 4; ++q) dft4(u[4 * q], u[4 * q + 1], u[4 * q + 2], u[4 * q + 3]);
#pragma unroll
        for (int q = 0; q < 4; ++q)
#pragma unroll
            for (int s = q + 1; s < 4; ++s) { const cf t = u[4 * q + s]; u[4 * q + s] = u[4 * s + q]; u[4 * s + q] = t; }
    }
};

FHD int launder(int t) {
#if defined(__HIP_DEVICE_COMPILE__)
    asm volatile("" : "+v"(t));
#endif
    return t;
}
template <int N, int R, int NT, int P> struct FPass {
    static constexpr int T = N / R, B = T / NT;
    static_assert(T % 32 == 0 && (P == 1 || P == 16 || P % 32 == 0), "offset algebra");
    static FHD void load(const cf* buf, int tid0, cf (&u)[B][R]) {
        const int tid = launder(tid0);
#pragma unroll
        for (int b = 0; b < B; ++b) { const cf* pb = buf + fphys(tid + b * NT);
#pragma unroll
            for (int r = 0; r < R; ++r) u[b][r] = pb[r * (T + T / 32)]; }
    }
    static FHD void compute(int tid0, cf (&u)[B][R]) {
        const int tid = launder(tid0);
#pragma unroll
        for (int b = 0; b < B; ++b) {
            const int i = tid + b * NT, k = i & (P - 1);
            if (P > 1) {
                cf w1 = twid((float)k * (1.0f / (float)(P * R)));
#if defined(__HIP_DEVICE_COMPILE__)
                { float one = 1.0f; asm volatile("" : "+v"(one)); w1 = w1 * one; }
#endif
                cf w = w1;
#pragma unroll
                for (int r = 1; r < R; ++r) { u[b][r] = cmul(u[b][r], w); if (r + 1 < R) w = cmul(w, w1); }
            }
            Dft<R>::run(u[b]);
        }
    }
    static FHD void store(cf* buf, int tid0, const cf (&u)[B][R]) {
        const int tid = launder(tid0);
#pragma unroll
        for (int b = 0; b < B; ++b) {
            const int i = tid + b * NT, k = i & (P - 1), j = (i - k) * R + k;
            cf* q = buf + fphys(j);
            if (P == 1) {
#pragma unroll
                for (int r = 0; r < R; ++r) q[r] = u[b][r];
            } else if (P == 16) {
                cf* qo = q + ((j >> 4) & 1);
#pragma unroll
                for (int r = 0; r < R; ++r) { if (r & 1) qo[16 * r + (r >> 1)] = u[b][r]; else q[16 * r + (r >> 1)] = u[b][r]; }
            } else {
#pragma unroll
                for (int r = 0; r < R; ++r) q[r * (P + P / 32)] = u[b][r];
            }
        }
    }
};
namespace pg8 {
#define PG8_LAS __attribute__((address_space(3)))
typedef unsigned short bf16_t;
typedef short bf16x8 __attribute__((ext_vector_type(8)));
typedef _Float16 f16x8 __attribute__((ext_vector_type(8)));
typedef float f32x4 __attribute__((ext_vector_type(4)));
typedef unsigned u32x4 __attribute__((ext_vector_type(4)));
constexpr int NCS_STRIDE = 2 * 5632 + 10240 + 2 * 5632;
constexpr int BM = 256, BK = 64, HALF = 128, HTB = HALF * BK * 2  , STAGE_BYTES = 8 * HTB, NXCD = 8;

__host__ __device__ __forceinline__ int lds_byte(int r, int c) { const int st = (r >> 4) * 2 + (c >> 5), rr = r & 15, cc = c & 31, ob = rr * 64 + cc * 2; return st * 1024 + (ob ^ (((ob >> 9) & 1) << 5)); }
__host__ __device__ __forceinline__ void stage_rc(int b, int& R, int& C) { const int st = b / 1024, sb = b % 1024, swz = sb ^ (((sb >> 9) & 1) << 5); R = (st >> 1) * 16 + swz / 64; C = (st & 1) * 32 + (swz % 64) / 2; }
__host__ __device__ __forceinline__ int perm32(int rho) { const int n = rho >> 4, i = rho & 15; return 8 * (i >> 2) + 4 * n + (i & 3); }

struct Unit { int pm, pn; };
struct Gemm { const bf16_t* A; const bf16_t* Bt; int M, N, K; };

struct StaticOrder {
    int nM, nN, nwg, G, c, WGM, rev;
    __host__ __device__ void init(int M, int N, int G_, int c_, int wgm = 8, int rev_ = 0) { nM = M / BM; nN = N / BM; nwg = nM * nN; G = G_; c = c_; WGM = wgm; rev = rev_; }
    __host__ __device__ bool next(int i, Unit& u) const {
        const int L = i * G + c; if (L >= nwg) return false;
        int wgid = L; { const int q = nwg / NXCD, r = nwg % NXCD, xcd = wgid % NXCD, off = wgid / NXCD; wgid = (xcd < r ? xcd * (q + 1) : r * (q + 1) + (xcd - r) * q) + off; }
        const int nig = WGM * nN, gid = wgid / nig, fm = gid * WGM, gsz = (nM - fm) < WGM ? (nM - fm) : WGM;
        u.pm = fm + ((wgid % nig) % gsz); u.pn = (wgid % nig) / gsz; if (rev) u.pm = nM - 1 - u.pm; return true;
    }
    __device__ __forceinline__ void a_ready(const Unit&) const {}
    __device__ __forceinline__ void done(const Unit&) const {}
};


__device__ __forceinline__ unsigned cvt_pk_bf16(float lo, float hi) { unsigned r; asm volatile("v_cvt_pk_bf16_f32 %0, %1, %2" : "=v"(r) : "v"(lo), "v"(hi)); return r; }
typedef float f32x2 __attribute__((ext_vector_type(2)));
__device__ __forceinline__ float ubf_lo(unsigned w) { return __builtin_bit_cast(float, w << 16); }
__device__ __forceinline__ float ubf_hi(unsigned w) { return __builtin_bit_cast(float, w & 0xffff0000u); }
__device__ __forceinline__ float silu_f(float x) { return x * __builtin_amdgcn_rcpf(1.0f + __builtin_amdgcn_exp2f(-1.4426950408889634f * x)); }
__device__ __forceinline__ float sigm_f(float x) { return __builtin_amdgcn_rcpf(1.0f + __builtin_amdgcn_exp2f(-1.4426950408889634f * x)); }

constexpr float STAT_SCALE = 1048576.0f, STAT_INV = 1.0f / 1048576.0f;
__device__ __forceinline__ f32x4 cs_load4(const float* p) { return *(const f32x4*)p + *(const f32x4*)(p + NCS_STRIDE); }
__device__ __forceinline__ void stat_add(float* Sn, int row, float ps, float pq) {
    long long* p = (long long*)Sn + 2 * (size_t)row;
    __hip_atomic_fetch_add(p, (long long)__builtin_rintf(ps * STAT_SCALE), __ATOMIC_RELAXED, __HIP_MEMORY_SCOPE_AGENT); __hip_atomic_fetch_add(p + 1, (long long)__builtin_rintf(pq * STAT_SCALE), __ATOMIC_RELAXED, __HIP_MEMORY_SCOPE_AGENT);
}
__device__ __forceinline__ void stat_mr(long long s1i, long long s2i, float& rstd, float& mr) {
    const float mean = (float)s1i * (STAT_INV / 2048.0f); float var = (float)s2i * (STAT_INV / 2048.0f) - mean * mean; var = var < 0.f ? 0.f : var;
    rstd = __builtin_amdgcn_rsqf(var + 1e-5f); mr = mean * rstd;
}
__device__ __forceinline__ void row_mr(const float* S, int row, float& rstd, float& mr) {
    const long long* p = (const long long*)S + 2 * (size_t)row; stat_mr(p[0], p[1], rstd, mr);
}
__device__ __forceinline__ void rows_mr(const float* S, int row0, float (&rstd)[2][4], float (&mr)[2][4]) {
    typedef long long i64x2 __attribute__((ext_vector_type(2)));
#pragma unroll
    for (int ai = 0; ai < 2; ++ai)
#pragma unroll
        for (int m = 0; m < 4; ++m) { const i64x2 st = *(const i64x2*)((const long long*)S + 2 * (size_t)(row0 + ai * HALF + m * 16)); stat_mr(st[0], st[1], rstd[ai][m], mr[ai][m]); }
}
struct EpiSwiglu {
    static constexpr bool PERM = true, AFTER_DRAIN = false; static constexpr int HOOK_T = 0;
    bf16_t* O; int ldc; const float* S; const float* cs; const float* cb;
    __device__ __forceinline__ void operator()(const f32x4 (&acc)[2][2][4][2], const Unit& u, int wr, int wc, int fr, int fq) const {
        const int row0 = u.pm * BM + wr * 64 + fr, col0 = u.pn * HALF + wc * 32 + 8 * fq, wcol0 = u.pn * BM + wc * 32 + 8 * fq;
        f32x4 csv[2][2], cbv[2][2]; float rstdv[2][4], mrv[2][4]; rows_mr(S, row0, rstdv, mrv);
        constexpr float KG = -1.4426950408889634f, KU = -0.6931471805599453f;
#pragma unroll
        for (int bj = 0; bj < 2; ++bj)
#pragma unroll
            for (int n = 0; n < 2; ++n) { csv[bj][n] = cs_load4(cs + wcol0 + bj * HALF + 4 * n); cbv[bj][n] = cs_load4(cb + wcol0 + bj * HALF + 4 * n) * (bj ? KU : KG); }
#pragma unroll
        for (int ai = 0; ai < 2; ++ai)
#pragma unroll
            for (int m = 0; m < 4; ++m) { const int row = row0 + ai * HALF + m * 16; const float rg = rstdv[ai][m] * KG, ru = rstdv[ai][m] * KU, ng = -mrv[ai][m] * KG, nu = -mrv[ai][m] * KU;
                bf16_t* rowp = O + (size_t)row * ldc + col0;
                const f32x4 g0 = acc[ai][0][m][0] * rg + (csv[0][0] * ng + cbv[0][0]), g1 = acc[ai][0][m][1] * rg + (csv[0][1] * ng + cbv[0][1]);
                const f32x4 u0 = acc[ai][1][m][0] * ru + (csv[1][0] * nu + cbv[1][0]), u1 = acc[ai][1][m][1] * ru + (csv[1][1] * nu + cbv[1][1]);
#define SWG(G, U) ((G) * (U) * __builtin_amdgcn_rcpf(1.0f + __builtin_amdgcn_exp2f(G)))
                u32x4 w; w.x = cvt_pk_bf16(SWG(g0[0], u0[0]), SWG(g0[1], u0[1])); w.y = cvt_pk_bf16(SWG(g0[2], u0[2]), SWG(g0[3], u0[3]));
                w.z = cvt_pk_bf16(SWG(g1[0], u1[0]), SWG(g1[1], u1[1])); w.w = cvt_pk_bf16(SWG(g1[2], u1[2]), SWG(g1[3], u1[3]));
#undef SWG
                *(u32x4*)rowp = w; }
    }
};
typedef _Float16 f16x2 __attribute__((ext_vector_type(2)));
__device__ __forceinline__ unsigned pk_f16(float lo, float hi) { unsigned a, b; asm volatile("v_cvt_f16_f32 %0, %1" : "=v"(a) : "v"(lo)); asm volatile("v_cvt_f16_f32 %0, %1" : "=v"(b) : "v"(hi)); return (a & 0xffffu) | (b << 16); }
__device__ __forceinline__ float f16_lo(unsigned w) { return (float)__builtin_bit_cast(f16x2, w)[0]; }
__device__ __forceinline__ float f16_hi(unsigned w) { return (float)__builtin_bit_cast(f16x2, w)[1]; }
struct EpiResid {
    static constexpr bool PERM = true, AFTER_DRAIN = false; static constexpr int HOOK_T = 0;
    bf16_t* R; bf16_t* RB; int ldc; float alpha, s; const float* So; const float* go; const float* bo; float* Sn;
    __device__ __forceinline__ void operator()(const f32x4 (&acc)[2][2][4][2], const Unit& u, int wr, int wc, int fr, int fq) const {
        const int row0 = u.pm * BM + wr * 64 + fr, col0 = u.pn * BM + wc * 32 + 8 * fq;
        f32x4 gv[2][2], bv[2][2]; float rstdv[2][4], mrv[2][4]; rows_mr(So, row0, rstdv, mrv);
#pragma unroll
        for (int bj = 0; bj < 2; ++bj)
#pragma unroll
            for (int n = 0; n < 2; ++n) { gv[bj][n] = *(const f32x4*)(go + col0 + bj * HALF + 4 * n); bv[bj][n] = *(const f32x4*)(bo + col0 + bj * HALF + 4 * n); }
#pragma unroll
        for (int ai = 0; ai < 2; ++ai)
#pragma unroll
            for (int m = 0; m < 4; ++m) { const int row = row0 + ai * HALF + m * 16; const float rstd = rstdv[ai][m], mr = mrv[ai][m];
                const unsigned off = (unsigned)(row * ldc + col0) * 2u; char* rowp = (char*)R + off; char* rbp = (char*)RB + off; float ps = 0.f, pq = 0.f;
#pragma unroll
                for (int bj = 0; bj < 2; ++bj) { const u32x4 hw = *(const u32x4*)(rowp + bj * HALF * 2);
                    const f32x4 h0 = {f16_lo(hw.x), f16_hi(hw.x), f16_lo(hw.y), f16_hi(hw.y)}, h1 = {f16_lo(hw.z), f16_hi(hw.z), f16_lo(hw.w), f16_hi(hw.w)};
                    const f32x4 r0 = ((h0 * rstd - mr) * gv[bj][0] + bv[bj][0]) * alpha + acc[ai][bj][m][0] * s, r1 = ((h1 * rstd - mr) * gv[bj][1] + bv[bj][1]) * alpha + acc[ai][bj][m][1] * s;
                    u32x4 w; w.x = pk_f16(r0[0], r0[1]); w.y = pk_f16(r0[2], r0[3]); w.z = pk_f16(r1[0], r1[1]); w.w = pk_f16(r1[2], r1[3]);
                    *(u32x4*)(rowp + bj * HALF * 2) = w;
                    if (RB) { u32x4 wb; wb.x = cvt_pk_bf16(r0[0], r0[1]); wb.y = cvt_pk_bf16(r0[2], r0[3]); wb.z = cvt_pk_bf16(r1[0], r1[1]); wb.w = cvt_pk_bf16(r1[2], r1[3]);
                        *(u32x4*)(rbp + bj * HALF * 2) = wb; }
                    ps += ((r0[0] + r0[1]) + (r0[2] + r0[3])) + ((r1[0] + r1[1]) + (r1[2] + r1[3]));
                    pq += ((r0[0] * r0[0] + r0[1] * r0[1]) + (r0[2] * r0[2] + r0[3] * r0[3])) + ((r1[0] * r1[0] + r1[1] * r1[1]) + (r1[2] * r1[2] + r1[3] * r1[3])); }
                ps += ::xshfl<16>(ps); ps = ::xadd32(ps); pq += ::xshfl<16>(pq); pq = ::xadd32(pq);
                if (fq == 0) stat_add(Sn, row, ps, pq);
                asm volatile("" ::: "memory"); }
    }
    __device__ __forceinline__ void tail(int row, int col, float s0, float s1) const {
        float rstd, mr; row_mr(So, row, rstd, mr);
        const unsigned hw = *(const unsigned*)(R + (size_t)row * ldc + col);
        const float r0 = ((f16_lo(hw) * rstd - mr) * go[col] + bo[col]) * alpha + s0 * s, r1 = ((f16_hi(hw) * rstd - mr) * go[col + 1] + bo[col + 1]) * alpha + s1 * s;
        *(unsigned*)(R + (size_t)row * ldc + col) = pk_f16(r0, r1); if (RB) *(unsigned*)(RB + (size_t)row * ldc + col) = cvt_pk_bf16(r0, r1);
        float ps = r0 + r1, pq = r0 * r0 + r1 * r1;
        ps += ::xshfl<1>(ps); ps += ::xshfl<2>(ps); ps += ::xshfl<4>(ps); pq += ::xshfl<1>(pq); pq += ::xshfl<2>(pq); pq += ::xshfl<4>(pq);
        if ((threadIdx.x & 7) == 0) stat_add(Sn, row, ps, pq);
    }
};
struct EpiProj {
    static constexpr bool PERM = true, AFTER_DRAIN = false; static constexpr int HOOK_T = 0;
    bf16_t* O; int ldc; const float* bias; int gate_col0; const float* S; const float* cs; const float* cb;
    __device__ __forceinline__ void operator()(const f32x4 (&acc)[2][2][4][2], const Unit& u, int wr, int wc, int fr, int fq) const {
        const int row0 = u.pm * BM + wr * 64 + fr, col0 = u.pn * BM + wc * 32 + 8 * fq;
        const bool gate = (u.pn * BM >= gate_col0);
        f32x4 csv[2][2], cbv[2][2]; float rstdv[2][4], mrv[2][4]; rows_mr(S, row0, rstdv, mrv);
#pragma unroll
        for (int bj = 0; bj < 2; ++bj)
#pragma unroll
            for (int n = 0; n < 2; ++n) { csv[bj][n] = cs_load4(cs + col0 + bj * HALF + 4 * n); cbv[bj][n] = cs_load4(cb + col0 + bj * HALF + 4 * n);
                if (gate) cbv[bj][n] += *(const f32x4*)(bias + (col0 - gate_col0) + bj * HALF + 4 * n); }
#pragma unroll
        for (int ai = 0; ai < 2; ++ai)
#pragma unroll
            for (int m = 0; m < 4; ++m) { const int row = row0 + ai * HALF + m * 16; const float rstd = rstdv[ai][m], mr = mrv[ai][m];
                bf16_t* rowp = O + (size_t)row * ldc + col0;
#pragma unroll
                for (int bj = 0; bj < 2; ++bj) { f32x4 v0 = acc[ai][bj][m][0] * rstd - csv[bj][0] * mr + cbv[bj][0], v1 = acc[ai][bj][m][1] * rstd - csv[bj][1] * mr + cbv[bj][1];
                    if (gate) {
#pragma unroll
                        for (int j = 0; j < 4; ++j) { v0[j] = sigm_f(v0[j]); v1[j] = sigm_f(v1[j]); } }
                    u32x4 w; w.x = cvt_pk_bf16(v0[0], v0[1]); w.y = cvt_pk_bf16(v0[2], v0[3]); w.z = cvt_pk_bf16(v1[0], v1[1]); w.w = cvt_pk_bf16(v1[2], v1[3]);
                    *(u32x4*)(rowp + bj * HALF) = w; } }
    }
};
__device__ __forceinline__ void epiproj_tail(const EpiProj& E, int row, int col, float s0, float s1) {
    float rstd, mr; row_mr(E.S, row, rstd, mr);
    float c0 = E.cs[col] + E.cs[col + NCS_STRIDE], c1 = E.cs[col + 1] + E.cs[col + 1 + NCS_STRIDE], b0 = E.cb[col] + E.cb[col + NCS_STRIDE], b1 = E.cb[col + 1] + E.cb[col + 1 + NCS_STRIDE];
    float v0 = s0 * rstd - c0 * mr + b0, v1 = s1 * rstd - c1 * mr + b1;
    if (col >= E.gate_col0) { v0 = sigm_f(v0 + E.bias[col - E.gate_col0]); v1 = sigm_f(v1 + E.bias[col + 1 - E.gate_col0]); }
    *(unsigned*)(E.O + (size_t)row * E.ldc + col) = cvt_pk_bf16(v0, v1);
}
struct EpiProjTail { const EpiProj& E; __device__ __forceinline__ void tail(int row, int col, float s0, float s1) const { epiproj_tail(E, row, col, s0, s1); } };
struct EpiGate2 {
    static constexpr bool PERM = true, AFTER_DRAIN = false; static constexpr int HOOK_T = DHY / BK;
    bf16_t* G; int ldc; const bf16_t* Gate; int ldg;
    static __device__ __forceinline__ float gcl(float g) { return g < 1e-30f ? 1e-30f : g; }
    __device__ __forceinline__ void mid(f32x4 (&acc)[2][2][4][2], const Unit& u, int wr, int wc, int fr, int fq) const {
        const int row0 = u.pm * BM + wr * 64 + fr, col0 = u.pn * BM + wc * 32 + 8 * fq;
#pragma unroll
        for (int ai = 0; ai < 2; ++ai)
#pragma unroll
          for (int mp = 0; mp < 2; ++mp) {
            u32x4 hv[2][2], av[2][2];
#pragma unroll
            for (int mm = 0; mm < 2; ++mm) { const bf16_t* gp = Gate + (size_t)(row0 + ai * HALF + (2 * mp + mm) * 16) * ldg + col0;
#pragma unroll
                for (int bj = 0; bj < 2; ++bj) { hv[mm][bj] = *(const u32x4*)(gp + bj * HALF); av[mm][bj] = *(const u32x4*)(gp + DM + bj * HALF); } }
#pragma unroll
            for (int mm = 0; mm < 2; ++mm) { const int m = 2 * mp + mm;
#pragma unroll
                for (int bj = 0; bj < 2; ++bj) { const u32x4 h = hv[mm][bj], a = av[mm][bj];
                    const f32x4 r0 = {ubf_lo(h.x) * __builtin_amdgcn_rcpf(gcl(ubf_lo(a.x))), ubf_hi(h.x) * __builtin_amdgcn_rcpf(gcl(ubf_hi(a.x))), ubf_lo(h.y) * __builtin_amdgcn_rcpf(gcl(ubf_lo(a.y))), ubf_hi(h.y) * __builtin_amdgcn_rcpf(gcl(ubf_hi(a.y)))};
                    const f32x4 r1 = {ubf_lo(h.z) * __builtin_amdgcn_rcpf(gcl(ubf_lo(a.z))), ubf_hi(h.z) * __builtin_amdgcn_rcpf(gcl(ubf_hi(a.z))), ubf_lo(h.w) * __builtin_amdgcn_rcpf(gcl(ubf_lo(a.w))), ubf_hi(h.w) * __builtin_amdgcn_rcpf(gcl(ubf_hi(a.w)))};
                    acc[ai][bj][m][0] *= r0; acc[ai][bj][m][1] *= r1; } }
            asm volatile("" ::: "memory"); }
    }
    __device__ __forceinline__ void operator()(const f32x4 (&acc)[2][2][4][2], const Unit& u, int wr, int wc, int fr, int fq) const {
        const int row0 = u.pm * BM + wr * 64 + fr, col0 = u.pn * BM + wc * 32 + 8 * fq;
#pragma unroll
        for (int ai = 0; ai < 2; ++ai) {
            u32x4 av[4][2];
#pragma unroll
            for (int m = 0; m < 4; ++m)
#pragma unroll
                for (int bj = 0; bj < 2; ++bj) av[m][bj] = *(const u32x4*)(Gate + (size_t)(row0 + ai * HALF + m * 16) * ldg + col0 + DM + bj * HALF);
#pragma unroll
            for (int m = 0; m < 4; ++m) { bf16_t* rowp = G + (size_t)(row0 + ai * HALF + m * 16) * ldc + col0;
#pragma unroll
                for (int bj = 0; bj < 2; ++bj) { const u32x4 a = av[m][bj]; const f32x4 a0 = acc[ai][bj][m][0], a1 = acc[ai][bj][m][1];
                    u32x4 w; w.x = cvt_pk_bf16(gcl(ubf_lo(a.x)) * a0[0], gcl(ubf_hi(a.x)) * a0[1]); w.y = cvt_pk_bf16(gcl(ubf_lo(a.y)) * a0[2], gcl(ubf_hi(a.y)) * a0[3]);
                    w.z = cvt_pk_bf16(gcl(ubf_lo(a.z)) * a1[0], gcl(ubf_hi(a.z)) * a1[1]); w.w = cvt_pk_bf16(gcl(ubf_lo(a.w)) * a1[2], gcl(ubf_hi(a.w)) * a1[3]);
                    *(u32x4*)(rowp + bj * HALF) = w; } }
            asm volatile("" ::: "memory"); }
    }
    __device__ __forceinline__ void tail(int row, int col, float h0, float h1, float a0, float a1) const {
        const unsigned gh = *(const unsigned*)(Gate + (size_t)row * ldg + col), ga = *(const unsigned*)(Gate + (size_t)row * ldg + col + DM);
        *(unsigned*)(G + (size_t)row * ldc + col) = cvt_pk_bf16(ubf_lo(gh) * h0 + ubf_lo(ga) * a0, ubf_hi(gh) * h1 + ubf_hi(ga) * a1);
    }
};
template <class Epi, class Sched, bool ALIGN_EPI = false, bool SP2 = false, bool F16 = false  >
__device__ __forceinline__ void gemm_phase(PG8_LAS unsigned char* lds, const Gemm g, const Sched& S, const Epi& E) {
    int tid_ = threadIdx.x; asm volatile("" : "+v"(tid_));
    const int tid = tid_, wid = __builtin_amdgcn_readfirstlane(tid >> 6), lane = tid & 63, wr = wid >> 2, wc = wid & 3, fr = lane & 15, fq = lane >> 4;
    const int K = g.K, nt = K / BK;
    unsigned voffA[2], voffB[2]; int aoff, boff;
    auto lane_offsets = [&](int t) {
        const int l = t & 63;
#pragma unroll
        for (int i = 0; i < 2; ++i) { int R, C; stage_rc(t * 16 + i * 8192, R, C); const int Rb = Epi::PERM ? ((R & ~31) + perm32(R & 31)) : R;
            voffA[i] = (unsigned)(R * K + C) * 2u; voffB[i] = (unsigned)(Rb * K + C) * 2u; }
        aoff = lds_byte(wr * 64 + (l & 15), (l >> 4) * 8); boff = lds_byte(wc * 32 + (l & 15), (l >> 4) * 8); };
    lane_offsets(tid);
    const size_t kstep = (size_t)(BK * 2);
    const size_t hstep = (size_t)HALF * K * 2;
    const size_t tstep = 2 * hstep;
    const unsigned ldsw = (unsigned)wid * 1024u;
#define PG8_SA(b, h) (((b) * 2 + (h)) * HTB)
#define PG8_SB(b, h) ((4 + (b) * 2 + (h)) * HTB)
#define PG8_STAGE(bufoff, gbase, voff) do { _Pragma("unroll") for (int _i = 0; _i < 2; ++_i) \
        __builtin_amdgcn_global_load_lds((const unsigned*)((const char*)(gbase) + (voff)[_i]), (PG8_LAS unsigned*)(lds + (bufoff) + ldsw + _i * 8192), 16, 0, 0); } while (0)
#define PG8_LDA(dst, b, h) do { _Pragma("unroll") for (int m = 0; m < 4; ++m) _Pragma("unroll") for (int k = 0; k < 2; ++k) dst[m][k] = *(const PG8_LAS bf16x8*)(lds + PG8_SA(b, h) + aoff + m * 2048 + k * 1024); } while (0)
#define PG8_LDB(dst, b, h) do { _Pragma("unroll") for (int n = 0; n < 2; ++n) _Pragma("unroll") for (int k = 0; k < 2; ++k) dst[n][k] = *(const PG8_LAS bf16x8*)(lds + PG8_SB(b, h) + boff + n * 2048 + k * 1024); } while (0)
#define PG8_MMA(ai, bj, At, Bt) do { __builtin_amdgcn_s_setprio(1); _Pragma("unroll") for (int m = 0; m < 4; ++m) _Pragma("unroll") for (int n = 0; n < 2; ++n) _Pragma("unroll") for (int k = 0; k < 2; ++k) \
        acc[ai][bj][m][n] = F16 ? __builtin_amdgcn_mfma_f32_16x16x32_f16(__builtin_bit_cast(f16x8, Bt[n][k]), __builtin_bit_cast(f16x8, At[m][k]), acc[ai][bj][m][n], 0, 0, 0) \
                                : __builtin_amdgcn_mfma_f32_16x16x32_bf16(Bt[n][k], At[m][k], acc[ai][bj][m][n], 0, 0, 0); __builtin_amdgcn_s_setprio(0); } while (0)
#define PG8_WAIT_V(n) asm volatile("s_waitcnt vmcnt(" #n ")" ::: "memory")
#define PG8_WAIT_L(n) asm volatile("s_waitcnt lgkmcnt(" #n ")" ::: "memory")
#define PG8_BAR __builtin_amdgcn_s_barrier()
#define PG8_SCHED __builtin_amdgcn_sched_barrier(0)
    Unit cur, nxt; int ui = 0;
    if (!S.next(0, cur)) return;
    f32x4 acc[2][2][4][2];
#pragma unroll
    for (int a = 0; a < 2; ++a)
#pragma unroll
        for (int b = 0; b < 2; ++b)
#pragma unroll
            for (int m = 0; m < 4; ++m)
#pragma unroll
                for (int n = 0; n < 2; ++n) acc[a][b][m][n] = (f32x4){0.f, 0.f, 0.f, 0.f};
    bf16x8 At[4][2], B0[2][2], B1[2][2];
    const char* cA = (const char*)g.A + (size_t)cur.pm * tstep; const char* cB = (const char*)g.Bt + (size_t)cur.pn * tstep;
    S.a_ready(cur);
    if constexpr (SP2) {
        PG8_STAGE(PG8_SB(0, 0), cB, voffB); PG8_STAGE(PG8_SB(0, 1), cB + hstep, voffB); PG8_STAGE(PG8_SA(0, 0), cA, voffA); PG8_STAGE(PG8_SA(0, 1), cA + hstep, voffA);
        if (wr == 1) PG8_BAR;
        PG8_WAIT_V(2); PG8_BAR;
        PG8_STAGE(PG8_SB(1, 0), cB + kstep, voffB); PG8_STAGE(PG8_SA(1, 0), cA + kstep, voffA); PG8_STAGE(PG8_SB(1, 1), cB + hstep + kstep, voffB);
        PG8_WAIT_V(6); PG8_BAR;
    } else {
        PG8_STAGE(PG8_SB(0, 0), cB, voffB); PG8_STAGE(PG8_SA(0, 0), cA, voffA); PG8_STAGE(PG8_SB(0, 1), cB + hstep, voffB); PG8_STAGE(PG8_SA(0, 1), cA + hstep, voffA);
        if (wr == 1) PG8_BAR;
        PG8_WAIT_V(4); PG8_BAR;
        PG8_STAGE(PG8_SB(1, 0), cB + kstep, voffB); PG8_STAGE(PG8_SA(1, 0), cA + kstep, voffA); PG8_STAGE(PG8_SB(1, 1), cB + hstep + kstep, voffB);
        PG8_WAIT_V(6); PG8_BAR;
    }
    for (;;) {
        const bool has_next = S.next(ui + 1, nxt);
        const char* nA = has_next ? (const char*)g.A + (size_t)nxt.pm * tstep : cA; const char* nB = has_next ? (const char*)g.Bt + (size_t)nxt.pn * tstep : cB;
        for (int t = 0; t < nt; t += 2) {
            const bool last = (t == nt - 2);
            const char* a1 = cA + (size_t)(t + 1) * kstep;
            const char* a2 = last ? nA : cA + (size_t)(t + 2) * kstep; const char* b2 = last ? nB : cB + (size_t)(t + 2) * kstep;
            const char* a3 = a2 + kstep; const char* b3 = b2 + kstep;
            if (last && has_next) S.a_ready(nxt);
            if constexpr (Epi::HOOK_T > 0) { if (t == Epi::HOOK_T) { int lh; asm volatile("v_mbcnt_lo_u32_b32 %0, -1, 0\n\tv_mbcnt_hi_u32_b32 %0, -1, %0" : "=v"(lh));
                E.mid(acc, cur, wr, wc, lh & 15, lh >> 4); } }
            if constexpr (SP2) {
            PG8_LDB(B0, 0, 0); PG8_LDB(B1, 0, 1); PG8_SCHED; PG8_LDA(At, 0, 0); PG8_STAGE(PG8_SA(1, 1), a1 + hstep, voffA);
            PG8_WAIT_V(8); PG8_WAIT_L(0); PG8_BAR; PG8_MMA(0, 0, At, B0); PG8_MMA(0, 1, At, B1); PG8_BAR; PG8_SCHED;
            PG8_LDA(At, 0, 1); PG8_STAGE(PG8_SB(0, 0), b2, voffB); PG8_STAGE(PG8_SB(0, 1), b2 + hstep, voffB); PG8_STAGE(PG8_SA(0, 0), a2, voffA);
            PG8_WAIT_V(8); PG8_WAIT_L(0); PG8_BAR; PG8_MMA(1, 0, At, B0); PG8_MMA(1, 1, At, B1); PG8_BAR; PG8_SCHED;
            PG8_LDB(B0, 1, 0); PG8_LDB(B1, 1, 1); PG8_SCHED; PG8_LDA(At, 1, 0); PG8_STAGE(PG8_SA(0, 1), a2 + hstep, voffA);
            PG8_WAIT_V(8); PG8_WAIT_L(0); PG8_BAR; PG8_MMA(0, 0, At, B0); PG8_MMA(0, 1, At, B1); PG8_BAR; PG8_SCHED;
            PG8_LDA(At, 1, 1); PG8_STAGE(PG8_SB(1, 0), b3, voffB); PG8_STAGE(PG8_SB(1, 1), b3 + hstep, voffB); PG8_STAGE(PG8_SA(1, 0), a3, voffA);
            PG8_WAIT_V(8); PG8_WAIT_L(0); PG8_BAR; PG8_MMA(1, 0, At, B0); PG8_MMA(1, 1, At, B1); PG8_BAR; PG8_SCHED;
            } else {
            PG8_LDB(B0, 0, 0); PG8_SCHED; PG8_LDA(At, 0, 0); PG8_STAGE(PG8_SA(1, 1), a1 + hstep, voffA);
            PG8_WAIT_L(8); PG8_BAR; PG8_WAIT_L(0); PG8_MMA(0, 0, At, B0); PG8_BAR; PG8_SCHED;
            PG8_LDB(B1, 0, 1); PG8_STAGE(PG8_SB(0, 0), b2, voffB);
            PG8_BAR; PG8_WAIT_L(0); PG8_MMA(0, 1, At, B1); PG8_BAR;
            PG8_LDA(At, 0, 1); PG8_STAGE(PG8_SA(0, 0), a2, voffA);
            PG8_BAR; PG8_WAIT_L(0); PG8_MMA(1, 0, At, B0); PG8_BAR; PG8_SCHED;
            PG8_STAGE(PG8_SB(0, 1), b2 + hstep, voffB);
            PG8_WAIT_V(6); PG8_BAR; PG8_MMA(1, 1, At, B1); PG8_BAR;
            PG8_LDB(B0, 1, 0); PG8_SCHED; PG8_LDA(At, 1, 0); PG8_STAGE(PG8_SA(0, 1), a2 + hstep, voffA);
            PG8_WAIT_L(8); PG8_BAR; PG8_WAIT_L(0); PG8_MMA(0, 0, At, B0); PG8_BAR; PG8_SCHED;
            PG8_LDB(B1, 1, 1); PG8_STAGE(PG8_SB(1, 0), b3, voffB);
            PG8_BAR; PG8_WAIT_L(0); PG8_MMA(0, 1, At, B1); PG8_BAR;
            PG8_LDA(At, 1, 1); PG8_STAGE(PG8_SA(1, 0), a3, voffA);
            PG8_BAR; PG8_WAIT_L(0); PG8_MMA(1, 0, At, B0); PG8_BAR; PG8_SCHED;
            PG8_STAGE(PG8_SB(1, 1), b3 + hstep, voffB);
            PG8_WAIT_V(6); PG8_BAR; PG8_MMA(1, 1, At, B1); PG8_BAR;
            }
        }
        if constexpr (ALIGN_EPI) { if (wr == 0) PG8_BAR; }
        if constexpr (!Epi::AFTER_DRAIN) { int le; asm volatile("v_mbcnt_lo_u32_b32 %0, -1, 0\n\tv_mbcnt_hi_u32_b32 %0, -1, %0" : "=v"(le));
            E(acc, cur, wr, wc, le & 15, le >> 4); S.done(cur); }
        if (!has_next) break;
#pragma unroll
        for (int a = 0; a < 2; ++a)
#pragma unroll
            for (int b = 0; b < 2; ++b)
#pragma unroll
                for (int m = 0; m < 4; ++m)
#pragma unroll
                    for (int n = 0; n < 2; ++n) acc[a][b][m][n] = (f32x4){0.f, 0.f, 0.f, 0.f};
        cur = nxt; cA = nA; cB = nB; ++ui;
        { int l2; asm volatile("v_mbcnt_lo_u32_b32 %0, -1, 0\n\tv_mbcnt_hi_u32_b32 %0, -1, %0" : "=v"(l2)); lane_offsets(wid * 64 + l2); }
        if constexpr (ALIGN_EPI) { if (wr == 1) PG8_BAR; }
    }
    PG8_WAIT_V(0);
    if constexpr (!ALIGN_EPI) { if (wr == 0) PG8_BAR; }
    PG8_BAR;
    if constexpr (Epi::AFTER_DRAIN) { E.fused(acc, cur, wr, wc, fr, fq, lds, wid, lane); S.done(cur); }
#undef PG8_SA
#undef PG8_SB
#undef PG8_STAGE
#undef PG8_LDA
#undef PG8_LDB
#undef PG8_MMA
#undef PG8_WAIT_V
#undef PG8_WAIT_L
#undef PG8_BAR
#undef PG8_SCHED
}
}

template <class TEpi>
__device__ __forceinline__ void gemm_tail(LAS unsigned char* lds, const bf16* A  , const bf16* Bt  , int N, int K, int R0, const TEpi& E, int G, int bid) {
    int tid_ = threadIdx.x; asm volatile("" : "+v"(tid_));
    const int tid = tid_, wave = __builtin_amdgcn_readfirstlane(tid >> 6), lane = tid & 63, fr = lane & 15, fq = lane >> 4, kw = K >> 3;
    LAS float* red = (LAS float*)lds;
    for (int nt = bid; nt < (N >> 4); nt += G) {
        f32x4 acc[4];
#pragma unroll
        for (int mt = 0; mt < 4; ++mt) acc[mt] = (f32x4){0.f, 0.f, 0.f, 0.f};
        const bf16* ap = A + (size_t)fr * K + wave * kw + fq * 8;
        const bf16* bp = Bt + (size_t)(nt * 16 + fr) * K + wave * kw + fq * 8;
#pragma unroll 4
        for (int k = 0; k < kw; k += 32) {
            const bf16x8 b = *(const bf16x8*)(bp + k);
#pragma unroll
            for (int mt = 0; mt < 4; ++mt) { const bf16x8 a = *(const bf16x8*)(ap + (size_t)(mt * 16) * K + k); acc[mt] = __builtin_amdgcn_mfma_f32_16x16x32_bf16(a, b, acc[mt], 0, 0, 0); }
        }
#pragma unroll
        for (int mt = 0; mt < 4; ++mt)
#pragma unroll
            for (int i = 0; i < 4; ++i) red[(wave * 64 + mt * 16 + fq * 4 + i) * 17 + fr] = acc[mt][i];
        __syncthreads();
        { const int m = tid >> 3, n2 = (tid & 7) * 2; float s0 = 0.f, s1 = 0.f;
#pragma unroll
          for (int w = 0; w < 8; ++w) { s0 += red[(w * 64 + m) * 17 + n2]; s1 += red[(w * 64 + m) * 17 + n2 + 1]; }
          E.tail(R0 + m, nt * 16 + n2, s0, s1); }
        __syncthreads();
    }
}

template <class TEpi>
__device__ __forceinline__ void gemm_tail2(LAS unsigned char* lds, const bf16* A  , const bf16* Bt  , int N, int K, int K1, int R0, const TEpi& E, int G, int bid) {
    int tid_ = threadIdx.x; asm volatile("" : "+v"(tid_));
    const int tid = tid_, wave = __builtin_amdgcn_readfirstlane(tid >> 6), lane = tid & 63, fr = lane & 15, fq = lane >> 4;
    LAS float* red = (LAS float*)lds;
    for (int nt = bid; nt < (N >> 4); nt += G) {
        float sv[2][2];
#pragma unroll
        for (int seg = 0; seg < 2; ++seg) {
            const int kb = seg ? K1 : 0, kw = (seg ? K - K1 : K1) >> 3;
            f32x4 acc[4];
#pragma unroll
            for (int mt = 0; mt < 4; ++mt) acc[mt] = (f32x4){0.f, 0.f, 0.f, 0.f};
            const bf16* ap = A + (size_t)fr * K + kb + wave * kw + fq * 8;
            const bf16* bp = Bt + (size_t)(nt * 16 + fr) * K + kb + wave * kw + fq * 8;
#pragma unroll 4
            for (int k = 0; k < kw; k += 32) {
                const bf16x8 b = *(const bf16x8*)(bp + k);
#pragma unroll
                for (int mt = 0; mt < 4; ++mt) { const bf16x8 a = *(const bf16x8*)(ap + (size_t)(mt * 16) * K + k); acc[mt] = __builtin_amdgcn_mfma_f32_16x16x32_bf16(a, b, acc[mt], 0, 0, 0); }
            }
#pragma unroll
            for (int mt = 0; mt < 4; ++mt)
#pragma unroll
                for (int i = 0; i < 4; ++i) red[(wave * 64 + mt * 16 + fq * 4 + i) * 17 + fr] = acc[mt][i];
            __syncthreads();
            { const int m = tid >> 3, n2 = (tid & 7) * 2; float s0 = 0.f, s1 = 0.f;
#pragma unroll
              for (int w = 0; w < 8; ++w) { s0 += red[(w * 64 + m) * 17 + n2]; s1 += red[(w * 64 + m) * 17 + n2 + 1]; }
              sv[seg][0] = s0; sv[seg][1] = s1; }
            __syncthreads();
        }
        E.tail(R0 + (tid >> 3), nt * 16 + (tid & 7) * 2, sv[0][0], sv[0][1], sv[1][0], sv[1][1]);
    }
}

template <int NS, class TEpi>
__device__ __forceinline__ void gemm_tailn(LAS unsigned char* lds, const bf16* A, const bf16* Bt, int N, int K, int R0, const TEpi& E, int G, int bid) {
    int tid_ = threadIdx.x; asm volatile("" : "+v"(tid_));
    const int tid = tid_, wave = __builtin_amdgcn_readfirstlane(tid >> 6), lane = tid & 63, fr = lane & 15, fq = lane >> 4, kw = K >> 3;
    constexpr int PITCH = NS * 16 + 1;
    LAS float* red = (LAS float*)lds;
    const int nsl = N >> 4, nitems = (nsl + NS - 1) / NS;
    for (int it = bid; it < nitems; it += G) {
        f32x4 acc[NS][4];
#pragma unroll
        for (int s = 0; s < NS; ++s)
#pragma unroll
            for (int mt = 0; mt < 4; ++mt) acc[s][mt] = (f32x4){0.f, 0.f, 0.f, 0.f};
        const bf16* ap = A + (size_t)fr * K + wave * kw + fq * 8;
        const bf16* bp[NS];
#pragma unroll
        for (int s = 0; s < NS; ++s) { int sl = it * NS + s; sl = sl < nsl ? sl : nsl - 1; bp[s] = Bt + (size_t)(sl * 16 + fr) * K + wave * kw + fq * 8; }
#pragma unroll 2
        for (int k = 0; k < kw; k += 32) {
            bf16x8 a[4];
#pragma unroll
            for (int mt = 0; mt < 4; ++mt) a[mt] = *(const bf16x8*)(ap + (size_t)(mt * 16) * K + k);
#pragma unroll
            for (int s = 0; s < NS; ++s) { const bf16x8 b = *(const bf16x8*)(bp[s] + k);
#pragma unroll
                for (int mt = 0; mt < 4; ++mt) acc[s][mt] = __builtin_amdgcn_mfma_f32_16x16x32_bf16(a[mt], b, acc[s][mt], 0, 0, 0); }
        }
#pragma unroll
        for (int s = 0; s < NS; ++s)
#pragma unroll
            for (int mt = 0; mt < 4; ++mt)
#pragma unroll
                for (int i = 0; i < 4; ++i) red[(wave * 64 + mt * 16 + fq * 4 + i) * PITCH + s * 16 + fr] = acc[s][mt][i];
        __syncthreads();
        { const int m = tid >> 3, c2 = (tid & 7) * 2;
#pragma unroll
          for (int s = 0; s < NS; ++s) { float s0 = 0.f, s1 = 0.f;
#pragma unroll
              for (int w = 0; w < 8; ++w) { s0 += red[(w * 64 + m) * PITCH + s * 16 + c2]; s1 += red[(w * 64 + m) * PITCH + s * 16 + c2 + 1]; }
              const int sl = it * NS + s; if (sl < nsl) E.tail(R0 + m, sl * 16 + c2, s0, s1); } }
        __syncthreads();
    }
}

namespace att {
#ifndef ATT_SDEPTH
#define ATT_SDEPTH 1
#endif
constexpr int D = 128, NW = 8, QBLK = 32, KVBLK = 64;
constexpr float SCALE = 0.088388347648318440f;
constexpr float THR = 8.f;
__device__ constexpr float ROTF[32] = {1.000000000e+00f, 7.498942093e-01f, 5.623413252e-01f, 4.216965034e-01f, 3.162277660e-01f, 2.371373706e-01f, 1.778279410e-01f, 1.333521432e-01f, 1.000000000e-01f, 7.498942093e-02f, 5.623413252e-02f, 4.216965034e-02f, 3.162277660e-02f, 2.371373706e-02f, 1.778279410e-02f, 1.333521432e-02f, 1.000000000e-02f, 7.498942093e-03f, 5.623413252e-03f, 4.216965034e-03f, 3.162277660e-03f, 2.371373706e-03f, 1.778279410e-03f, 1.333521432e-03f, 1.000000000e-03f, 7.498942093e-04f, 5.623413252e-04f, 4.216965034e-04f, 3.162277660e-04f, 2.371373706e-04f, 1.778279410e-04f, 1.333521432e-04f};
constexpr int LDQ = NIN, LDK = HD, LDV = NIN, LDO = DYC;
constexpr int KPITCH = D * 2 + 16;
constexpr size_t SHM_V = KVBLK * D * 2, SHM_K = KVBLK * KPITCH, SHM_ATTN = 2 * SHM_V + 2 * SHM_K + NW * 64 * 4;
using s16x4  = __attribute__((ext_vector_type(4))) short;
using f32x16 = __attribute__((ext_vector_type(16))) float;
#define KSWZ(row, colB) ((row) * KPITCH + (colB))
#define SBAR() __builtin_amdgcn_sched_barrier(0)
__device__ __forceinline__ int crow(int r, int hi) { return (r & 3) + 8 * (r >> 2) + 4 * hi; }
__device__ __forceinline__ unsigned cvtpk(float lo, float hi) { unsigned r; asm volatile("v_cvt_pk_bf16_f32 %0, %1, %2" : "=v"(r) : "v"(lo), "v"(hi)); return r; }

__device__ __forceinline__ void partialSM(f32x16& p0, f32x16& p1, float& m_reg, float& mn, float& alpha) {
  constexpr float C = SCALE * 1.4426950408889634f;
  float pmax = p0[0]; for (int r = 1; r < 16; ++r) pmax = fmaxf(pmax, p0[r]); for (int r = 0; r < 16; ++r) pmax = fmaxf(pmax, p1[r]);
  { auto rr = __builtin_amdgcn_permlane32_swap(__float_as_uint(pmax), __float_as_uint(pmax), false, false);
    pmax = fmaxf(__uint_as_float(rr[0]), __uint_as_float(rr[1])); }
  if (__builtin_expect(__all(pmax - m_reg <= THR / SCALE), 1)) { mn = m_reg; alpha = 1.f; }
  else { mn = fmaxf(m_reg, pmax); alpha = __builtin_amdgcn_exp2f((m_reg - mn) * C); m_reg = mn; }
  float mnC = -mn * C;
  for (int r = 0; r < 16; ++r) p0[r] = fmaf(p0[r], C, mnC); for (int r = 0; r < 16; ++r) p1[r] = fmaf(p1[r], C, mnC);
}
__device__ __forceinline__ void expP0(f32x16& p0) { for (int r = 0; r < 16; ++r) { float e = __builtin_amdgcn_exp2f(p0[r]); asm volatile("" : "+v"(e)); p0[r] = e; } }
__device__ __forceinline__ void finishSM(f32x16& p0, f32x16& p1, float alpha, float& l_reg, bf16x8& pa0, bf16x8& pa1, bf16x8& pa2, bf16x8& pa3) {
  for (int r = 0; r < 16; ++r) p1[r] = __builtin_amdgcn_exp2f(p1[r]);
  float ps = 0; for (int r = 0; r < 16; ++r) ps += p0[r]; for (int r = 0; r < 16; ++r) ps += p1[r];
  { auto rr = __builtin_amdgcn_permlane32_swap(__float_as_uint(ps), __float_as_uint(ps), false, false);
    ps = __uint_as_float(rr[0]) + __uint_as_float(rr[1]); }
  l_reg = l_reg * alpha + ps;
#define PK4(P, BASE, OUT) do { unsigned a0 = cvtpk(P[BASE + 0], P[BASE + 1]), a1 = cvtpk(P[BASE + 2], P[BASE + 3]);   \
    unsigned b0 = cvtpk(P[BASE + 4], P[BASE + 5]), b1 = cvtpk(P[BASE + 6], P[BASE + 7]);                              \
    auto r0 = __builtin_amdgcn_permlane32_swap(a0, b0, false, false); auto r1 = __builtin_amdgcn_permlane32_swap(a1, b1, false, false); \
    v4u w = {r0[0], r1[0], r0[1], r1[1]}; OUT = *reinterpret_cast<bf16x8*>(&w); } while (0)
  PK4(p0, 0, pa0); PK4(p0, 8, pa1); PK4(p1, 0, pa2); PK4(p1, 8, pa3);
#undef PK4
}
template <int BUF> __device__ __forceinline__ void qkt(f32x16& p0, f32x16& p1, const char* kp, const bf16x8* qr) {
  const char* k0 = kp + BUF * (int)SHM_K; const char* k1 = k0 + 32 * KPITCH;
  bf16x8 b0[8], b1[8];
#pragma unroll
  for (int d0 = 0; d0 < 8; ++d0) { b0[d0] = *reinterpret_cast<const bf16x8*>(k0 + d0 * 32); b1[d0] = *reinterpret_cast<const bf16x8*>(k1 + d0 * 32); }
  p0 = f32x16{}; p1 = f32x16{};
#pragma unroll
  for (int d0 = 0; d0 < 8; ++d0) { p0 = __builtin_amdgcn_mfma_f32_32x32x16_bf16(b0[d0], qr[d0], p0, 0, 0, 0); p1 = __builtin_amdgcn_mfma_f32_32x32x16_bf16(b1[d0], qr[d0], p1, 0, 0, 0); }
}
template <int NE> __device__ __forceinline__ void qkt_order() {
  __builtin_amdgcn_sched_group_barrier(0x100, 4, 0);
  if (NE) __builtin_amdgcn_sched_group_barrier(0x400, NE, 0);
#pragma unroll
  for (int d0 = 0; d0 < 6; ++d0) { __builtin_amdgcn_sched_group_barrier(0x100, 2, 0); __builtin_amdgcn_sched_group_barrier(0x008, 2, 0); }
  __builtin_amdgcn_sched_group_barrier(0x008, 4, 0);
}
__device__ __forceinline__ void kmask(f32x16& p0, f32x16& p1, int kbase, int nvalid, int hi) {
#pragma unroll
  for (int r = 0; r < 16; ++r) { const int k = kbase + crow(r, hi); if (k >= nvalid) p0[r] = -1e30f; if (k + 32 >= nvalid) p1[r] = -1e30f; }
}
__device__ __forceinline__ int v_st(int k, int c) { const int kk = (k & ~0xC) | ((k & 4) << 1) | ((k & 8) >> 1); return ((kk >> 3) * 4 + (c >> 5)) * 512 + ((kk & 7) * 32 + (c & 31)) * 2; }
__device__ __forceinline__ int v_rd_base(int lane) { return ((lane & 3) << 3) | (((lane >> 2) & 3) << 6) | (((lane >> 4) & 1) << 5) | (((lane >> 5) & 1) << 8); }
constexpr int v_rd_off(int d0, int ks, int half) { return d0 * 512 + ks * 4096 + half * 2048; }
template <int OFF> __device__ __forceinline__ s16x4 tr_read(int vb) {
  s16x4 r; asm volatile("ds_read_b64_tr_b16 %0, %1 offset:%2" : "=&v"(r) : "v"(vb), "i"(OFF) : "memory"); return r;
}
template <int D0> __device__ __forceinline__ void pv_one(f32x16& od, int vb, bf16x8 pa0, bf16x8 pa1, bf16x8 pa2, bf16x8 pa3) {
  const s16x4 l0 = tr_read<v_rd_off(D0, 0, 0)>(vb), h0 = tr_read<v_rd_off(D0, 0, 1)>(vb), l1 = tr_read<v_rd_off(D0, 1, 0)>(vb), h1 = tr_read<v_rd_off(D0, 1, 1)>(vb);
  const s16x4 l2 = tr_read<v_rd_off(D0, 2, 0)>(vb), h2 = tr_read<v_rd_off(D0, 2, 1)>(vb), l3 = tr_read<v_rd_off(D0, 3, 0)>(vb), h3 = tr_read<v_rd_off(D0, 3, 1)>(vb);
  asm volatile("s_waitcnt lgkmcnt(0)" ::: "memory"); SBAR();
#define PK(L, H) (bf16x8){L[0], L[1], L[2], L[3], H[0], H[1], H[2], H[3]}
  od = __builtin_amdgcn_mfma_f32_32x32x16_bf16(pa0, PK(l0, h0), od, 0, 0, 0);
  od = __builtin_amdgcn_mfma_f32_32x32x16_bf16(pa1, PK(l1, h1), od, 0, 0, 0);
  od = __builtin_amdgcn_mfma_f32_32x32x16_bf16(pa2, PK(l2, h2), od, 0, 0, 0);
  od = __builtin_amdgcn_mfma_f32_32x32x16_bf16(pa3, PK(l3, h3), od, 0, 0, 0);
#undef PK
}
__device__ __forceinline__ void pv_d0(f32x16* o, int vb, bf16x8 pa0, bf16x8 pa1, bf16x8 pa2, bf16x8 pa3) {
  pv_one<0>(o[0], vb, pa0, pa1, pa2, pa3); pv_one<1>(o[1], vb, pa0, pa1, pa2, pa3); pv_one<2>(o[2], vb, pa0, pa1, pa2, pa3); pv_one<3>(o[3], vb, pa0, pa1, pa2, pa3);
}

__device__ __forceinline__ void attn_unit(const bf16* __restrict__ Qb, int qvalid, int packed, const bf16* __restrict__ Kh, const bf16* __restrict__ Vh,
                                          bf16* __restrict__ Ob, int nvalid, int NT, char* lds, unsigned* qctr, unsigned& nxt  , const float* __restrict__ qg  , int tq0  ) {
  int tid_ = threadIdx.x; asm volatile("" : "+v"(tid_));
  const int tid = tid_, wid = tid >> 6, lane = tid & 63, r32 = lane & 31, hi = lane >> 5;
  bf16* V_lds = (bf16*)lds; bf16* K_lds = (bf16*)(lds + 2 * SHM_V);
  float* ws = (float*)(lds + 2 * SHM_V + 2 * SHM_K) + wid * 64; float* li_l = ws; float* al_l = ws + 32;
  float m_reg = -1e30f, l_reg = 0; f32x16 o[4] = {}; bf16x8 qr[8];
  { int qrow = wid * QBLK + r32; qrow = qrow < qvalid ? qrow : qvalid - 1;
    const bf16* Qw = Qb + (packed ? (long)(qrow & 15) * LDQ + (qrow >> 4) * HD : (long)qrow * LDQ) + hi * 8;
#pragma unroll
    for (int d0 = 0; d0 < 8; ++d0) qr[d0] = *reinterpret_cast<const bf16x8*>(Qw + d0 * 16);
    float qf[8][8]; float ss = 0.f;
#pragma unroll
    for (int d0 = 0; d0 < 8; ++d0)
#pragma unroll
        for (int e = 0; e < 8; ++e) { qf[d0][e] = __builtin_bit_cast(float, (unsigned)(unsigned short)qr[d0][e] << 16); ss += qf[d0][e] * qf[d0][e]; }
    ss = ::xadd32(ss);
    const float rstd = __builtin_amdgcn_rsqf(ss * (1.0f / HD) + QK_EPS);
#pragma unroll
    for (int d0 = 0; d0 < 8; ++d0) { const f32x4 g0 = *(const f32x4*)(qg + d0 * 16 + hi * 8), g1 = *(const f32x4*)(qg + d0 * 16 + hi * 8 + 4);
#pragma unroll
        for (int e = 0; e < 4; ++e) { qf[d0][e] *= rstd * g0[e]; qf[d0][4 + e] *= rstd * g1[e]; } }
    const int tq = tq0 + (packed ? (qrow & 15) : qrow);
    float rowp, colp; if (tq < NMETA) { rowp = -1.0f; colp = (float)tq; } else { const int jj = tq - NMETA; rowp = (float)(jj >> 6); colp = (float)(jj & 63); }
    const float hsc = hi ? 0.1f * 0.15915494309189535f : 0.15915494309189535f;
#pragma unroll
    for (int sg = 0; sg < 2; ++sg) { const float ph = (sg ? colp : rowp) * hsc;
#pragma unroll
        for (int dd = 0; dd < 2; ++dd)
#pragma unroll
            for (int e = 0; e < 8; ++e) { const float ang = ph * ROTF[16 * dd + e];
                const float sn = __builtin_amdgcn_sinf(ang), cs = __builtin_amdgcn_cosf(ang), a = qf[4 * sg + dd][e], b = qf[4 * sg + dd + 2][e];
                qf[4 * sg + dd][e] = a * cs - b * sn; qf[4 * sg + dd + 2][e] = b * cs + a * sn; } }
#pragma unroll
    for (int d0 = 0; d0 < 8; ++d0) { v4u w; w.x = ::pk2(qf[d0][0], qf[d0][1]); w.y = ::pk2(qf[d0][2], qf[d0][3]); w.z = ::pk2(qf[d0][4], qf[d0][5]); w.w = ::pk2(qf[d0][6], qf[d0][7]);
        qr[d0] = __builtin_bit_cast(bf16x8, w); } }
  const int sr = tid >> 4, sc = (tid & 15) * 8, vst0 = v_st(sr, sc), vst1 = v_st(32 + sr, sc);
  const int vb0 = (int)(uintptr_t)V_lds + v_rd_base(lane);
  constexpr int SDEPTH = ATT_SDEPTH;
  struct { bf16x8 vs0, vs1, ks0, ks1; } sr_[SDEPTH];
  const unsigned goff0 = (unsigned)(sr * LDK + sc) * 2u, goff1 = goff0 + 32u * LDK * 2u;
  const unsigned gofv0 = (unsigned)(sr * LDV + sc) * 2u, gofv1 = gofv0 + 32u * LDV * 2u;
#define SLOAD(i, k0) do { const char* vbp = (const char*)Vh + (size_t)(k0) * (LDV * 2); const char* kbp = (const char*)Kh + (size_t)(k0) * (LDK * 2); \
    sr_[i].vs0 = *reinterpret_cast<const bf16x8*>(vbp + gofv0); sr_[i].vs1 = *reinterpret_cast<const bf16x8*>(vbp + gofv1); \
    sr_[i].ks0 = *reinterpret_cast<const bf16x8*>(kbp + goff0); sr_[i].ks1 = *reinterpret_cast<const bf16x8*>(kbp + goff1); } while (0)
#define SWRITE(b, i) do { *(bf16x8*)((char*)V_lds + (b) * SHM_V + vst0) = sr_[i].vs0;          \
    *(bf16x8*)((char*)V_lds + (b) * SHM_V + vst1) = sr_[i].vs1; int kc = sc * 2;               \
    *(bf16x8*)((char*)K_lds + (b) * SHM_K + KSWZ(sr, kc)) = sr_[i].ks0;                       \
    *(bf16x8*)((char*)K_lds + (b) * SHM_K + KSWZ(32 + sr, kc)) = sr_[i].ks1; } while (0)
#define SWAIT() do { if constexpr (SDEPTH == 2) asm volatile("s_waitcnt vmcnt(4)" ::: "memory"); else asm volatile("s_waitcnt vmcnt(0)" ::: "memory"); } while (0)
#define RESC(a) do { if (__any((a) < 1.f)) { if (hi == 0) al_l[r32] = (a); asm volatile("s_waitcnt lgkmcnt(0)" ::: "memory"); \
    for (int d = 0; d < 4; ++d) for (int r = 0; r < 16; ++r) o[d][r] *= al_l[crow(r, hi)]; } } while (0)
  f32x16 pA0, pA1, pB0, pB1; float mnA, mnB, alA, alB; bf16x8 pa0, pa1, pa2, pa3;
  constexpr int SE = 0, SO = SDEPTH - 1;
  SLOAD(SE, 0); asm volatile("s_waitcnt vmcnt(0)" ::: "memory"); SWRITE(0, SE); __syncthreads();
  const char* kb0 = (const char*)K_lds + r32 * KPITCH + hi * 16;
  qkt<0>(pA0, pA1, kb0, qr); qkt_order<0>(); SBAR(); partialSM(pA0, pA1, m_reg, mnA, alA);
  SLOAD(SO, KVBLK); if constexpr (SDEPTH == 2) { if (2 < NT) SLOAD(SE, 2 * KVBLK); }
  SWAIT(); SWRITE(1, SO); __syncthreads();
  for (int j = 1; j + 1 < NT; j += 2) {
    SBAR(); qkt<1>(pB0, pB1, kb0, qr); expP0(pA0); qkt_order<16>(); SBAR();
    if (__builtin_expect((j + 1) * KVBLK > nvalid, 0)) kmask(pB0, pB1, j * KVBLK, nvalid, hi);
    finishSM(pA0, pA1, alA, l_reg, pa0, pa1, pa2, pa3); SBAR();
    SLOAD(SO, (j + SDEPTH) * KVBLK); SBAR();
    pv_d0(o, vb0, pa0, pa1, pa2, pa3); partialSM(pB0, pB1, m_reg, mnB, alB);
    __syncthreads(); SWAIT(); SWRITE(0, SE);
    RESC(alB); __syncthreads();
    SBAR(); qkt<0>(pA0, pA1, kb0, qr); expP0(pB0); qkt_order<16>(); SBAR();
    if (__builtin_expect((j + 2) * KVBLK > nvalid, 0)) kmask(pA0, pA1, (j + 1) * KVBLK, nvalid, hi);
    finishSM(pB0, pB1, alB, l_reg, pa0, pa1, pa2, pa3); SBAR();
    if (SDEPTH == 1 || j + 3 < NT) SLOAD(SE, (j + 1 + SDEPTH) * KVBLK); SBAR();
    pv_d0(o, vb0 + (int)SHM_V, pa0, pa1, pa2, pa3); partialSM(pA0, pA1, m_reg, mnA, alA);
    __syncthreads(); SWAIT(); SWRITE(1, SO);
    RESC(alA); __syncthreads();
  }
  nxt = ::mix_issue(qctr);
  expP0(pA0); finishSM(pA0, pA1, alA, l_reg, pa0, pa1, pa2, pa3); SBAR();
  pv_d0(o, vb0, pa0, pa1, pa2, pa3);
  if (hi == 0) li_l[r32] = l_reg; asm volatile("s_waitcnt lgkmcnt(0)" ::: "memory");
  const int rbase = wid * QBLK; const bool odd = (lane & 1);
#pragma unroll
  for (int r = 0; r < 16; r += 2) {
    const int rowA = crow(r, hi), rowB = crow(r + 1, hi);
    const float ia = __builtin_amdgcn_rcpf(li_l[rowA]), ib = __builtin_amdgcn_rcpf(li_l[rowB]);
    const int myrow = odd ? rowB : rowA;
#pragma unroll
    for (int d0 = 0; d0 < 4; ++d0) {
      const float va = o[d0][r] * ia, vb = o[d0][r + 1] * ib;
      const float send = odd ? va : vb, got = ::xshfl<1>(send);
      const unsigned w = odd ? cvtpk(got, vb) : cvtpk(va, got);
      const int orow = rbase + myrow;
      if (orow < qvalid) *(unsigned*)(Ob + (packed ? (long)(orow & 15) * LDO + (orow >> 4) * HD : (long)orow * LDO) + d0 * 32 + (r32 & ~1)) = w;
    }
  }
#undef SLOAD
#undef SWRITE
#undef SWAIT
#undef RESC
}
#undef KSWZ
#undef SBAR
}

struct FiltArgs { const zt_t* tf; const zt_t* tb; const float* skip; };
template <int N, int RL>
__device__ __forceinline__ void conv_unit(bool dostore, int skip  , char* ldsg, const FiltArgs fa, int c, int L, zt_t* z0p, zt_t* z1p  , unsigned* qctr, unsigned& nxt  ) {
    constexpr int NT = 512, PER = N / NT;
    int tid_ = threadIdx.x; asm volatile("" : "+v"(tid_));
    const int tid = tid_;
    cf* buf = (cf*)ldsg;
    float* side = (float*)(ldsg + LDS_SIDE);
    float* exf = side + 128;
    float* exb = side + 160;
    float* zh0 = side + 192, *zh1 = side + 224, *zt0 = side + 256, *zt1 = side + 288;
    float* red = side + 320;
    const int lo = N - L + 1;
    constexpr int LC = (N == 16384) ? LP : LS, PZ = (LC + NT - 1) / NT, PT = (LC / 4 + NT - 1) / NT;
    float zr0[PZ], zr1[PZ];
    { int t0 = tid; asm volatile("" : "+v"(t0));
#pragma unroll
    for (int i = 0; i < PZ; ++i) { const int t = t0 + i * NT; const bool ok = ((i + 1) * NT <= LC) || t < L; zr0[i] = ok ? (float)z0p[t] : 0.f; zr1[i] = ok ? (float)z1p[t] : 0.f; } }
    const float delta = 3.0701134573253945f + (float)c * (12.280453829301578f / 1023.0f);
    const float tinv = 1.0f / (float)(L - 1);
    float asum = 0.f;
    if (!(skip & 1)) for (int q = tid; q < (L >> 2); q += NT) {
        typedef _Float16 h4 __attribute__((ext_vector_type(4)));
        const h4 sfh = *(const h4*)(fa.tf + 4 * q), sbh = *(const h4*)(fa.tb + 4 * q);
        const f32x4 sf4 = {(float)sfh[0], (float)sfh[1], (float)sfh[2], (float)sfh[3]}, sb4 = {(float)sbh[0], (float)sbh[1], (float)sbh[2], (float)sbh[3]};
#pragma unroll
        for (int i = 0; i < 4; ++i) {
            const int k = 4 * q + i;
            const float dec = __expf(-(float)k * tinv * delta);
            const float sf = sf4[i] * dec, sb = sb4[i] * dec;
            asum += fabsf(sf) + (k >= 1 ? fabsf(sb) : 0.f);
            if (k < lo) { cf v; v.x = sf; v.y = 0.f; buf[fphys(k)] = v; if (k >= 1) { cf w; w.x = sb; w.y = 0.f; buf[fphys(N - k)] = w; } }
            else { float zz = 0.f; asm volatile("" : "+v"(zz)); cf v; v.x = zz; v.y = zz; buf[fphys(k)] = v; exf[k - lo] = sf; exb[k - lo] = sb; }
        }
    }
    asum = wave_sum(asum);
    if ((tid & 63) == 0) red[tid >> 6] = asum;
    __syncthreads();
    float norm = __builtin_amdgcn_rcpf(((red[0] + red[1]) + (red[2] + red[3])) + ((red[4] + red[5]) + (red[6] + red[7])));
    asm volatile("" : "+v"(norm));
    cf Hreg[PER / RL][RL];
    {
        if (!(skip & 2)) {
        { using FP = FPass<N, 16, NT, 1>; cf u[FP::B][16]; FP::load(buf, tid, u); __syncthreads(); FP::compute(tid, u); FP::store(buf, tid, u); __syncthreads(); }
        { using FP = FPass<N, 16, NT, 16>; cf u[FP::B][16]; FP::load(buf, tid, u); __syncthreads(); FP::compute(tid, u); FP::store(buf, tid, u); __syncthreads(); }
        { using FP = FPass<N, 16, NT, 256>; cf u[FP::B][16]; FP::load(buf, tid, u); __syncthreads(); FP::compute(tid, u); FP::store(buf, tid, u); __syncthreads(); }
        }
        FPass<N, RL, NT, 4096>::load(buf, tid, Hreg); __syncthreads(); FPass<N, RL, NT, 4096>::compute(tid, Hreg);
    }
#pragma unroll
    for (int i = 0; i < PZ; ++i) { const int t = tid + i * NT; cf v; v.x = zr0[i]; v.y = zr1[i];
        if (i == 0) { if (t <= 30) { zh0[t] = v.x; zh1[t] = v.y; } }
        if ((i + 1) * NT > N - LC + 1) { if (t >= lo && t < L) { zt0[t - lo] = v.x; zt1[t - lo] = v.y; } }
        buf[fphys(t)] = v; }
    for (int t = tid + PZ * NT; t < N; t += NT) { float zz = 0.f; asm volatile("" : "+v"(zz)); cf v; v.x = zz; v.y = zz; buf[fphys(t)] = v; }
    __syncthreads();
    if (!(skip & 4)) {
        { using FP = FPass<N, 16, NT, 1>; cf u[FP::B][16]; FP::load(buf, tid, u); __syncthreads(); FP::compute(tid, u); FP::store(buf, tid, u); __syncthreads(); }
        { using FP = FPass<N, 16, NT, 16>; cf u[FP::B][16]; FP::load(buf, tid, u); __syncthreads(); FP::compute(tid, u); FP::store(buf, tid, u); __syncthreads(); }
        { using FP = FPass<N, 16, NT, 256>; cf u[FP::B][16]; FP::load(buf, tid, u); __syncthreads(); FP::compute(tid, u); FP::store(buf, tid, u); __syncthreads(); }
        { cf u[PER / RL][RL]; FPass<N, RL, NT, 4096>::load(buf, tid, u); __syncthreads(); FPass<N, RL, NT, 4096>::compute(tid, u);
#pragma unroll
          for (int b = 0; b < PER / RL; ++b)
#pragma unroll
              for (int r = 0; r < RL; ++r) { cf w = cmul(u[b][r], Hreg[b][r]); w.y = -w.y; u[b][r] = w; }
          FPass<N, RL, NT, 4096>::store(buf, tid, u); __syncthreads(); }
    }
    if (dostore) nxt = mix_issue(qctr);
    if (!(skip & 4)) {
        { using FP = FPass<N, 16, NT, 1>; cf u[FP::B][16]; FP::load(buf, tid, u); __syncthreads(); FP::compute(tid, u); FP::store(buf, tid, u); __syncthreads(); }
        { using FP = FPass<N, 16, NT, 16>; cf u[FP::B][16]; FP::load(buf, tid, u); __syncthreads(); FP::compute(tid, u); FP::store(buf, tid, u); __syncthreads(); }
        { using FP = FPass<N, 16, NT, 256>; cf u[FP::B][16]; FP::load(buf, tid, u); __syncthreads(); FP::compute(tid, u); FP::store(buf, tid, u); __syncthreads(); }
        { cf u[PER / RL][RL]; FPass<N, RL, NT, 4096>::load(buf, tid, u); __syncthreads(); FPass<N, RL, NT, 4096>::compute(tid, u); FPass<N, RL, NT, 4096>::store(buf, tid, u); __syncthreads(); }
    }
    const float sk = fa.skip[c], sc = norm * (1.0f / (float)N);
    if (!(skip & 8)) {
        float y0[PZ], y1[PZ];
        int tf = tid; asm volatile("" : "+v"(tf));
#pragma unroll
        for (int i = 0; i < PZ; ++i) { const int t = tf + i * NT; const bool ok = ((i + 1) * NT <= LC) || t < L; y0[i] = ok ? (float)z0p[t] : 0.f; y1[i] = ok ? (float)z1p[t] : 0.f; }
#pragma unroll
        for (int i = 0; i < PZ; ++i) { const int t = tf + i * NT;
            if (((i + 1) * NT <= LC) || t < L) {
                const cf v = buf[fphys(t)];
                float a = v.x * sc, b = -v.y * sc;
                if (i == 0 || (i + 1) * NT > N - LC + 1) {
                    float ca = 0.f, cb = 0.f;
                    if (t >= lo) for (int k = lo; k <= t; ++k) { const float h = exf[k - lo]; ca += h * zh0[t - k]; cb += h * zh1[t - k]; }
                    if (t <= L - 1 - lo) for (int k = lo; k <= L - 1 - t; ++k) { const float h = exb[k - lo]; ca += h * zt0[t + k - lo]; cb += h * zt1[t + k - lo]; }
                    a += ca * norm; b += cb * norm; }
                a += sk * y0[i]; b += sk * y1[i];
                if (dostore) { z0p[t] = (zt_t)a; z1p[t] = (zt_t)b; } } }
    }
    __syncthreads();
}

#define XB_TMO      128
#define XB_XCNT(j)  (256  + 64 * (j))
#define XB_XSUB(j)  (1280 + 64 * (j))
#define XB_XGEN(j)  (2304 + 64 * (j))
#define XB_TOP      3328
#define XB_TOPGEN   3392
#define XCD_BAR_WORDS 3456
#define XB_SPIN_CAP (1u << 18)
__device__ __forceinline__ unsigned xb_ld(unsigned* p)              { return __hip_atomic_load(p, __ATOMIC_RELAXED, __HIP_MEMORY_SCOPE_AGENT); }
__device__ __forceinline__ unsigned xb_add(unsigned* p, unsigned v) { return __hip_atomic_fetch_add(p, v, __ATOMIC_RELAXED, __HIP_MEMORY_SCOPE_AGENT); }
__device__ __forceinline__ unsigned xb_xcc_id() { return (unsigned)__builtin_amdgcn_s_getreg((3 << 11) | 20) & 0xFu; }
#define XB_SPIN(cond, bar) do { unsigned _sp = 0; while (cond) { __builtin_amdgcn_s_sleep(1); \
    if ((++_sp & 255u) == 0u) { if (xb_ld(&(bar)[XB_TMO])) break; if (_sp > XB_SPIN_CAP) { atomicAdd(&(bar)[XB_TMO], 1u); break; } } } } while (0)
struct XcdBarrier { unsigned* bar; unsigned x; volatile LAS unsigned* st; };
__device__ __forceinline__ XcdBarrier xcd_barrier_post(unsigned* bar, volatile LAS unsigned* st) {
    XcdBarrier b; b.bar = bar; b.x = xb_xcc_id(); b.st = st;
    if (threadIdx.x == 0) (void)xb_add(&bar[XB_XCNT(b.x)], 1u);
    return b;
}
__device__ __forceinline__ void xcd_barrier_complete(unsigned* bar, unsigned x, unsigned& nloc, unsigned& nx) {
    const unsigned G = gridDim.x * gridDim.y * gridDim.z;
    unsigned sum, cnt, mine, sp = 0u;
    for (;;) {
        sum = 0u; cnt = 0u; mine = 0u;
#pragma unroll
        for (unsigned j = 0; j < 16; ++j) { const unsigned c = xb_ld(&bar[XB_XCNT(j)]); sum += c; cnt += (c > 0u) ? 1u : 0u; mine = (j == x) ? c : mine; }
        if (sum == G) break;
        __builtin_amdgcn_s_sleep(1);
        if ((++sp & 255u) == 0u) { if (xb_ld(&bar[XB_TMO])) break; if (sp > XB_SPIN_CAP) { atomicAdd(&bar[XB_TMO], 1u); break; } }
    }
    nloc = mine > 0u ? mine : 1u; nx = cnt > 0u ? cnt : 1u;
}
__device__ __forceinline__ void xcd_barrier(const XcdBarrier& b) {
    asm volatile("s_waitcnt vmcnt(0)" ::: "memory");
    __syncthreads();
    if (threadIdx.x == 0) {
        unsigned* bar = b.bar; unsigned bx = b.x;
        asm volatile("" : "+s"(bar), "+s"(bx));
        __builtin_amdgcn_s_waitcnt(0);
        unsigned nloc = b.st[0], nx = b.st[1];
        if (nloc == 0u) { xcd_barrier_complete(bar, bx, nloc, nx); b.st[0] = nloc; b.st[1] = nx; }
        const unsigned old = xb_add(&bar[XB_XSUB(bx)], 1u);
        const unsigned gen = old / nloc;
        if (old + 1u == (gen + 1u) * nloc) {
            __builtin_amdgcn_fence(__ATOMIC_RELEASE, "agent");
            asm volatile("s_waitcnt vmcnt(0)" ::: "memory");
            const unsigned og = xb_add(&bar[XB_TOP], 1u);
            const unsigned tg = og / nx;
            if (og + 1u == (tg + 1u) * nx) xb_add(&bar[XB_TOPGEN], 1u);
            else XB_SPIN(xb_ld(&bar[XB_TOPGEN]) == tg, bar);
            __builtin_amdgcn_fence(__ATOMIC_ACQUIRE, "agent");
            xb_add(&bar[XB_XGEN(bx)], 1u);
            asm volatile("s_waitcnt vmcnt(0)" ::: "memory");
        } else {
            XB_SPIN(xb_ld(&bar[XB_XGEN(bx)]) == gen, bar);
            __builtin_amdgcn_fence(__ATOMIC_ACQUIRE, "agent");
            asm volatile("s_waitcnt vmcnt(0)" ::: "memory");
        }
    }
    __syncthreads();
}

struct Ptrs {
    const float *x_prompt, *x_sample, *meta, *ln_g, *ln_b, *ffa_w13, *ffa_w2, *w_in, *b_gate, *conv_w, *conv_b, *f_w1, *f_b1, *f_freq, *f_w2, *f_b2, *f_w3, *skip, *q_norm, *k_norm,
                *w_br_hy, *w_br_attn, *w_out, *ffb_w13, *ffb_w2;
    float* out; unsigned char* ws;
};
typedef const __attribute__((address_space(4))) Ptrs CPtrs;
__device__ __forceinline__ unsigned pkh16(float lo, float hi) { unsigned a, b; asm volatile("v_cvt_f16_f32 %0, %1" : "=v"(a) : "v"(lo)); asm volatile("v_cvt_f16_f32 %0, %1" : "=v"(b) : "v"(hi)); return (a & 0xffffu) | (b << 16); }
#ifndef MMA_F16
#define MMA_F16 0
#endif
#if MMA_F16
__device__ __forceinline__ unsigned pkh2(float lo, float hi) { return pkh16(lo, hi); }
__device__ __forceinline__ float hsum2(unsigned w) { return pg8::f16_lo(w) + pg8::f16_hi(w); }
#else
__device__ __forceinline__ unsigned pkh2(float lo, float hi) { return pk2(lo, hi); }
__device__ __forceinline__ float hsum2(unsigned w) { return bflo(w) + bfhi(w); }
#endif
__device__ __forceinline__ void transpose_item(const float* W, int K, int N, bf16* WT, int k0, int n0, int dst_row0, LAS float* scr, int lane, const float* gk, const float* bk, float (&csum)[4], float (&bsum)[4], int ldw  ) {
#pragma unroll 8
    for (int i = 0; i < 32; ++i) { const int kk = 2 * i + (lane >> 5); scr[kk * 33 + (lane & 31)] = W[(size_t)(k0 + kk) * N + n0 + (lane & 31)]; }
    LDS_WAIT(); asm volatile("" ::: "memory");
    const int c = lane & 7;
    float gq[8], bq[8];
#pragma unroll
    for (int q = 0; q < 8; ++q) { gq[q] = gk ? gk[k0 + 8 * c + q] : 1.0f; bq[q] = gk ? bk[k0 + 8 * c + q] : 0.0f; }
#pragma unroll
    for (int j = 0; j < 4; ++j) { const int n = (lane >> 3) + 8 * j; const LAS float* s = scr + (8 * c) * 33 + n;
        float w[8]; float bs = 0.f;
#pragma unroll
        for (int q = 0; q < 8; ++q) { const float x = s[q * 33]; bs += bq[q] * x; w[q] = x * gq[q]; }
        v4u o; if (gk) { o.x = pkh2(w[0], w[1]); o.y = pkh2(w[2], w[3]); o.z = pkh2(w[4], w[5]); o.w = pkh2(w[6], w[7]); } else { o.x = pk2(w[0], w[1]); o.y = pk2(w[2], w[3]); o.z = pk2(w[4], w[5]); o.w = pk2(w[6], w[7]); }
        *(GAS v4u*)(WT + (size_t)(dst_row0 + n) * ldw + k0 + 8 * c) = o;
        if (gk) { csum[j] += (hsum2(o.x) + hsum2(o.y)) + (hsum2(o.z) + hsum2(o.w)); bsum[j] += bs; } }
    LDS_WAIT(); asm volatile("" ::: "memory");
}
__device__ __forceinline__ int swiglu_row(int n0) { const int up = n0 >= DFF, j = up ? n0 - DFF : n0; return 256 * (j >> 7) + (up ? 128 : 0) + (j & 127); }
__device__ __forceinline__ void convert_one(const float* W, int K, int N, bf16* WT, int item, LAS float* scr, int lane, int ldw = 0  ) {
    const int nblk = N / 32, kb = item / nblk, nb = item % nblk; float cd[4], bd[4];
    transpose_item(W, K, N, WT, 64 * kb, 32 * nb, 32 * nb, scr, lane, nullptr, nullptr, cd, bd, ldw ? ldw : K);
}
__device__ __forceinline__ void convert_folded(const float* W, int N, bf16* WT, int item, bool swiglu, LAS float* scr, int lane, const float* gk, const float* bk, float* cs, float* cb) {
    const int nb = item >> 1, half = item & 1, n0 = 32 * nb, dst = swiglu ? swiglu_row(n0) : n0;
    float csum[4] = {0.f, 0.f, 0.f, 0.f}, bsum[4] = {0.f, 0.f, 0.f, 0.f};
    for (int kb = half * (DM / 128); kb < (half + 1) * (DM / 128); ++kb) transpose_item(W, DM, N, WT, 64 * kb, n0, dst, scr, lane, gk, bk, csum, bsum, DM);
#pragma unroll
    for (int j = 0; j < 4; ++j) { float a = csum[j], b = bsum[j];
        a += xshfl<1>(a); a += xshfl<2>(a); a += xshfl<4>(a); b += xshfl<1>(b); b += xshfl<2>(b); b += xshfl<4>(b);
        if ((lane & 7) == 0) { const int n = (lane >> 3) + 8 * j; cs[(size_t)half * NCS + dst + n] = a; cb[(size_t)half * NCS + dst + n] = b; } }
}
__device__ __forceinline__ const float* ln_gain(CPtrs& P, int idx) { return idx < 0 ? (const float*)(P.ws + WS_ONE) : P.ln_g + (size_t)idx * DM; }
__device__ __forceinline__ const float* ln_bias(CPtrs& P, int idx) { return idx < 0 ? (const float*)(P.ws + WS_ONE) + DM : P.ln_b + (size_t)idx * DM; }
__device__ __forceinline__ void phase_convert(CPtrs& P, int layer, LAS unsigned char* lds, int gw, int NGW, int wave, int lane) {
    LAS float* scr = (LAS float*)(lds + wave * 16384);
    constexpr int F13 = 2 * (2 * DFF / 32), FIN = 2 * (NIN / 32), NFOLD = 2 * F13 + FIN;
    constexpr int I2 = (DFF / 64) * (DM / 32), IBH = (DHY / 64) * (DM / 32), IBA = (DM / 64) * (DM / 32), NSHORT = 2 * I2 + IBH + 2 * IBA;
    unsigned char* ws = P.ws;
    float* CS = (float*)(ws + WS_CS) + (size_t)layer * 2 * NCS; float* CB = (float*)(ws + WS_CB) + (size_t)layer * 2 * NCS;
    const int lnA = layer == 0 ? -1 : (layer - 1) * 3 + 2, lnI = layer * 3 + 0, lnB = layer * 3 + 1;
    for (int it = gw; it < NFOLD + NSHORT; it += NGW) {
        int r = it;
        if (r < F13) { convert_folded(P.ffa_w13 + (size_t)layer * DM * 2 * DFF, 2 * DFF, (bf16*)(ws + WS_W13A), r, true, scr, lane, ln_gain(P, lnA), ln_bias(P, lnA), CS + CS_W13A, CB + CS_W13A); continue; } r -= F13;
        if (r < FIN) { convert_folded(P.w_in + (size_t)layer * DM * NIN, NIN, (bf16*)(ws + WS_WIN), r, false, scr, lane, ln_gain(P, lnI), ln_bias(P, lnI), CS + CS_WIN, CB + CS_WIN); continue; } r -= FIN;
        if (r < F13) { convert_folded(P.ffb_w13 + (size_t)layer * DM * 2 * DFF, 2 * DFF, (bf16*)(ws + WS_W13B), r, true, scr, lane, ln_gain(P, lnB), ln_bias(P, lnB), CS + CS_W13B, CB + CS_W13B); continue; } r -= F13;
        if (r < I2) { convert_one(P.ffa_w2 + (size_t)layer * DFF * DM, DFF, DM, (bf16*)(ws + WS_W2A), r, scr, lane); continue; } r -= I2;
        if (r < IBH) { convert_one(P.w_br_hy + (size_t)layer * DHY * DM, DHY, DM, (bf16*)(ws + WS_WBH), r, scr, lane, DYC); continue; } r -= IBH;
        if (r < IBA) { convert_one(P.w_br_attn + (size_t)layer * DM * DM, DM, DM, (bf16*)(ws + WS_WBH) + DHY, r, scr, lane, DYC); continue; } r -= IBA;
        if (r < IBA) { convert_one(P.w_out + (size_t)layer * DM * DM, DM, DM, (bf16*)(ws + WS_WOUT), r, scr, lane); continue; } r -= IBA;
        convert_one(P.ffb_w2 + (size_t)layer * DFF * DM, DFF, DM, (bf16*)(ws + WS_W2B), r, scr, lane);
    }
}
__device__ __forceinline__ void row_to_seq(int m, int& s, int& t) { s = m < LP ? 0 : (m < 2 * LP ? 1 : (m < 2 * LP + LS ? 2 : 3)); t = m - seq_row0(s); }
__device__ __forceinline__ void phase_init(CPtrs& P, int gw, int NGW, int lane) {
    bf16* HB = (bf16*)(P.ws + WS_HB); bf16* R16 = (bf16*)(P.ws + WS_H32);
    { long long* ST = (long long*)(P.ws + WS_ST); float* ONE = (float*)(P.ws + WS_ONE);
      const size_t t0 = (size_t)gw * 64 + lane, ts = (size_t)NGW * 64;
      for (size_t e = t0; e < (size_t)MPAD * 2; e += ts) ST[e] = (e & 1) ? (long long)(2048.0 * (1.0 - 1e-5) * 1048576.0) : 0ll;
      for (size_t e = (size_t)MPAD * 2 + t0; e < (size_t)NSTAT * MPAD * 2; e += ts) ST[e] = 0ll;
      for (size_t e = t0; e < (size_t)2 * DM; e += ts) ONE[e] = e < DM ? 1.0f : 0.0f; }
    for (int m = gw; m < MPAD; m += NGW) {
        const float* src = nullptr;
        if (m < NTOK) { int s, t; row_to_seq(m, s, t);
            if (t < NMETA) src = P.meta + (size_t)t * DM;
            else src = (s < 2 ? P.x_prompt + ((size_t)s * SP + (t - NMETA)) * DM : P.x_sample + ((size_t)(s - 2) * SS + (t - NMETA)) * DM); }
#pragma unroll
        for (int j = 0; j < 4; ++j) { const int e = 8 * lane + 512 * j;
            f32x4 a = {0.f, 0.f, 0.f, 0.f}, b = {0.f, 0.f, 0.f, 0.f};
            if (src) { a = *(const f32x4*)(src + e); b = *(const f32x4*)(src + e + 4); }
            v4u o; o.x = pk2(a[0], a[1]); o.y = pk2(a[2], a[3]); o.z = pk2(b[0], b[1]); o.w = pk2(b[2], b[3]);
            if (!MMA_F16) *(v4u*)(HB + (size_t)m * DM + e) = o;
            v4u h; h.x = pkh16(a[0], a[1]); h.y = pkh16(a[2], a[3]); h.z = pkh16(b[0], b[1]); h.w = pkh16(b[2], b[3]);
            *(v4u*)(R16 + (size_t)m * DM + e) = h; }
    }
}
__device__ __forceinline__ void phase_filter_hidden(CPtrs& P, int gw, int NGW, int lane) {
    bf16* H2 = (bf16*)(P.ws + WS_H2);
    { bf16* W3T = (bf16*)(P.ws + WS_W3T);
      for (int e = gw * 64 + lane; e < DEPTH * 2 * DHY * FILT_W; e += NGW * 64) { const int j = e & 63, cc = (e >> 6) & (2 * DHY - 1), ly = e >> 17; W3T[e] = (bf16)f2bf(P.f_w3[((size_t)ly * FILT_W + j) * 2 * DHY + cc]); } }
    for (int layer = 0; layer < DEPTH; ++layer) {
        float w1c[FILT_EMB], w2c[FILT_W];
#pragma unroll
        for (int f = 0; f < FILT_EMB; ++f) w1c[f] = P.f_w1[((size_t)layer * FILT_EMB + f) * FILT_W + lane];
#pragma unroll
        for (int i = 0; i < FILT_W; ++i) w2c[i] = P.f_w2[((size_t)layer * FILT_W + i) * FILT_W + lane];
        const float b1 = P.f_b1[layer * FILT_W + lane], b2 = P.f_b2[layer * FILT_W + lane], fq = P.f_freq[layer * FILT_W + lane];
        for (int rr = gw; rr < LP + LS; rr += NGW) {
            const int grp = rr < LP ? 0 : 1, k = grp ? rr - LP : rr, L = grp ? LS : LP;
            float zf;
            { const float w = 6.283185307179586f * (float)k / (float)L;
              if (lane == 0) zf = (float)k / (float)(L - 1);
              else { const int mm = (lane - 1) & 15; const float fr = 1e-4f + (float)mm * ((15.0f - 1e-4f) / 15.0f); const float rv = __builtin_amdgcn_fractf(fr * (float)k / (float)L); zf = (lane <= 16) ? __builtin_amdgcn_cosf(rv) : -__builtin_amdgcn_sinf(rv); } }
            float a = b1;
#pragma unroll
            for (int f = 0; f < FILT_EMB; ++f) a += __builtin_bit_cast(float, __builtin_amdgcn_readlane(__builtin_bit_cast(int, zf), f)) * w1c[f];
            const float h1 = __builtin_amdgcn_sinf(__builtin_amdgcn_fractf(fq * a * 0.15915494309189535f));
            float c = b2;
#pragma unroll
            for (int i = 0; i < FILT_W; ++i) c += __builtin_bit_cast(float, __builtin_amdgcn_readlane(__builtin_bit_cast(int, h1), i)) * w2c[i];
            H2[(((size_t)layer * 2 + grp) * LP + k) * FILT_W + lane] = (bf16)f2bf(__builtin_amdgcn_sinf(__builtin_amdgcn_fractf(fq * c * 0.15915494309189535f)));
        }
    }
}
__device__ __forceinline__ void phase_taps(CPtrs& P, int layer, int gw, int NGW, int lane) {
    const bf16* W3T = (const bf16*)(P.ws + WS_W3T) + (size_t)layer * 2 * DHY * FILT_W; zt_t* TAPS = (zt_t*)(P.ws + WS_G);
    const int fr = lane & 15, fq = lane >> 4;
    constexpr int NKP = (LP + 63) / 64, NKS = (LS + 63) / 64, NITEM = (NKP + NKS) * 8;
    for (int it = gw; it < NITEM; it += NGW) {
        const int kb = it >> 3, cb = it & 7, grp = kb >= NKP ? 1 : 0, L = grp ? LS : LP, k0 = (grp ? kb - NKP : kb) * 64;
        const bf16* hb = (const bf16*)(P.ws + WS_H2) + ((size_t)layer * 2 + grp) * LP * FILT_W;
        bf16x8 a[4][2];
#pragma unroll
        for (int mt = 0; mt < 4; ++mt) { int row = k0 + 16 * mt + fr; row = row < L ? row : L - 1;
#pragma unroll
            for (int ks = 0; ks < 2; ++ks) a[mt][ks] = *(const bf16x8*)(hb + (size_t)row * FILT_W + 32 * ks + 8 * fq); }
        zt_t* tb = TAPS + (grp ? (size_t)2 * DHY * LP : 0);
#pragma unroll 4
        for (int ct = 0; ct < 16; ++ct) {
            const int cc = cb * 256 + ct * 16 + fr;
            const bf16x8 b0 = *(const bf16x8*)(W3T + (size_t)cc * FILT_W + 8 * fq), b1 = *(const bf16x8*)(W3T + (size_t)cc * FILT_W + 32 + 8 * fq);
#pragma unroll
            for (int mt = 0; mt < 4; ++mt) { f32x4 acc = {0.f, 0.f, 0.f, 0.f};
                acc = __builtin_amdgcn_mfma_f32_16x16x32_bf16(a[mt][0], b0, acc, 0, 0, 0); acc = __builtin_amdgcn_mfma_f32_16x16x32_bf16(a[mt][1], b1, acc, 0, 0, 0);
                const int kk = k0 + 16 * mt + 4 * fq;
                if (kk < L) { typedef _Float16 h4 __attribute__((ext_vector_type(4))); const h4 hv = {(_Float16)acc[0], (_Float16)acc[1], (_Float16)acc[2], (_Float16)acc[3]}; *(h4*)(tb + (size_t)cc * L + kk) = hv; } }
        }
    }
}
__device__ __forceinline__ void phase_ln_out(CPtrs& P, const float* g, const float* b, int gw, int NGW, int lane) {
    const bf16* HB = (const bf16*)(P.ws + WS_H32);
    f32x4 gv[8], bv[8];
#pragma unroll
    for (int j = 0; j < 4; ++j) { const int e = 8 * lane + 512 * j; gv[2 * j] = *(const f32x4*)(g + e); gv[2 * j + 1] = *(const f32x4*)(g + e + 4); bv[2 * j] = *(const f32x4*)(b + e); bv[2 * j + 1] = *(const f32x4*)(b + e + 4); }
    typedef _Float16 h2 __attribute__((ext_vector_type(2)));
    for (int m = gw; m < NTOK; m += NGW) {
        int s, t; row_to_seq(m, s, t); if (t < NMETA) continue;
        float* orow = P.out + (s < 2 ? ((size_t)s * SP + (t - NMETA)) * DM : (size_t)2 * SP * DM + ((size_t)(s - 2) * SS + (t - NMETA)) * DM);
        f32x4 v[8]; float sm = 0.f;
#pragma unroll
        for (int j = 0; j < 4; ++j) { const v4u w = *(const v4u*)(HB + (size_t)m * DM + 8 * lane + 512 * j);
            v[2 * j] = (f32x4){pg8::f16_lo(w.x), pg8::f16_hi(w.x), pg8::f16_lo(w.y), pg8::f16_hi(w.y)}; v[2 * j + 1] = (f32x4){pg8::f16_lo(w.z), pg8::f16_hi(w.z), pg8::f16_lo(w.w), pg8::f16_hi(w.w)}; }
#pragma unroll
        for (int j = 0; j < 8; ++j) sm += (v[j][0] + v[j][1]) + (v[j][2] + v[j][3]);
        const float mean = wave_sum(sm) * (1.0f / DM); float s2 = 0.f;
#pragma unroll
        for (int j = 0; j < 8; ++j) { v[j] = v[j] - mean; s2 += (v[j][0] * v[j][0] + v[j][1] * v[j][1]) + (v[j][2] * v[j][2] + v[j][3] * v[j][3]); }
        const float rstd = __builtin_amdgcn_rsqf(wave_sum(s2) * (1.0f / DM) + LN_EPS);
#pragma unroll
        for (int j = 0; j < 4; ++j) { const int e = 8 * lane + 512 * j;
            *(f32x4*)(orow + e) = v[2 * j] * rstd * gv[2 * j] + bv[2 * j]; *(f32x4*)(orow + e + 4) = v[2 * j + 1] * rstd * gv[2 * j + 1] + bv[2 * j + 1]; }
    }
}
__device__ __forceinline__ void phase_qkprep(CPtrs& P, int layer, int gw, int NGW, int lane) {
    bf16* PR = (bf16*)(P.ws + WS_PROJ); bf16* KC = (bf16*)(P.ws + WS_KC);
    const int h2 = lane >> 5, l = lane & 31, seg = l >> 4, j = l & 15, idxA = seg * 64 + 2 * j, idxB = idxA + 32;
    const float invf0 = exp2f(-(float)(2 * j) * (13.287712379549449f / 32.0f)), invf1 = exp2f(-(float)(2 * j + 1) * (13.287712379549449f / 32.0f));
    const float gqA0 = P.q_norm[layer * HD + idxA], gqA1 = P.q_norm[layer * HD + idxA + 1], gqB0 = P.q_norm[layer * HD + idxB], gqB1 = P.q_norm[layer * HD + idxB + 1];
    const float gkA0 = P.k_norm[layer * HD + idxA], gkA1 = P.k_norm[layer * HD + idxA + 1], gkB0 = P.k_norm[layer * HD + idxB], gkB1 = P.k_norm[layer * HD + idxB + 1];
    for (int m = gw; m < NTOK; m += NGW) {
        int s, t; row_to_seq(m, s, t);
        float rowp, colp; if (t < NMETA) { rowp = -1.0f; colp = (float)t; } else { const int jj = t - NMETA; rowp = (float)(jj >> 6); colp = (float)(jj & 63); }
        const float pos = seg ? colp : rowp;
        const float rv0 = pos * invf0 * 0.15915494309189535f, rv1 = pos * invf1 * 0.15915494309189535f;
        const float sn0 = __builtin_amdgcn_sinf(rv0), cs0 = __builtin_amdgcn_cosf(rv0), sn1 = __builtin_amdgcn_sinf(rv1), cs1 = __builtin_amdgcn_cosf(rv1);
        bf16* rowb = PR + (size_t)m * NIN;
        unsigned wA[10], wB[10];
#pragma unroll
        for (int it = 8; it < 10; ++it) { const int hd = 2 * it + h2; const bf16* hp = rowb + (it < 8 ? COL_Q + hd * HD : COL_K + (hd - NQH) * HD);
            wA[it] = *(const unsigned*)(hp + idxA); wB[it] = *(const unsigned*)(hp + idxB); }
#pragma unroll
        for (int it = 8; it < 10; ++it) { const int hd = 2 * it + h2; bf16* hp = (it < 8) ? rowb + COL_Q + hd * HD : KC + (kc_row(s, hd - NQH) + t) * HD;
            const float a0 = bflo(wA[it]), a1 = bfhi(wA[it]), b0 = bflo(wB[it]), b1 = bfhi(wB[it]);
            float ss = (a0 * a0 + a1 * a1) + (b0 * b0 + b1 * b1);
            ss += xshfl<1>(ss); ss += xshfl<2>(ss); ss += xshfl<4>(ss); ss += xshfl<8>(ss); ss += xshfl<16>(ss);
            const float rstd = __builtin_amdgcn_rsqf(ss * (1.0f / HD) + QK_EPS);
            const float n1a = a0 * rstd * (it < 8 ? gqA0 : gkA0), n1b = a1 * rstd * (it < 8 ? gqA1 : gkA1), n2a = b0 * rstd * (it < 8 ? gqB0 : gkB0), n2b = b1 * rstd * (it < 8 ? gqB1 : gkB1);
            *(unsigned*)(hp + idxA) = pk2(n1a * cs0 - n2a * sn0, n1b * cs1 - n2b * sn1);
            *(unsigned*)(hp + idxB) = pk2(n2a * cs0 + n1a * sn0, n2b * cs1 + n1b * sn1); }
    }
}
__device__ __forceinline__ void phase_vcopy(CPtrs& P, int gw, int NGW, int lane) {
    const bf16* PR = (const bf16*)(P.ws + WS_PROJ); bf16* KC = (bf16*)(P.ws + WS_KC); bf16* VC = (bf16*)(P.ws + WS_VC);
    const int kvh = lane >> 4, e = (lane & 15) * 8;
    (void)kvh; (void)e; (void)PR;
    constexpr int PADP = LPP - LP, PADS = LSP - LS, NPAD = 2 * NKVH * PADP + 2 * NKVH * PADS;
    for (int r = gw; r < NPAD; r += NGW) { int s, q = r; if (q < 2 * NKVH * PADP) { s = q / (NKVH * PADP); q -= s * NKVH * PADP; } else { q -= 2 * NKVH * PADP; s = 2 + q / (NKVH * PADS); q -= (s - 2) * NKVH * PADS; }
        const int pad = s < 2 ? PADP : PADS, kv = q / pad, t = seq_len(s) + q % pad;
        if (lane < 16) { unsigned z0 = 0u; asm volatile("" : "+v"(z0)); const v4u z = {z0, z0, z0, z0}; *(v4u*)(KC + (kc_row(s, kv) + t) * HD + lane * 8) = z; } }
}
__device__ __forceinline__ void hy_item(int it, int& s, int& tt, int& ct) {
    constexpr int FTP = LP / 32, FTS = LS / 32, NFULL = 2 * FTP * 8 + 2 * FTS * 8;
    static_assert(LP - FTP * 32 == 16 && LS - FTS * 32 == 16, "remainder tiles have 16 rows");
    if (it < 2 * FTP * 8) { s = it / (FTP * 8); const int r = it - s * FTP * 8; ct = r & 7; tt = r >> 3; }
    else if (it < NFULL) { const int v = it - 2 * FTP * 8; s = 2 + v / (FTS * 8); const int r = v - (s - 2) * FTS * 8; ct = r & 7; tt = r >> 3; }
    else { const int v = it - NFULL; s = v >> 3; ct = v & 7; tt = s < 2 ? FTP : FTS; }
}
constexpr int HY_NITEM = 2 * ((LP + 31) / 32) * 8 + 2 * ((LS + 31) / 32) * 8;
__device__ __forceinline__ void phase_hy_pre(CPtrs& P, int layer, LAS unsigned char* lds, int gw, int NGW, int wave, int lane) {
    const bf16* PR = (const bf16*)(P.ws + WS_PROJ); zt_t* ZT = (zt_t*)(P.ws + WS_ZT);
    LAS float* tile = (LAS float*)(lds + wave * 16896);
    const float* cw = P.conv_w + (size_t)layer * 3 * 3 * DHY; const float* cb = P.conv_b + (size_t)layer * 3 * DHY;
    const int half = lane >> 5, tl5 = lane & 31;
    for (int it = gw; it < HY_NITEM; it += NGW) {
        int s, tt, ct; hy_item(it, s, tt, ct);
        const int L = seq_len(s), row0 = seq_row0(s), t0 = tt * 32, c0 = ct * 128 + 2 * lane;
        unsigned xr[34], vr[34];
        const bool fullt = (t0 + 16 < L);
#pragma unroll
        for (int i = 0; i < 18; ++i) { const int t = t0 - 1 + i; const bool ok = (t >= 0 && t < L); const bf16* rp = PR + (size_t)(row0 + (ok ? t : 0)) * NIN + c0;
            const unsigned xa = *(const unsigned*)(rp + DHY), va = *(const unsigned*)(rp + 2 * DHY); xr[i] = ok ? xa : 0u; vr[i] = ok ? va : 0u; }
        if (fullt) {
#pragma unroll
        for (int i = 18; i < 34; ++i) { const int t = t0 - 1 + i; const bool ok = (t >= 0 && t < L); const bf16* rp = PR + (size_t)(row0 + (ok ? t : 0)) * NIN + c0;
            const unsigned xa = *(const unsigned*)(rp + DHY), va = *(const unsigned*)(rp + 2 * DHY); xr[i] = ok ? xa : 0u; vr[i] = ok ? va : 0u; }
        } else {
#pragma unroll
        for (int i = 18; i < 34; ++i) { xr[i] = 0u; vr[i] = 0u; } }
        float wx[3][2], wv[3][2], bx[2], bv[2];
#pragma unroll
        for (int k = 0; k < 3; ++k) { wx[k][0] = cw[k * 3 * DHY + DHY + c0]; wx[k][1] = cw[k * 3 * DHY + DHY + c0 + 1]; wv[k][0] = cw[k * 3 * DHY + 2 * DHY + c0]; wv[k][1] = cw[k * 3 * DHY + 2 * DHY + c0 + 1]; }
        bx[0] = cb[DHY + c0]; bx[1] = cb[DHY + c0 + 1]; bv[0] = cb[2 * DHY + c0]; bv[1] = cb[2 * DHY + c0 + 1];
#define HYPRE_Q(q) { \
            const float x0 = wx[0][0] * bflo(xr[q]) + wx[1][0] * bflo(xr[q + 1]) + wx[2][0] * bflo(xr[q + 2]) + bx[0], x1 = wx[0][1] * bfhi(xr[q]) + wx[1][1] * bfhi(xr[q + 1]) + wx[2][1] * bfhi(xr[q + 2]) + bx[1]; \
            const float v0 = wv[0][0] * bflo(vr[q]) + wv[1][0] * bflo(vr[q + 1]) + wv[2][0] * bflo(vr[q + 2]) + bv[0], v1 = wv[0][1] * bfhi(vr[q]) + wv[1][1] * bfhi(vr[q + 1]) + wv[2][1] * bfhi(vr[q + 2]) + bv[1]; \
            tile[lane * 33 + q] = x0 * v0; tile[2112 + lane * 33 + q] = x1 * v1; }
#pragma unroll
        for (int q = 0; q < 16; ++q) HYPRE_Q(q)
        if (fullt) {
#pragma unroll
        for (int q = 16; q < 32; ++q) HYPRE_Q(q)
        }
#undef HYPRE_Q
        LDS_WAIT(); asm volatile("" ::: "memory");
        zt_t* zb = ZT + zt_off(s) + (size_t)(ct * 128 + half) * L + t0 + tl5;
        if (t0 + tl5 < L) {
#pragma unroll 16
            for (int cc = 0; cc < 64; ++cc) zb[(size_t)(2 * cc) * L] = (zt_t)tile[half * 2112 + cc * 33 + tl5];
        }
        LDS_WAIT(); asm volatile("" ::: "memory");
    }
}
__device__ __forceinline__ void phase_hy_post(CPtrs& P, int layer, LAS unsigned char* lds, int gw, int NGW, int wave, int lane) {
    const bf16* PR = (const bf16*)(P.ws + WS_PROJ); const zt_t* ZT = (const zt_t*)(P.ws + WS_ZT); bf16* YH = (bf16*)(P.ws + WS_YHY);
    LAS float* tile = (LAS float*)(lds + wave * 16896);
    const float* cw = P.conv_w + (size_t)layer * 3 * 3 * DHY; const float* cb = P.conv_b + (size_t)layer * 3 * DHY;
    const int half = lane >> 5, tl5 = lane & 31;
    for (int it = gw; it < HY_NITEM; it += NGW) {
        int s, tt, ct; hy_item(it, s, tt, ct);
        const int L = seq_len(s), row0 = seq_row0(s), t0 = tt * 32, c0 = ct * 128 + 2 * lane;
        unsigned xr[34];
        const bool fullt = (t0 + 16 < L);
#pragma unroll
        for (int i = 0; i < 18; ++i) { const int t = t0 - 1 + i; const bool ok = (t >= 0 && t < L); const unsigned xa = *(const unsigned*)(PR + (size_t)(row0 + (ok ? t : 0)) * NIN + c0); xr[i] = ok ? xa : 0u; }
        if (fullt) {
#pragma unroll
        for (int i = 18; i < 34; ++i) { const int t = t0 - 1 + i; const bool ok = (t >= 0 && t < L); const unsigned xa = *(const unsigned*)(PR + (size_t)(row0 + (ok ? t : 0)) * NIN + c0); xr[i] = ok ? xa : 0u; }
        } else {
#pragma unroll
        for (int i = 18; i < 34; ++i) xr[i] = 0u; }
        { const bool okt = (t0 + tl5 < L); const zt_t* zb = ZT + zt_off(s) + (size_t)(ct * 128 + half) * L + (okt ? t0 + tl5 : 0);
#pragma unroll 16
          for (int cc = 0; cc < 64; ++cc) { const float z = (float)zb[(size_t)(2 * cc) * L]; tile[half * 2112 + cc * 33 + tl5] = okt ? z : 0.f; } }
        float wx[3][2], bx[2];
#pragma unroll
        for (int k = 0; k < 3; ++k) { wx[k][0] = cw[k * 3 * DHY + c0]; wx[k][1] = cw[k * 3 * DHY + c0 + 1]; }
        bx[0] = cb[c0]; bx[1] = cb[c0 + 1];
        LDS_WAIT(); asm volatile("" ::: "memory");
#define HYPOST_Q(q) { \
            const float x0 = wx[0][0] * bflo(xr[q]) + wx[1][0] * bflo(xr[q + 1]) + wx[2][0] * bflo(xr[q + 2]) + bx[0], x1 = wx[0][1] * bfhi(xr[q]) + wx[1][1] * bfhi(xr[q + 1]) + wx[2][1] * bfhi(xr[q + 2]) + bx[1]; \
            if (t0 + q < L) *(unsigned*)(YH + (size_t)(row0 + t0 + q) * DYC + c0) = pk2(x0 * tile[lane * 33 + q], x1 * tile[2112 + lane * 33 + q]); }
#pragma unroll
        for (int q = 0; q < 16; ++q) HYPOST_Q(q)
        if (fullt) {
#pragma unroll
        for (int q = 16; q < 32; ++q) HYPOST_Q(q)
        }
#undef HYPOST_Q
        LDS_WAIT(); asm volatile("" ::: "memory");
    }
}
constexpr int NFB_P = LP / 256, NFB_S = LS / 256;
static_assert(LP - NFB_P * 256 == 16 && LS - NFB_S * 256 == 16 && ((LP + 63) / 64) % 2 == 1 && ((LS + 63) / 64) % 2 == 1, "attention unit geometry (odd tile counts)");
constexpr int NU_SP = NQH * NFB_P + NKVH, NU_SS = NQH * NFB_S + NKVH;
constexpr int NU_AP = 2 * NU_SP, NU_AS = 2 * NU_SS, NU_ATT = NU_AP + NU_AS;
constexpr int NU_MIX = NU_ATT + 2 * DHY;
__device__ __forceinline__ int mix_fetch(volatile LAS unsigned* MISC, unsigned* qctr) {
    __syncthreads();
    if (threadIdx.x == 0) MISC[16] = __hip_atomic_fetch_add(qctr, 1u, __ATOMIC_RELAXED, __HIP_MEMORY_SCOPE_AGENT);
    __syncthreads();
    return __builtin_amdgcn_readfirstlane((int)MISC[16]);
}
__device__ __forceinline__ int mix_complete(volatile LAS unsigned* MISC, unsigned v) {
    __syncthreads();
    int t = threadIdx.x; asm volatile("" : "+v"(t));
    if (t == 0) MISC[16] = v;
    __syncthreads();
    return __builtin_amdgcn_readfirstlane((int)MISC[16]);
}
#ifndef MIX_MASK
#define MIX_MASK 7
#endif
#define FFT_REPS ((REP_MASK >> 16 & 1u) ? 2 : 1)
#define PROBE_SKIP ((int)(REP_MASK >> 24 & 15u))
template <int MODE  >
__device__ __forceinline__ void phase_mix(CPtrs& P, int layer, unsigned char* ldsg, volatile LAS unsigned* MISC, unsigned* qctr) {
    int u = mix_fetch(MISC, qctr); unsigned nxt = 0u;
    while (u < NU_ATT) {
        if (MIX_MASK & 1) {
            const bf16* PR = (const bf16*)(P.ws + WS_PROJ); bf16* YA = (bf16*)(P.ws + WS_YHY) + DHY; const bf16* KC = (const bf16*)(P.ws + WS_KC); const bf16* VC = (const bf16*)(P.ws + WS_VC);
            int s, r, L, nfb;
            if (u < NU_AP) { s = u / NU_SP; r = u % NU_SP; L = LP; nfb = NFB_P; } else { const int v = u - NU_AP; s = 2 + v / NU_SS; r = v % NU_SS; L = LS; nfb = NFB_S; }
            int hd, q0, qvalid, packed;
            if (r < NQH * nfb) { hd = r / nfb; q0 = (r % nfb) * 256; qvalid = 256; packed = 0; } else { hd = 4 * (r - NQH * nfb); q0 = nfb * 256; qvalid = 64; packed = 1; }
            const int row0 = seq_row0(s), kvh = hd >> 2, NT = (L + 63) / 64;
            att::attn_unit(PR + (size_t)(row0 + q0) * NIN + COL_Q + hd * HD, qvalid, packed, KC + kc_row(s, kvh) * HD, PR + (size_t)row0 * NIN + COL_V + kvh * HD,
                           YA + (size_t)(row0 + q0) * DYC + hd * HD, L, NT, (char*)ldsg, qctr, nxt, P.q_norm + layer * HD, q0);
        }
        u = mix_complete(MISC, nxt);
    }
    if (MODE == 1) return;
    while (u < NU_ATT + DHY) {
        if (MIX_MASK & 2) {
            zt_t* ZT = (zt_t*)(P.ws + WS_ZT); const int c = u - NU_ATT;
            FiltArgs fa; fa.tf = (const zt_t*)(P.ws + WS_G) + (size_t)c * LP; fa.tb = fa.tf + (size_t)DHY * LP; fa.skip = P.skip + (size_t)layer * DHY;
            for (int rp = 0; rp < FFT_REPS; ++rp) conv_unit<16384, 4>(rp == FFT_REPS - 1, rp == FFT_REPS - 1 ? 0 : PROBE_SKIP, (char*)ldsg, fa, c, LP, ZT + zt_off(0) + (size_t)c * LP, ZT + zt_off(1) + (size_t)c * LP, qctr, nxt);
        }
        u = mix_complete(MISC, nxt);
    }
    while (u < NU_MIX) {
        if (MIX_MASK & 4) {
            zt_t* ZT = (zt_t*)(P.ws + WS_ZT); const int c = u - NU_ATT - DHY;
            FiltArgs fa; fa.tf = (const zt_t*)(P.ws + WS_G) + (size_t)2 * DHY * LP + (size_t)c * LS; fa.tb = fa.tf + (size_t)DHY * LS; fa.skip = P.skip + (size_t)layer * DHY;
            for (int rp = 0; rp < FFT_REPS; ++rp) conv_unit<8192, 2>(rp == FFT_REPS - 1, rp == FFT_REPS - 1 ? 0 : PROBE_SKIP, (char*)ldsg, fa, c, LS, ZT + zt_off(2) + (size_t)c * LS, ZT + zt_off(3) + (size_t)c * LS, qctr, nxt);
        }
        u = mix_complete(MISC, nxt);
    }
}

__device__ __forceinline__ CPtrs* lsp(CPtrs* p) { asm volatile("" : "+s"(p)); return p; }
__device__ __forceinline__ int lvg(int v) { asm volatile("" : "+v"(v)); return v; }
__device__ __forceinline__ int lsg(int v) { asm volatile("" : "+s"(v)); return v; }
#ifndef W2_WGM
#define W2_WGM 4
#endif
#ifndef W2_REV
#define W2_REV 0
#endif
constexpr int MMAIN = 24576, MTAIL0 = MMAIN;
static_assert(NTOK - MMAIN == 64, "tail panel is exactly 64 rows");
constexpr int NPH_LAYER = 14, NPHASES = 1 + DEPTH * NPH_LAYER;
struct Args { Ptrs p; int ph_lo, ph_hi; };
__global__ void __launch_bounds__(512, 2) fwd(Args args) {
    extern __shared__ __attribute__((aligned(16))) unsigned char lds[];
    CPtrs* Pk = (CPtrs*)__builtin_amdgcn_kernarg_segment_ptr();
#define P (*lsp(Pk))
    LAS unsigned char* ldsl = (LAS unsigned char*)lds;
    volatile LAS unsigned* MISC = (volatile LAS unsigned*)(ldsl + LDS_MISC);
    const int tid = threadIdx.x, lane = tid & 63, wave = __builtin_amdgcn_readfirstlane(tid >> 6);
    const int G = gridDim.x, gw = blockIdx.x * 8 + wave, NGW = G * 8;
    if (tid < 64) MISC[tid] = 0u;
    __syncthreads();
    unsigned* ctl = (unsigned*)(P.ws + WS_CTL);
    const int lo = args.ph_lo, hi = args.ph_hi;
    const bool multi = (hi - lo) > 1;
    XcdBarrier bar; bar.bar = ctl + CW_BAR; bar.x = 0; bar.st = nullptr;
    if (multi) bar = xcd_barrier_post(ctl + CW_BAR, MISC + 8);
#ifndef PH_MASK
#define PH_MASK 0xFFFFFFFFu
#endif
#ifndef REP_MASK
#define REP_MASK 0u
#endif
#define NREP(j) ((REP_MASK >> (j) & 1u) ? 2 : 1)
#define INP(k, j) ((PH_MASK >> (j) & 1u) && lo <= (k) && (k) < hi)
#define IN(k) (lo <= (k) && (k) < hi)
#define SEAM(k) do { if (IN(k) && (k) + 1 < hi) xcd_barrier(bar); } while (0)
    if (INP(0, 14)) { phase_init(P, gw, NGW, lane); phase_filter_hidden(P, gw, NGW, lane); }
    SEAM(0);
    const pg8::bf16_t* HB = (const pg8::bf16_t*)(P.ws + (MMA_F16 ? WS_H32 : WS_HB));
    pg8::bf16_t* PROJ = (pg8::bf16_t*)(P.ws + WS_PROJ);
    bf16* RBw = MMA_F16 ? (bf16*)nullptr : (bf16*)(P.ws + WS_HB);
#define STAT(i) ((float*)((long long*)(P.ws + WS_ST) + (size_t)(i) * MPAD * 2))
    for (int layer = 0; layer < DEPTH; ++layer) {
        const int pb = 1 + layer * NPH_LAYER;
        const int sA = layer == 0 ? 0 : 3 * layer, sI = 1 + 3 * layer, sB = 2 + 3 * layer, sC = 3 + 3 * layer;
        const int lnA = layer == 0 ? -1 : (layer - 1) * 3 + 2, lnI = layer * 3, lnB = layer * 3 + 1;
        const float* CSl = (const float*)(P.ws + WS_CS) + (size_t)layer * 2 * NCS; const float* CBl = (const float*)(P.ws + WS_CB) + (size_t)layer * 2 * NCS;
        for (int rep = 0; rep < NREP(0); ++rep) { if (rep) xcd_barrier(bar);
        if (INP(pb + 0, 0)) { phase_convert(P, layer, ldsl, lsg(gw), lsg(NGW), lsg(wave), lvg(lane)); phase_taps(P, layer, lsg(gw), lsg(NGW), lvg(lane)); }
        }
        SEAM(pb + 0);
        for (int rep = 0; rep < NREP(1); ++rep) { if (rep) xcd_barrier(bar);
        if (INP(pb + 1, 1)) {
            pg8::Gemm g{HB, (const pg8::bf16_t*)(P.ws + WS_W13A), MPAD, 2 * DFF, DM}; pg8::StaticOrder S; S.init(MPAD, 2 * DFF, lsg(G), lsg((int)blockIdx.x));
            pg8::EpiSwiglu E{PROJ, DFF, STAT(sA), CSl + CS_W13A, CBl + CS_W13A};
            pg8::gemm_phase<pg8::EpiSwiglu, pg8::StaticOrder, true, true, MMA_F16 != 0>(ldsl, g, S, E);
        }
        }
        SEAM(pb + 1);
        if (INP(pb + 2, 2)) {
            pg8::Gemm g{PROJ, (const pg8::bf16_t*)(P.ws + WS_W2A), MMAIN, DM, DFF}; pg8::StaticOrder S; S.init(MMAIN, DM, lsg(G), lsg((int)blockIdx.x), W2_WGM, W2_REV);
            pg8::EpiResid E{(pg8::bf16_t*)(P.ws + WS_H32), (pg8::bf16_t*)RBw, DM, ALPHA, 0.5f, STAT(sA), ln_gain(P, lnA), ln_bias(P, lnA), STAT(sI)};
            gemm_tail(ldsl, (const bf16*)PROJ + (size_t)MTAIL0 * DFF, (const bf16*)(P.ws + WS_W2A), DM, DFF, MTAIL0, E, lsg(G), lsg((int)blockIdx.x));
            pg8::gemm_phase<pg8::EpiResid, pg8::StaticOrder, true, true>(ldsl, g, S, E);
        }
        SEAM(pb + 2);
        for (int rep = 0; rep < NREP(4); ++rep) { if (rep) xcd_barrier(bar);
        if (INP(pb + 4, 4)) {
            pg8::Gemm g{HB, (const pg8::bf16_t*)(P.ws + WS_WIN), MMAIN, NIN, DM}; pg8::StaticOrder S; S.init(MMAIN, NIN, lsg(G), lsg((int)blockIdx.x));
            pg8::EpiProj E{PROJ, NIN, P.b_gate + (size_t)layer * 2 * DM, COL_G, STAT(sI), CSl + CS_WIN, CBl + CS_WIN};
            { pg8::EpiProjTail ET{E}; gemm_tailn<3>(ldsl, (const bf16*)HB + (size_t)MTAIL0 * DM, (const bf16*)(P.ws + WS_WIN), NIN, DM, MTAIL0, ET, lsg(G), lsg((int)blockIdx.x)); }
            pg8::gemm_phase<pg8::EpiProj, pg8::StaticOrder, true, true, MMA_F16 != 0>(ldsl, g, S, E);
        }
        }
        SEAM(pb + 4);
        if (INP(pb + 5, 5)) {
            if (wave & 1) { phase_hy_pre(P, layer, ldsl, lsg(gw), lsg(NGW), lsg(wave), lvg(lane)); phase_vcopy(P, lsg(gw), lsg(NGW), lvg(lane)); phase_qkprep(P, layer, lsg(gw), lsg(NGW), lvg(lane)); }
            else { phase_qkprep(P, layer, lsg(gw), lsg(NGW), lvg(lane)); phase_vcopy(P, lsg(gw), lsg(NGW), lvg(lane)); phase_hy_pre(P, layer, ldsl, lsg(gw), lsg(NGW), lsg(wave), lvg(lane)); }
            if (NREP(5) > 1) { xcd_barrier(bar); phase_vcopy(P, lsg(gw), lsg(NGW), lvg(lane)); phase_hy_pre(P, layer, ldsl, lsg(gw), lsg(NGW), lsg(wave), lvg(lane)); } }
        SEAM(pb + 5);
        if (INP(pb + 6, 6)) { phase_mix<0>(P, layer, lds, MISC, ctl + CW_Q + 64 * layer);
            if (NREP(6) > 1) { xcd_barrier(bar); phase_mix<1>(P, layer, lds, MISC, ctl + CW_Q + 64 * (DEPTH + layer)); } }
        SEAM(pb + 6);
        for (int rep = 0; rep < NREP(7); ++rep) { if (rep) xcd_barrier(bar);
        if (INP(pb + 7, 7)) phase_hy_post(P, layer, ldsl, lsg(gw), lsg(NGW), lsg(wave), lvg(lane));
        }
        SEAM(pb + 7);
        for (int rep = 0; rep < NREP(8); ++rep) { if (rep) xcd_barrier(bar);
        if (INP(pb + 8, 8)) {
            pg8::Gemm g{(const pg8::bf16_t*)(P.ws + WS_YHY), (const pg8::bf16_t*)(P.ws + WS_WBH), MMAIN, DM, DYC}; pg8::StaticOrder S; S.init(MMAIN, DM, lsg(G), lsg((int)blockIdx.x), W2_WGM, W2_REV);
            pg8::EpiGate2 E{(pg8::bf16_t*)(P.ws + WS_G), DM, PROJ + COL_G, NIN};
            gemm_tail2(ldsl, (const bf16*)(P.ws + WS_YHY) + (size_t)MTAIL0 * DYC, (const bf16*)(P.ws + WS_WBH), DM, DYC, DHY, MTAIL0, E, lsg(G), lsg((int)blockIdx.x));
            pg8::gemm_phase<pg8::EpiGate2, pg8::StaticOrder, true, true>(ldsl, g, S, E);
        }
        }
        SEAM(pb + 8);
        if (INP(pb + 9, 9)) {
            pg8::Gemm g{(const pg8::bf16_t*)(P.ws + WS_G), (const pg8::bf16_t*)(P.ws + WS_WOUT), MMAIN, DM, DM}; pg8::StaticOrder S; S.init(MMAIN, DM, lsg(G), lsg((int)blockIdx.x), W2_WGM, W2_REV);
            pg8::EpiResid E{(pg8::bf16_t*)(P.ws + WS_H32), (pg8::bf16_t*)RBw, DM, ALPHA, 1.0f, STAT(sI), ln_gain(P, lnI), ln_bias(P, lnI), STAT(sB)};
            gemm_tail(ldsl, (const bf16*)(P.ws + WS_G) + (size_t)MTAIL0 * DM, (const bf16*)(P.ws + WS_WOUT), DM, DM, MTAIL0, E, lsg(G), lsg((int)blockIdx.x));
            pg8::gemm_phase<pg8::EpiResid, pg8::StaticOrder, true, true>(ldsl, g, S, E);
        }
        SEAM(pb + 9);
        for (int rep = 0; rep < NREP(11); ++rep) { if (rep) xcd_barrier(bar);
        if (INP(pb + 11, 11)) {
            pg8::Gemm g{HB, (const pg8::bf16_t*)(P.ws + WS_W13B), MPAD, 2 * DFF, DM}; pg8::StaticOrder S; S.init(MPAD, 2 * DFF, lsg(G), lsg((int)blockIdx.x));
            pg8::EpiSwiglu E{PROJ, DFF, STAT(sB), CSl + CS_W13B, CBl + CS_W13B};
            pg8::gemm_phase<pg8::EpiSwiglu, pg8::StaticOrder, true, true, MMA_F16 != 0>(ldsl, g, S, E);
        }
        }
        SEAM(pb + 11);
        if (INP(pb + 12, 12)) {
            pg8::Gemm g{PROJ, (const pg8::bf16_t*)(P.ws + WS_W2B), MMAIN, DM, DFF}; pg8::StaticOrder S; S.init(MMAIN, DM, lsg(G), lsg((int)blockIdx.x), W2_WGM, W2_REV);
            pg8::EpiResid E{(pg8::bf16_t*)(P.ws + WS_H32), (pg8::bf16_t*)(layer == DEPTH - 1 ? (bf16*)nullptr : RBw), DM, ALPHA, 0.5f, STAT(sB), ln_gain(P, lnB), ln_bias(P, lnB), STAT(sC)};
            gemm_tail(ldsl, (const bf16*)PROJ + (size_t)MTAIL0 * DFF, (const bf16*)(P.ws + WS_W2B), DM, DFF, MTAIL0, E, lsg(G), lsg((int)blockIdx.x));
            pg8::gemm_phase<pg8::EpiResid, pg8::StaticOrder, true, true>(ldsl, g, S, E);
        }
        SEAM(pb + 12);
        if (layer == DEPTH - 1 && INP(pb + 13, 13)) phase_ln_out(P, P.ln_g + ((size_t)layer * 3 + 2) * DM, P.ln_b + ((size_t)layer * 3 + 2) * DM, lsg(gw), lsg(NGW), lvg(lane));
    }
#undef STAT
#undef IN
#undef SEAM
#undef P
}

#ifndef MK_N_LAUNCHES
#define MK_N_LAUNCHES 1
#endif
extern "C" void kernel_launch(void* const* d_in, const int* in_sizes, int n_in, void* d_out, int out_size, void* d_ws, size_t ws_size, hipStream_t stream) {
    static int grid = 0;
    if (grid == 0) {
        if (n_in != 25 || ws_size < WS_END) { fprintf(stderr, "kernel_launch: n_in %d ws %zu need %zu\n", n_in, ws_size, (size_t)WS_END); grid = -1; return; }
        int dev = 0, cus = 0, per_cu = 0;
        if (hipGetDevice(&dev) != hipSuccess || hipDeviceGetAttribute(&cus, hipDeviceAttributeMultiprocessorCount, dev) != hipSuccess) { grid = -1; return; }
        if (hipFuncSetAttribute((const void*)fwd, hipFuncAttributeMaxDynamicSharedMemorySize, LDS_BYTES) != hipSuccess) { fprintf(stderr, "kernel_launch: hipFuncSetAttribute failed\n"); grid = -1; return; }
        if (hipOccupancyMaxActiveBlocksPerMultiprocessor(&per_cu, (const void*)fwd, 512, LDS_BYTES) != hipSuccess || per_cu < 1) { fprintf(stderr, "kernel_launch: occupancy query says %d\n", per_cu); grid = -1; (void)hipGetLastError(); return; }
        grid = cus;
    }
    if (grid < 0) return;
    if (hipMemsetAsync((char*)d_ws + WS_CTL, 0, CTL_ZERO_BYTES, stream) != hipSuccess) return;
    Args a{};
    const float** pp = (const float**)&a.p;
    for (int i = 0; i < 25; ++i) pp[i] = (const float*)d_in[i];
    a.p.out = (float*)d_out; a.p.ws = (unsigned char*)d_ws;
#if MK_N_LAUNCHES == 1
    a.ph_lo = 0; a.ph_hi = NPHASES;
    hipLaunchKernelGGL(fwd, dim3(grid), dim3(512), LDS_BYTES, stream, a);
#else
    for (int ph = 0; ph < NPHASES; ++ph) { a.ph_lo = ph; a.ph_hi = ph + 1; hipLaunchKernelGGL(fwd, dim3(grid), dim3(512), LDS_BYTES, stream, a); }
#endif
}
```
